# Optimizing an MI355X kernel written in HIP

```python
import math
import jax, jax.numpy as jnp
from jax import lax
import numpy as np

D_MODEL = 1024
BATCH = 2
SEQ = 16384
DEPTH = 4

N_MIXERS = 4
EPS = 1e-6
CONV_WIDTH = 1024
CONV_K = 3
FOX_HEADS = 8
FOX_HEAD_DIM = 128
FOX_WIDTH = FOX_HEADS * FOX_HEAD_DIM
Q_BLOCK = 128
GDN_HEADS = 8
GDN_HEAD_DIM = 128
GDN_WIDTH = GDN_HEADS * GDN_HEAD_DIM
GDN_CONV_K = 4
GDN_CHUNK = 64
SWA_HEADS = 16
SWA_KV_HEADS = 4
SWA_GROUP = SWA_HEADS // SWA_KV_HEADS
SWA_HEAD_DIM = 64
SWA_WIDTH = SWA_HEADS * SWA_HEAD_DIM
SWA_KV_WIDTH = SWA_KV_HEADS * SWA_HEAD_DIM
WINDOW = 128
ROPE_THETA = 10000.0

N_CONV_LAYERS = (DEPTH + 3) // 4
N_FOX_LAYERS = (DEPTH + 2) // 4
N_GDN_LAYERS = (DEPTH + 1) // 4
N_SWA_LAYERS = DEPTH // 4

kernel_name = "hybrid_interleaved_mixers"


def rms_norm(x, w):
    x32 = x.astype(jnp.float32)
    y = x32 * lax.rsqrt(jnp.mean(x32 * x32, axis=-1, keepdims=True) + EPS)
    return (y * w.astype(jnp.float32)).astype(x.dtype)


def causal_conv(u, w):
    K = w.shape[0]
    S = u.shape[1]
    up = jnp.pad(u, ((0, 0), (K - 1, 0), (0, 0)))
    out = up[:, 0:S] * w[0]
    for k in range(1, K):
        out = out + up[:, k:k + S] * w[k]
    return out


def rope(x, positions):
    d = x.shape[-1]
    half = d // 2
    inv_freq = ROPE_THETA ** (-jnp.arange(half, dtype=jnp.float32) / half)
    ang = positions.astype(jnp.float32)[..., None] * inv_freq
    cos = jnp.cos(ang)[:, :, None, :]
    sin = jnp.sin(ang)[:, :, None, :]
    x32 = x.astype(jnp.float32)
    x1, x2 = x32[..., :half], x32[..., half:]
    return jnp.concatenate([x1 * cos - x2 * sin, x2 * cos + x1 * sin], axis=-1).astype(x.dtype)


def conv_mixer(h, w_in, w_conv, w_out):
    proj = h @ w_in
    b_gate, c_gate, v, z = jnp.split(proj, 4, axis=-1)
    y = b_gate * causal_conv(c_gate * v, w_conv)
    return (y * jax.nn.silu(z)) @ w_out


def fox_mixer(h, w_in, b_f, w_out):
    B_, S, _ = h.shape
    H, d = FOX_HEADS, FOX_HEAD_DIM
    proj = h @ w_in
    q, k, v, z, f_logit = jnp.split(proj, [FOX_WIDTH, 2 * FOX_WIDTH, 3 * FOX_WIDTH, 4 * FOX_WIDTH], axis=-1)
    q = q.reshape(B_, S, H, d)
    k = k.reshape(B_, S, H, d)
    v = v.reshape(B_, S, H, d)
    log_f = jax.nn.log_sigmoid((f_logit + b_f).astype(jnp.float32))
    c = jnp.cumsum(log_f, axis=1)
    c_keys = c.transpose(0, 2, 1)
    nblk = S // Q_BLOCK
    q_blocks = q.reshape(B_, nblk, Q_BLOCK, H, d).transpose(1, 0, 2, 3, 4)
    c_blocks = c.reshape(B_, nblk, Q_BLOCK, H).transpose(1, 0, 3, 2)
    scale = 1.0 / math.sqrt(d)
    k_pos = jnp.arange(S)

    def block(args):
        i, q_i, c_i = args
        s = jnp.einsum('bqhd,bkhd->bhqk', q_i, k).astype(jnp.float32) * scale
        decay = c_i[..., :, None] - c_keys[:, :, None, :]
        q_pos = i * Q_BLOCK + jnp.arange(Q_BLOCK)
        mask = k_pos[None, :] <= q_pos[:, None]
        logits = jnp.where(mask, s + decay, -jnp.inf)
        p = jax.nn.softmax(logits, axis=-1)
        return jnp.einsum('bhqk,bkhd->bqhd', p.astype(v.dtype), v)

    o = lax.map(block, (jnp.arange(nblk), q_blocks, c_blocks))
    o = o.transpose(1, 0, 2, 3, 4).reshape(B_, S, FOX_WIDTH)
    return (o * jax.nn.silu(z)) @ w_out


def chunk_gated_delta(q, k, v, g, beta):
    B_, S, H, dk = q.shape
    dv = v.shape[-1]
    C = GDN_CHUNK
    n = S // C
    f32 = jnp.float32

    def chunks(t):
        return t.astype(f32).reshape(B_, n, C, H, -1).transpose(0, 3, 1, 2, 4)

    q, k, v = chunks(q), chunks(k), chunks(v)
    beta = beta.astype(f32).reshape(B_, n, C, H).transpose(0, 3, 1, 2)
    g_cum = jnp.cumsum(g.astype(f32).reshape(B_, n, C, H).transpose(0, 3, 1, 2), axis=-1)
    k_beta = k * beta[..., None]
    v_beta = v * beta[..., None]
    idx = jnp.arange(C)
    causal = idx[:, None] >= idx[None, :]
    strict = idx[:, None] > idx[None, :]
    diff = g_cum[..., :, None] - g_cum[..., None, :]
    decay = jnp.where(causal, jnp.exp(jnp.where(causal, diff, 0.0)), 0.0)
    L = jnp.where(strict, jnp.einsum('bhnid,bhnjd->bhnij', k_beta, k) * decay, 0.0)
    eye = jnp.eye(C, dtype=f32)
    T = lax.linalg.triangular_solve(eye + L, jnp.broadcast_to(eye, L.shape), left_side=True, lower=True, unit_diagonal=True)
    u = T @ v_beta
    w = T @ (k_beta * jnp.exp(g_cum)[..., None])
    qk = jnp.where(causal, jnp.einsum('bhnid,bhnjd->bhnij', q, k) * decay, 0.0)
    g_last = g_cum[..., -1]
    k_dec = k * jnp.exp(g_last[..., None] - g_cum)[..., None]
    q_dec = q * jnp.exp(g_cum)[..., None]

    def to_scan(t):
        return jnp.moveaxis(t, 2, 0)

    def step(state, xs):
        qd, kd, u_c, w_c, qk_c, gl = xs
        v_new = u_c - w_c @ state
        o = qd @ state + qk_c @ v_new
        state = state * jnp.exp(gl)[..., None, None] + jnp.einsum('bhck,bhcv->bhkv', kd, v_new)
        return state, o

    state0 = jnp.zeros((B_, H, dk, dv), f32)
    xs = (to_scan(q_dec), to_scan(k_dec), to_scan(u), to_scan(w), to_scan(qk), to_scan(g_last))
    _, o = lax.scan(step, state0, xs)
    return o.transpose(1, 0, 3, 2, 4).reshape(B_, S, H, dv)


def gdn_mixer(h, w_in, w_conv, a_log, dt_bias, w_onorm, w_out):
    B_, S, _ = h.shape
    H, d = GDN_HEADS, GDN_HEAD_DIM
    proj = h @ w_in
    qkv, z, beta_logit, a_logit = jnp.split(proj, [3 * GDN_WIDTH, 4 * GDN_WIDTH, 4 * GDN_WIDTH + H], axis=-1)
    qkv = jax.nn.silu(causal_conv(qkv, w_conv))
    q, k, v = jnp.split(qkv, 3, axis=-1)
    q = q.reshape(B_, S, H, d).astype(jnp.float32)
    k = k.reshape(B_, S, H, d).astype(jnp.float32)
    v = v.reshape(B_, S, H, d)
    q = q * lax.rsqrt(jnp.sum(q * q, axis=-1, keepdims=True) + EPS) * (1.0 / math.sqrt(d))
    k = k * lax.rsqrt(jnp.sum(k * k, axis=-1, keepdims=True) + EPS)
    beta = jax.nn.sigmoid(beta_logit.astype(jnp.float32))
    g = -jnp.exp(a_log.astype(jnp.float32)) * jax.nn.softplus(a_logit.astype(jnp.float32) + dt_bias.astype(jnp.float32))
    o = chunk_gated_delta(q, k, v, g, beta)
    o = o * lax.rsqrt(jnp.mean(o * o, axis=-1, keepdims=True) + EPS) * w_onorm.astype(jnp.float32)
    o = o.reshape(B_, S, GDN_WIDTH).astype(h.dtype)
    return (o * jax.nn.silu(z)) @ w_out


def swa_mixer(h, positions, w_in, sinks, w_out):
    B_, S, _ = h.shape
    Hk, G, d = SWA_KV_HEADS, SWA_GROUP, SWA_HEAD_DIM
    proj = h @ w_in
    q, k, v, z = jnp.split(proj, [SWA_WIDTH, SWA_WIDTH + SWA_KV_WIDTH, SWA_WIDTH + 2 * SWA_KV_WIDTH], axis=-1)
    q = rope(q.reshape(B_, S, SWA_HEADS, d), positions)
    k = rope(k.reshape(B_, S, Hk, d), positions)
    v = v.reshape(B_, S, Hk, d)
    W = WINDOW
    nblk = S // W
    qb = q.reshape(B_, nblk, W, Hk, G, d)

    def band(t):
        tb = t.reshape(B_, nblk, W, Hk, d)
        prev = jnp.pad(tb, ((0, 0), (1, 0), (0, 0), (0, 0), (0, 0)))[:, :-1]
        return jnp.concatenate([prev, tb], axis=2)

    kk, vv = band(k), band(v)
    s = jnp.einsum('bnqhgd,bnkhd->bnhgqk', qb, kk).astype(jnp.float32) * (1.0 / math.sqrt(d))
    q_idx = jnp.arange(W)[:, None] + W
    k_idx = jnp.arange(2 * W)[None, :]
    rel = q_idx - k_idx
    blk = jnp.arange(nblk)[:, None, None]
    mask = (rel >= 0) & (rel < WINDOW) & (blk * W + k_idx - W >= 0)
    logits = jnp.where(mask[None, :, None, None, :, :], s, -jnp.inf)
    sink = sinks.astype(jnp.float32).reshape(1, 1, Hk, G, 1, 1)
    m = jnp.maximum(jnp.max(logits, axis=-1, keepdims=True), sink)
    e = jnp.exp(logits - m)
    p = e / (jnp.sum(e, axis=-1, keepdims=True) + jnp.exp(sink - m))
    o = jnp.einsum('bnhgqk,bnkhd->bnqhgd', p.astype(vv.dtype), vv).reshape(B_, S, SWA_WIDTH)
    return (o * jax.nn.silu(z)) @ w_out


def setup_inputs(seed: int = 0) -> dict:
    key = jax.random.key(seed)
    ks = jax.random.split(key, 24)
    f32 = jnp.float32
    D = D_MODEL

    def lin(k, shape):
        return jax.random.normal(k, shape, f32) * (shape[-2] ** -0.5)

    x = jax.random.normal(ks[0], (BATCH, SEQ, D), f32)
    offset = jax.random.randint(ks[1], (BATCH, 1), 0, 1024, dtype=jnp.int32)
    positions = offset + jnp.arange(SEQ, dtype=jnp.int32)[None, :]
    norm_w = 1.0 + 0.1 * jax.random.normal(ks[2], (DEPTH, D), f32)
    final_norm_w = 1.0 + 0.1 * jax.random.normal(ks[3], (D,), f32)
    conv_w_in = lin(ks[4], (N_CONV_LAYERS, D, 4 * CONV_WIDTH))
    conv_w_conv = jax.random.normal(ks[5], (N_CONV_LAYERS, CONV_K, CONV_WIDTH), f32) * (CONV_K ** -0.5)
    conv_w_out = lin(ks[6], (N_CONV_LAYERS, CONV_WIDTH, D))
    fox_w_in = lin(ks[7], (N_FOX_LAYERS, D, 4 * FOX_WIDTH + FOX_HEADS))
    fox_b_f = jax.random.uniform(ks[8], (N_FOX_LAYERS, FOX_HEADS), f32, 1.0, 5.0)
    fox_w_out = lin(ks[9], (N_FOX_LAYERS, FOX_WIDTH, D))
    gdn_w_in = lin(ks[10], (N_GDN_LAYERS, D, 4 * GDN_WIDTH + 2 * GDN_HEADS))
    gdn_w_conv = jax.random.normal(ks[11], (N_GDN_LAYERS, GDN_CONV_K, 3 * GDN_WIDTH), f32) * (GDN_CONV_K ** -0.5)
    gdn_a_log = jnp.log(jax.random.uniform(ks[12], (N_GDN_LAYERS, GDN_HEADS), f32, 1.0, 16.0))
    dt = jnp.exp(jax.random.uniform(ks[13], (N_GDN_LAYERS, GDN_HEADS), f32, math.log(1e-3), math.log(1e-1)))
    gdn_dt_bias = dt + jnp.log(-jnp.expm1(-dt))
    gdn_norm_w = 1.0 + 0.1 * jax.random.normal(ks[14], (N_GDN_LAYERS, GDN_HEAD_DIM), f32)
    gdn_w_out = lin(ks[15], (N_GDN_LAYERS, GDN_WIDTH, D))
    swa_w_in = lin(ks[16], (N_SWA_LAYERS, D, 2 * SWA_WIDTH + 2 * SWA_KV_WIDTH))
    swa_sinks = 0.5 * jax.random.normal(ks[17], (N_SWA_LAYERS, SWA_HEADS), f32)
    swa_w_out = lin(ks[18], (N_SWA_LAYERS, SWA_WIDTH, D))
    return {"x": x, "positions": positions, "norm_w": norm_w, "final_norm_w": final_norm_w,
            "conv_w_in": conv_w_in, "conv_w_conv": conv_w_conv, "conv_w_out": conv_w_out,
            "fox_w_in": fox_w_in, "fox_b_f": fox_b_f, "fox_w_out": fox_w_out,
            "gdn_w_in": gdn_w_in, "gdn_w_conv": gdn_w_conv, "gdn_a_log": gdn_a_log, "gdn_dt_bias": gdn_dt_bias,
            "gdn_norm_w": gdn_norm_w, "gdn_w_out": gdn_w_out,
            "swa_w_in": swa_w_in, "swa_sinks": swa_sinks, "swa_w_out": swa_w_out}


def reference(x, positions, norm_w, final_norm_w, conv_w_in, conv_w_conv, conv_w_out,
              fox_w_in, fox_b_f, fox_w_out, gdn_w_in, gdn_w_conv, gdn_a_log, gdn_dt_bias,
              gdn_norm_w, gdn_w_out, swa_w_in, swa_sinks, swa_w_out):
    for i in range(DEPTH):
        h = rms_norm(x, norm_w[i])
        kind, j = i % N_MIXERS, i // N_MIXERS
        if kind == 0:
            y = conv_mixer(h, conv_w_in[j], conv_w_conv[j], conv_w_out[j])
        elif kind == 1:
            y = fox_mixer(h, fox_w_in[j], fox_b_f[j], fox_w_out[j])
        elif kind == 2:
            y = gdn_mixer(h, gdn_w_in[j], gdn_w_conv[j], gdn_a_log[j], gdn_dt_bias[j], gdn_norm_w[j], gdn_w_out[j])
        else:
            y = swa_mixer(h, positions, swa_w_in[j], swa_sinks[j], swa_w_out[j])
        x = x + y.astype(x.dtype)
    return rms_norm(x, final_norm_w)
```

```cpp
#include <hip/hip_runtime.h>
#include <hip/hip_cooperative_groups.h>
#include <cstdio>
#include <cstdint>
namespace cg = cooperative_groups;

#define DI __device__ __forceinline__
#define LAS __attribute__((address_space(3)))
#define GAS __attribute__((address_space(1)))
typedef unsigned short bf16;
typedef unsigned v4u __attribute__((ext_vector_type(4)));
typedef unsigned v2u __attribute__((ext_vector_type(2)));
typedef float f32x4 __attribute__((ext_vector_type(4)));
typedef float f32x16 __attribute__((ext_vector_type(16)));
typedef short bf16x8 __attribute__((ext_vector_type(8)));

constexpr int NBATCH = 2, SEQ = 16384, TT = NBATCH * SEQ, DM = 1024;
constexpr float EPS = 1e-6f;
constexpr int NWAVES = 8, NTHR = 512;
constexpr size_t MiB = 1u << 20;
constexpr size_t WS_W0I = 0, WS_W0O = 8 * MiB, WS_W1I = 10 * MiB, WS_W1O = 18 * MiB, WS_W2I = 20 * MiB, WS_W2O = 28 * MiB, WS_W3I = 30 * MiB, WS_W3O = 35 * MiB;
constexpr size_t WS_LOGF = 38 * MiB;
constexpr size_t WS_CUM = 39 * MiB;
constexpr size_t WS_GL = 40 * MiB;
constexpr size_t WS_HALO = 48 * MiB;
constexpr size_t WS_HY = 64 * MiB;
constexpr size_t WS_PROJ = 128 * MiB;
constexpr size_t WS_EX = 384 * MiB;
constexpr size_t WS_END = 512 * MiB;
constexpr int LDS_BYTES = 155648;

DI unsigned f2bf(float f) { unsigned u = __builtin_bit_cast(unsigned, f); return (u + 0x7fffu + ((u >> 16) & 1u)) >> 16; }
typedef float f32x2_t __attribute__((ext_vector_type(2)));
typedef __bf16 bf16x2_t __attribute__((ext_vector_type(2)));
DI unsigned pk2(float lo, float hi) { f32x2_t v = {lo, hi}; bf16x2_t b = __builtin_convertvector(v, bf16x2_t); return __builtin_bit_cast(unsigned, b); }
DI float bflo(unsigned u) { return __builtin_bit_cast(float, u << 16); }
DI float bfhi(unsigned u) { return __builtin_bit_cast(float, u & 0xffff0000u); }
DI float bf2f(bf16 b) { return __builtin_bit_cast(float, (unsigned)b << 16); }
DI float wave_sum(float v) {
#pragma unroll
    for (int o = 1; o < 64; o <<= 1) v += __shfl_xor(v, o);
    return v;
}
DI float silu_f(float x) { return x / (1.f + __expf(-x)); }
DI float softplus_f(float x) { return fmaxf(x, 0.f) + log1pf(__expf(-fabsf(x))); }
namespace pg8 {
#define PG8_LAS __attribute__((address_space(3)))
typedef unsigned short bf16_t;
typedef short bf16x8 __attribute__((ext_vector_type(8)));
typedef float f32x4 __attribute__((ext_vector_type(4)));
typedef unsigned u32x4 __attribute__((ext_vector_type(4)));
constexpr int BM = 256, BK = 64, HALF = 128, HTB = HALF * BK * 2  , STAGE_BYTES = 8 * HTB, NXCD = 8, WGM = 8;

__host__ __device__ __forceinline__ int lds_byte(int r, int c) { const int st = (r >> 4) * 2 + (c >> 5), rr = r & 15, cc = c & 31, ob = rr * 64 + cc * 2; return st * 1024 + (ob ^ (((ob >> 9) & 1) << 5)); }
__host__ __device__ __forceinline__ void stage_rc(int b, int& R, int& C) { const int st = b / 1024, sb = b % 1024, swz = sb ^ (((sb >> 9) & 1) << 5); R = (st >> 1) * 16 + swz / 64; C = (st & 1) * 32 + (swz % 64) / 2; }
__host__ __device__ __forceinline__ int perm32(int rho) { const int n = rho >> 4, i = rho & 15; return 8 * (i >> 2) + 4 * n + (i & 3); }

struct Unit { int pm, pn; };
struct Gemm { const bf16_t* A; const bf16_t* Bt; int M, N, K; };

struct StaticOrder {
    int nM, nN, nwg, G, c;
    __host__ __device__ void init(int M, int N, int G_, int c_) { nM = M / BM; nN = N / BM; nwg = nM * nN; G = G_; c = c_; }
    __host__ __device__ bool next(int i, Unit& u) const {
        const long L = (long)i * G + c; if (L >= nwg) return false;
        int wgid = (int)L; { const int q = nwg / NXCD, r = nwg % NXCD, xcd = wgid % NXCD, off = wgid / NXCD; wgid = (xcd < r ? xcd * (q + 1) : r * (q + 1) + (xcd - r) * q) + off; }
        const int nig = WGM * nN, gid = wgid / nig, fm = gid * WGM, gsz = (nM - fm) < WGM ? (nM - fm) : WGM;
        u.pm = fm + ((wgid % nig) % gsz); u.pn = (wgid % nig) / gsz; return true;
    }
    __device__ __forceinline__ void a_ready(const Unit&) const {}
    __device__ __forceinline__ void done(const Unit&) const {}
};

__device__ __forceinline__ unsigned cvt_pk_bf16(float lo, float hi) { unsigned r; asm volatile("v_cvt_pk_bf16_f32 %0, %1, %2" : "=v"(r) : "v"(lo), "v"(hi)); return r; }
struct EpiStore {
    static constexpr bool PERM = true, AFTER_DRAIN = false;
    bf16_t* O; int ldc; bf16_t* HALO; float* KP;
    __device__ __forceinline__ void operator()(const f32x4 (&acc)[2][2][4][2], const Unit& u, int wr, int wc, int fr, int fq) const {
        const int row0 = u.pm * BM + wr * 64 + fr; const int col0 = u.pn * BM + wc * 32 + 8 * fq;
#pragma unroll
        for (int ai = 0; ai < 2; ++ai)
#pragma unroll
            for (int m = 0; m < 4; ++m) { const int row = row0 + ai * HALF + m * 16; bf16_t* rowp = O + (size_t)row * ldc + col0;
#pragma unroll
                for (int bj = 0; bj < 2; ++bj) { const f32x4 v0 = acc[ai][bj][m][0], v1 = acc[ai][bj][m][1];
                    u32x4 w; w.x = cvt_pk_bf16(v0[0], v0[1]); w.y = cvt_pk_bf16(v0[2], v0[3]); w.z = cvt_pk_bf16(v1[0], v1[1]); w.w = cvt_pk_bf16(v1[2], v1[3]);
                    *(u32x4*)(rowp + bj * HALF) = w;
                    if (KP != nullptr && (u.pn >> 2) == 1) { float s = 0.f;
#pragma unroll
                        for (int i = 0; i < 4; ++i) { const unsigned ww = (i == 0) ? w.x : (i == 1 ? w.y : (i == 2 ? w.z : w.w));
                            const float lo = __builtin_bit_cast(float, ww << 16), hi = __builtin_bit_cast(float, ww & 0xffff0000u); s += lo * lo + hi * hi; }
                        s += __shfl_xor(s, 16); s += __shfl_xor(s, 32);
                        if (fq == 0) KP[((size_t)row * 8 + 2 * (u.pn - 4) + bj) * 4 + wc] = s; }
                    if (HALO != nullptr && m == 3 && fr >= 13 && (col0 + bj * HALF) < 3072)
                        *(u32x4*)(HALO + ((size_t)(row >> 6) * 3 + (fr - 13)) * 3072 + col0 + bj * HALF) = w;
                } }
    }
};
template <bool RB, bool OB, bool PSUM = false>
struct EpiRes {
    static constexpr bool PERM = true, AFTER_DRAIN = false;
    const void* R; void* O; float* PS;
    __device__ __forceinline__ void operator()(const f32x4 (&acc)[2][2][4][2], const Unit& u, int wr, int wc, int fr, int fq) const {
        const int row0 = u.pm * BM + wr * 64 + fr; const int col0 = u.pn * BM + wc * 32 + 8 * fq;
#pragma unroll
        for (int ai = 0; ai < 2; ++ai)
#pragma unroll
            for (int m = 0; m < 4; ++m) { const size_t off = (size_t)(row0 + ai * HALF + m * 16) * 1024 + col0; float ssq = 0.f;
#pragma unroll
                for (int bj = 0; bj < 2; ++bj) {
                    f32x4 r0, r1;
                    if constexpr (RB) { const u32x4 w = *(const u32x4*)((const bf16_t*)R + off + bj * HALF);
                        r0 = (f32x4){__builtin_bit_cast(float, w.x << 16), __builtin_bit_cast(float, w.x & 0xffff0000u), __builtin_bit_cast(float, w.y << 16), __builtin_bit_cast(float, w.y & 0xffff0000u)};
                        r1 = (f32x4){__builtin_bit_cast(float, w.z << 16), __builtin_bit_cast(float, w.z & 0xffff0000u), __builtin_bit_cast(float, w.w << 16), __builtin_bit_cast(float, w.w & 0xffff0000u)}; }
                    else { r0 = *(const f32x4*)((const float*)R + off + bj * HALF); r1 = *(const f32x4*)((const float*)R + off + bj * HALF + 4); }
                    const f32x4 v0 = r0 + acc[ai][bj][m][0], v1 = r1 + acc[ai][bj][m][1];
                    if constexpr (OB) { u32x4 w; w.x = cvt_pk_bf16(v0[0], v0[1]); w.y = cvt_pk_bf16(v0[2], v0[3]); w.z = cvt_pk_bf16(v1[0], v1[1]); w.w = cvt_pk_bf16(v1[2], v1[3]);
                        *(u32x4*)((bf16_t*)O + off + bj * HALF) = w;
                        if constexpr (PSUM) {
#pragma unroll
                            for (int i = 0; i < 4; ++i) { const unsigned ww = (i == 0) ? w.x : (i == 1 ? w.y : (i == 2 ? w.z : w.w));
                                const float lo = __builtin_bit_cast(float, ww << 16), hi = __builtin_bit_cast(float, ww & 0xffff0000u); ssq += lo * lo + hi * hi; } } }
                    else { *(f32x4*)((float*)O + off + bj * HALF) = v0; *(f32x4*)((float*)O + off + bj * HALF + 4) = v1; }
                }
                if constexpr (PSUM) { ssq += __shfl_xor(ssq, 16); ssq += __shfl_xor(ssq, 32);
                    if (fq == 0) PS[(size_t)(row0 + ai * HALF + m * 16) * 16 + u.pn * 4 + wc] = ssq; } }
    }
};
struct EpiConvGate {
    static constexpr bool PERM = true, AFTER_DRAIN = false;
    bf16_t* Y; const float* wconv; float* CVH; float* BND;
    __device__ __forceinline__ void operator()(const f32x4 (&acc)[2][2][4][2], const Unit& u, int wr, int wc, int fr, int fq) const {
        const int ch0 = 64 * u.pn + 16 * wc + 4 * fq;
        const f32x4 w0 = *(const f32x4*)(wconv + ch0), w1 = *(const f32x4*)(wconv + 1024 + ch0), w2 = *(const f32x4*)(wconv + 2048 + ch0);
#pragma unroll
        for (int ai = 0; ai < 2; ++ai) {
            f32x4 p15 = (f32x4){0.f, 0.f, 0.f, 0.f}, p14 = (f32x4){0.f, 0.f, 0.f, 0.f};
#pragma unroll
            for (int m = 0; m < 4; ++m) {
                const int row = u.pm * BM + ai * HALF + wr * 64 + m * 16 + fr;
                const f32x4 b = acc[ai][0][m][0], c = acc[ai][0][m][1], v = acc[ai][1][m][0], z = acc[ai][1][m][1];
                const f32x4 cv = c * v;
                f32x4 y, n15, n14;
#pragma unroll
                for (int e = 0; e < 4; ++e) {
                    const float up1 = __shfl_up(cv[e], 1, 16), up2 = __shfl_up(cv[e], 2, 16);
                    const float cm1 = (fr >= 1) ? up1 : p15[e];
                    const float cm2 = (fr >= 2) ? up2 : ((fr == 1) ? p15[e] : p14[e]);
                    const float zz = z[e];
                    y[e] = b[e] * (w0[e] * cm2 + w1[e] * cm1 + w2[e] * cv[e]) * (zz / (1.f + __expf(-zz)));
                    n15[e] = __shfl(cv[e], 15, 16); n14[e] = __shfl(cv[e], 14, 16);
                }
                p15 = n15; p14 = n14;
                if (m > 0 || fr >= 2) {
                    unsigned long long o = (unsigned long long)cvt_pk_bf16(y[0], y[1]) | ((unsigned long long)cvt_pk_bf16(y[2], y[3]) << 32);
                    *(unsigned long long*)(Y + (size_t)row * 1024 + ch0) = o;
                } else {
                    float* bp = BND + ((size_t)(row >> 6) * 2 + fr) * 3 * 1024 + ch0;
                    *(f32x4*)bp = b; *(f32x4*)(bp + 1024) = z; *(f32x4*)(bp + 2048) = cv;
                }
                if (m == 3 && fr >= 14) *(f32x4*)(CVH + ((size_t)(row >> 6) * 2 + (fr - 14)) * 1024 + ch0) = cv;
            }
        }
    }
};
struct EpiStoreScaled {
    static constexpr bool PERM = true, AFTER_DRAIN = false;
    bf16_t* O; int ldc; const float* PS;
    __device__ __forceinline__ void operator()(const f32x4 (&acc)[2][2][4][2], const Unit& u, int wr, int wc, int fr, int fq) const {
        const int row0 = u.pm * BM + wr * 64 + fr; const int col0 = u.pn * BM + wc * 32 + 8 * fq;
#pragma unroll
        for (int ai = 0; ai < 2; ++ai)
#pragma unroll
            for (int m = 0; m < 4; ++m) { const int row = row0 + ai * HALF + m * 16; bf16_t* rowp = O + (size_t)row * ldc + col0;
                const f32x4* pp = (const f32x4*)(PS + (size_t)row * 16);
                const f32x4 s4 = (pp[0] + pp[1]) + (pp[2] + pp[3]);
                const float r = rsqrtf(((s4[0] + s4[1]) + (s4[2] + s4[3])) * (1.f / 1024.f) + 1e-6f);
#pragma unroll
                for (int bj = 0; bj < 2; ++bj) { const f32x4 v0 = acc[ai][bj][m][0] * r, v1 = acc[ai][bj][m][1] * r;
                    u32x4 w; w.x = cvt_pk_bf16(v0[0], v0[1]); w.y = cvt_pk_bf16(v0[2], v0[3]); w.z = cvt_pk_bf16(v1[0], v1[1]); w.w = cvt_pk_bf16(v1[2], v1[3]);
                    *(u32x4*)(rowp + bj * HALF) = w; } }
    }
};
template <class Epi, class Sched, bool ALIGN_EPI = false, bool SP2 = false>
__device__ __forceinline__ void gemm_phase(PG8_LAS unsigned char* lds, const Gemm g, const Sched& S, const Epi& E) {
    int tid_l = threadIdx.x; asm volatile("" : "+v"(tid_l));
    const int tid = tid_l, wid = __builtin_amdgcn_readfirstlane(tid >> 6), lane = tid & 63, wr = wid >> 2, wc = wid & 3, fr = lane & 15, fq = lane >> 4;
    const int K = g.K, nt = K / BK;
    unsigned voffA[2], voffB[2];
#pragma unroll
    for (int i = 0; i < 2; ++i) { int R, C; stage_rc(tid * 16 + i * 8192, R, C); const int Rb = Epi::PERM ? ((R & ~31) + perm32(R & 31)) : R;
        voffA[i] = (unsigned)(R * K + C) * 2u; voffB[i] = (unsigned)(Rb * K + C) * 2u; }
    const size_t kstep = (size_t)(BK * 2);
    const size_t hstep = (size_t)HALF * K * 2;
    const size_t tstep = 2 * hstep;
    const unsigned ldsw = (unsigned)wid * 1024u;
    const int aoff = lds_byte(wr * 64 + fr, fq * 8), boff = lds_byte(wc * 32 + fr, fq * 8);
#define PG8_SA(b, h) (((b) * 2 + (h)) * HTB)
#define PG8_SB(b, h) ((4 + (b) * 2 + (h)) * HTB)
#define PG8_STAGE(bufoff, gbase, voff) do { _Pragma("unroll") for (int _i = 0; _i < 2; ++_i) \
        __builtin_amdgcn_global_load_lds((const unsigned*)((const char*)(gbase) + (voff)[_i]), (PG8_LAS unsigned*)(lds + (bufoff) + ldsw + _i * 8192), 16, 0, 0); } while (0)
#define PG8_LDA(dst, b, h) do { _Pragma("unroll") for (int m = 0; m < 4; ++m) _Pragma("unroll") for (int k = 0; k < 2; ++k) dst[m][k] = *(const PG8_LAS bf16x8*)(lds + PG8_SA(b, h) + aoff + m * 2048 + k * 1024); } while (0)
#define PG8_LDB(dst, b, h) do { _Pragma("unroll") for (int n = 0; n < 2; ++n) _Pragma("unroll") for (int k = 0; k < 2; ++k) dst[n][k] = *(const PG8_LAS bf16x8*)(lds + PG8_SB(b, h) + boff + n * 2048 + k * 1024); } while (0)
#define PG8_MMA(ai, bj, At, Bt) do { __builtin_amdgcn_s_setprio(1); _Pragma("unroll") for (int m = 0; m < 4; ++m) _Pragma("unroll") for (int n = 0; n < 2; ++n) _Pragma("unroll") for (int k = 0; k < 2; ++k) \
        acc[ai][bj][m][n] = __builtin_amdgcn_mfma_f32_16x16x32_bf16(Bt[n][k], At[m][k], acc[ai][bj][m][n], 0, 0, 0); __builtin_amdgcn_s_setprio(0); } while (0)
#define PG8_WAIT_V(n) asm volatile("s_waitcnt vmcnt(" #n ")" ::: "memory")
#define PG8_WAIT_L(n) asm volatile("s_waitcnt lgkmcnt(" #n ")" ::: "memory")
#define PG8_BAR __builtin_amdgcn_s_barrier()
#define PG8_SCHED __builtin_amdgcn_sched_barrier(0)
    Unit cur, nxt; int ui = 0;
    if (!S.next(0, cur)) return;
    f32x4 acc[2][2][4][2];
#pragma unroll
    for (int a = 0; a < 2; ++a)
#pragma unroll
        for (int b = 0; b < 2; ++b)
#pragma unroll
            for (int m = 0; m < 4; ++m)
#pragma unroll
                for (int n = 0; n < 2; ++n) acc[a][b][m][n] = (f32x4){0.f, 0.f, 0.f, 0.f};
    bf16x8 At[4][2], B0[2][2], B1[2][2];
    const char* cA = (const char*)g.A + (size_t)cur.pm * tstep; const char* cB = (const char*)g.Bt + (size_t)cur.pn * tstep;
    S.a_ready(cur);
    if constexpr (SP2) {
        PG8_STAGE(PG8_SB(0, 0), cB, voffB); PG8_STAGE(PG8_SB(0, 1), cB + hstep, voffB); PG8_STAGE(PG8_SA(0, 0), cA, voffA); PG8_STAGE(PG8_SA(0, 1), cA + hstep, voffA);
        if (wr == 1) PG8_BAR;
        PG8_WAIT_V(2); PG8_BAR;
        PG8_STAGE(PG8_SB(1, 0), cB + kstep, voffB); PG8_STAGE(PG8_SA(1, 0), cA + kstep, voffA); PG8_STAGE(PG8_SB(1, 1), cB + hstep + kstep, voffB);
        PG8_WAIT_V(6); PG8_BAR;
    } else {
        PG8_STAGE(PG8_SB(0, 0), cB, voffB); PG8_STAGE(PG8_SA(0, 0), cA, voffA); PG8_STAGE(PG8_SB(0, 1), cB + hstep, voffB); PG8_STAGE(PG8_SA(0, 1), cA + hstep, voffA);
        if (wr == 1) PG8_BAR;
        PG8_WAIT_V(4); PG8_BAR;
        PG8_STAGE(PG8_SB(1, 0), cB + kstep, voffB); PG8_STAGE(PG8_SA(1, 0), cA + kstep, voffA); PG8_STAGE(PG8_SB(1, 1), cB + hstep + kstep, voffB);
        PG8_WAIT_V(6); PG8_BAR;
    }
    for (;;) {
        const bool has_next = S.next(ui + 1, nxt);
        const char* nA = has_next ? (const char*)g.A + (size_t)nxt.pm * tstep : cA; const char* nB = has_next ? (const char*)g.Bt + (size_t)nxt.pn * tstep : cB;
        for (int t = 0; t < nt; t += 2) {
            const bool last = (t == nt - 2);
            const char* a1 = cA + (size_t)(t + 1) * kstep;
            const char* a2 = last ? nA : cA + (size_t)(t + 2) * kstep; const char* b2 = last ? nB : cB + (size_t)(t + 2) * kstep;
            const char* a3 = a2 + kstep; const char* b3 = b2 + kstep;
            if (last && has_next) S.a_ready(nxt);
            if constexpr (SP2) {
            PG8_LDB(B0, 0, 0); PG8_LDB(B1, 0, 1); PG8_SCHED; PG8_LDA(At, 0, 0); PG8_STAGE(PG8_SA(1, 1), a1 + hstep, voffA);
            PG8_WAIT_V(8); PG8_WAIT_L(0); PG8_BAR; PG8_MMA(0, 0, At, B0); PG8_MMA(0, 1, At, B1); PG8_BAR; PG8_SCHED;
            PG8_LDA(At, 0, 1); PG8_STAGE(PG8_SB(0, 0), b2, voffB); PG8_STAGE(PG8_SB(0, 1), b2 + hstep, voffB); PG8_STAGE(PG8_SA(0, 0), a2, voffA);
            PG8_WAIT_V(8); PG8_WAIT_L(0); PG8_BAR; PG8_MMA(1, 0, At, B0); PG8_MMA(1, 1, At, B1); PG8_BAR; PG8_SCHED;
            PG8_LDB(B0, 1, 0); PG8_LDB(B1, 1, 1); PG8_SCHED; PG8_LDA(At, 1, 0); PG8_STAGE(PG8_SA(0, 1), a2 + hstep, voffA);
            PG8_WAIT_V(8); PG8_WAIT_L(0); PG8_BAR; PG8_MMA(0, 0, At, B0); PG8_MMA(0, 1, At, B1); PG8_BAR; PG8_SCHED;
            PG8_LDA(At, 1, 1); PG8_STAGE(PG8_SB(1, 0), b3, voffB); PG8_STAGE(PG8_SB(1, 1), b3 + hstep, voffB); PG8_STAGE(PG8_SA(1, 0), a3, voffA);
            PG8_WAIT_V(8); PG8_WAIT_L(0); PG8_BAR; PG8_MMA(1, 0, At, B0); PG8_MMA(1, 1, At, B1); PG8_BAR; PG8_SCHED;
            } else {
            PG8_LDB(B0, 0, 0); PG8_SCHED; PG8_LDA(At, 0, 0); PG8_STAGE(PG8_SA(1, 1), a1 + hstep, voffA);
            PG8_WAIT_L(8); PG8_BAR; PG8_WAIT_L(0); PG8_MMA(0, 0, At, B0); PG8_BAR; PG8_SCHED;
            PG8_LDB(B1, 0, 1); PG8_STAGE(PG8_SB(0, 0), b2, voffB);
            PG8_BAR; PG8_WAIT_L(0); PG8_MMA(0, 1, At, B1); PG8_BAR;
            PG8_LDA(At, 0, 1); PG8_STAGE(PG8_SA(0, 0), a2, voffA);
            PG8_BAR; PG8_WAIT_L(0); PG8_MMA(1, 0, At, B0); PG8_BAR; PG8_SCHED;
            PG8_STAGE(PG8_SB(0, 1), b2 + hstep, voffB);
            PG8_WAIT_V(6); PG8_BAR; PG8_MMA(1, 1, At, B1); PG8_BAR;
            PG8_LDB(B0, 1, 0); PG8_SCHED; PG8_LDA(At, 1, 0); PG8_STAGE(PG8_SA(0, 1), a2 + hstep, voffA);
            PG8_WAIT_L(8); PG8_BAR; PG8_WAIT_L(0); PG8_MMA(0, 0, At, B0); PG8_BAR; PG8_SCHED;
            PG8_LDB(B1, 1, 1); PG8_STAGE(PG8_SB(1, 0), b3, voffB);
            PG8_BAR; PG8_WAIT_L(0); PG8_MMA(0, 1, At, B1); PG8_BAR;
            PG8_LDA(At, 1, 1); PG8_STAGE(PG8_SA(1, 0), a3, voffA);
            PG8_BAR; PG8_WAIT_L(0); PG8_MMA(1, 0, At, B0); PG8_BAR; PG8_SCHED;
            PG8_STAGE(PG8_SB(1, 1), b3 + hstep, voffB);
            PG8_WAIT_V(6); PG8_BAR; PG8_MMA(1, 1, At, B1); PG8_BAR;
            }
        }
        if constexpr (ALIGN_EPI) { if (wr == 0) PG8_BAR; }
        if constexpr (!Epi::AFTER_DRAIN) { E(acc, cur, wr, wc, fr, fq); S.done(cur); }
        if (!has_next) break;
#pragma unroll
        for (int a = 0; a < 2; ++a)
#pragma unroll
            for (int b = 0; b < 2; ++b)
#pragma unroll
                for (int m = 0; m < 4; ++m)
#pragma unroll
                    for (int n = 0; n < 2; ++n) acc[a][b][m][n] = (f32x4){0.f, 0.f, 0.f, 0.f};
        cur = nxt; cA = nA; cB = nB; ++ui;
        if constexpr (ALIGN_EPI) { if (wr == 1) PG8_BAR; }
    }
    PG8_WAIT_V(0);
    if constexpr (!ALIGN_EPI) { if (wr == 0) PG8_BAR; }
    PG8_BAR;
    if constexpr (Epi::AFTER_DRAIN) { E.fused(acc, cur, wr, wc, fr, fq, lds, wid, lane); S.done(cur); }
#undef PG8_SA
#undef PG8_SB
#undef PG8_STAGE
#undef PG8_LDA
#undef PG8_LDB
#undef PG8_MMA
#undef PG8_WAIT_V
#undef PG8_WAIT_L
#undef PG8_BAR
#undef PG8_SCHED
}
}
#define XB_TMO      128
#define XB_XCNT(j)  (256  + 64 * (j))
#define XB_XSUB(j)  (1280 + 64 * (j))
#define XB_XGEN(j)  (2304 + 64 * (j))
#define XB_TOP      3328
#define XB_TOPGEN   3392
#define XCD_BAR_WORDS 3456
#define XB_SPIN_CAP (1u << 18)

__device__ __forceinline__ unsigned xb_ld(unsigned* p)              { return __hip_atomic_load(p, __ATOMIC_RELAXED, __HIP_MEMORY_SCOPE_AGENT); }
__device__ __forceinline__ unsigned xb_add(unsigned* p, unsigned v) { return __hip_atomic_fetch_add(p, v, __ATOMIC_RELAXED, __HIP_MEMORY_SCOPE_AGENT); }
__device__ __forceinline__ unsigned xb_xcc_id() { return (unsigned)__builtin_amdgcn_s_getreg((3 << 11) | 20) & 0xFu; }
#define XB_SPIN(cond, bar) do { unsigned _sp = 0; while (cond) { __builtin_amdgcn_s_sleep(1); \
    if ((++_sp & 255u) == 0u) { if (xb_ld(&(bar)[XB_TMO])) break; if (_sp > XB_SPIN_CAP) { atomicAdd(&(bar)[XB_TMO], 1u); break; } } } } while (0)

struct XcdBarrier {
    unsigned* bar; unsigned x;
    volatile LAS unsigned* st;
};

__device__ __forceinline__ XcdBarrier xcd_barrier_post(unsigned* bar, volatile LAS unsigned* st) {
    XcdBarrier b; b.bar = bar; b.x = xb_xcc_id(); b.st = st;
    if (threadIdx.x == 0) (void)xb_add(&bar[XB_XCNT(b.x)], 1u);
    return b;
}
__device__ __forceinline__ void xcd_barrier_complete(unsigned* bar, unsigned x, unsigned& nloc, unsigned& nx) {
    const unsigned G = gridDim.x * gridDim.y * gridDim.z;
    unsigned sum, cnt, mine, sp = 0u;
    for (;;) {
        sum = 0u; cnt = 0u; mine = 0u;
#pragma unroll
        for (unsigned j = 0; j < 16; ++j) { const unsigned c = xb_ld(&bar[XB_XCNT(j)]); sum += c; cnt += (c > 0u) ? 1u : 0u; mine = (j == x) ? c : mine; }
        if (sum == G) break;
        __builtin_amdgcn_s_sleep(1);
        if ((++sp & 255u) == 0u) { if (xb_ld(&bar[XB_TMO])) break; if (sp > XB_SPIN_CAP) { atomicAdd(&bar[XB_TMO], 1u); break; } }
    }
    nloc = mine > 0u ? mine : 1u; nx = cnt > 0u ? cnt : 1u;
}

__device__ __forceinline__ void xcd_barrier(const XcdBarrier& b) {
    asm volatile("s_waitcnt vmcnt(0)" ::: "memory");
    __syncthreads();
    if (threadIdx.x == 0) {
        unsigned* bar = b.bar;
        __builtin_amdgcn_s_waitcnt(0);
        unsigned nloc = b.st[0], nx = b.st[1];
        if (nloc == 0u) { xcd_barrier_complete(bar, b.x, nloc, nx); b.st[0] = nloc; b.st[1] = nx; }
        const unsigned old = xb_add(&bar[XB_XSUB(b.x)], 1u);
        const unsigned gen = old / nloc;
        if (old + 1u == (gen + 1u) * nloc) {
            __builtin_amdgcn_fence(__ATOMIC_RELEASE, "agent");
            asm volatile("s_waitcnt vmcnt(0)" ::: "memory");
            const unsigned og = xb_add(&bar[XB_TOP], 1u);
            const unsigned tg = og / nx;
            if (og + 1u == (tg + 1u) * nx) xb_add(&bar[XB_TOPGEN], 1u);
            else XB_SPIN(xb_ld(&bar[XB_TOPGEN]) == tg, bar);
            __builtin_amdgcn_fence(__ATOMIC_ACQUIRE, "agent");
            xb_add(&bar[XB_XGEN(b.x)], 1u);
            asm volatile("s_waitcnt vmcnt(0)" ::: "memory");
        } else {
            XB_SPIN(xb_ld(&bar[XB_XGEN(b.x)]) == gen, bar);
            __builtin_amdgcn_fence(__ATOMIC_ACQUIRE, "agent");
            asm volatile("s_waitcnt vmcnt(0)" ::: "memory");
        }
    }
    __syncthreads();
}

template <bool CONVPERM = false>
DI void p0_transpose_item(const float* W, int K, int ldw, int ncols, bf16* WT, LAS float* scr, int item, int lane, const float* rowscale = nullptr) {
    const int nblk = ncols / 32, kb = item / nblk, nb = item % nblk, k0 = 64 * kb, n0 = 32 * nb;
#pragma unroll 8
    for (int i = 0; i < 32; ++i) { const int kk = 2 * i + (lane >> 5); float wv = W[(size_t)(k0 + kk) * ldw + n0 + (lane & 31)]; if (rowscale != nullptr) wv *= rowscale[k0 + kk];
        scr[kk * 33 + (lane & 31)] = wv; }
    asm volatile("s_waitcnt lgkmcnt(0)" ::: "memory");
    const int c = lane & 7;
#pragma unroll
    for (int j = 0; j < 4; ++j) { const int n = (lane >> 3) + 8 * j; const LAS float* s = scr + (8 * c) * 33 + n;
        v4u o; o.x = pk2(s[0 * 33], s[1 * 33]); o.y = pk2(s[2 * 33], s[3 * 33]); o.z = pk2(s[4 * 33], s[5 * 33]); o.w = pk2(s[6 * 33], s[7 * 33]);
        int orow = n0 + n;
        if constexpr (CONVPERM) { const int sct = orow >> 10, ch = orow & 1023;
            orow = 256 * (ch >> 6) + 128 * (sct >> 1) + 32 * ((ch >> 4) & 3) + 8 * ((ch >> 2) & 3) + 4 * (sct & 1) + (ch & 3); }
        *(v4u*)(WT + (size_t)orow * K + k0 + 8 * c) = o; }
    asm volatile("s_waitcnt lgkmcnt(0)" ::: "memory");
}

struct Ptrs {
    const float* in[19]; float* out; unsigned char* ws; int ph_lo, ph_hi;
};

DI void p0_prologue(const Ptrs& P, LAS unsigned char* lds, int gw, int NGW, int wave, int lane) {
    LAS float* scr = (LAS float*)(lds + wave * 16384);
    unsigned char* ws = P.ws;
    constexpr int I_IN = 16 * 128, I_OUT = 16 * 32, I_SWA = 16 * 80;
    constexpr int NIT = 3 * I_IN + I_SWA + 4 * I_OUT;
    for (int it = gw; it < NIT; it += NGW) {
        int r = it;
        if (r < I_IN) { p0_transpose_item<true>(P.in[4], 1024, 4096, 4096, (bf16*)(ws + WS_W0I), scr, r, lane); continue; } r -= I_IN;
        if (r < I_IN) { p0_transpose_item(P.in[7], 1024, 4104, 4096, (bf16*)(ws + WS_W1I), scr, r, lane); continue; } r -= I_IN;
        if (r < I_IN) { p0_transpose_item(P.in[10], 1024, 4112, 4096, (bf16*)(ws + WS_W2I), scr, r, lane); continue; } r -= I_IN;
        if (r < I_SWA) { p0_transpose_item(P.in[16], 1024, 2560, 2560, (bf16*)(ws + WS_W3I), scr, r, lane, P.in[2] + 3072); continue; } r -= I_SWA;
        if (r < I_OUT) { p0_transpose_item(P.in[6], 1024, 1024, 1024, (bf16*)(ws + WS_W0O), scr, r, lane); continue; } r -= I_OUT;
        if (r < I_OUT) { p0_transpose_item(P.in[9], 1024, 1024, 1024, (bf16*)(ws + WS_W1O), scr, r, lane); continue; } r -= I_OUT;
        if (r < I_OUT) { p0_transpose_item(P.in[15], 1024, 1024, 1024, (bf16*)(ws + WS_W2O), scr, r, lane); continue; } r -= I_OUT;
        p0_transpose_item(P.in[18], 1024, 1024, 1024, (bf16*)(ws + WS_W3O), scr, r, lane);
    }
}

template <int MODE, bool XBF = false>
DI void norm_phase(const float* X, const float* nw, bf16* H, float* OUTF, const float* W, int ldw, float* oa, float* ob, const float* p0, const float* p1, const float* p2,
                   const int* pos, LAS unsigned char* lds, int gw, int NGW, int tid, int lane) {
    constexpr int NT = (MODE == 1) ? 8 : (MODE == 2 ? 16 : 0);
    LAS f32x4* thin = (LAS f32x4*)lds;
    if constexpr (NT > 0) {
        for (int i = tid; i < 1024 * (NT / 4); i += NTHR) { const int k = i / (NT / 4), c4 = i % (NT / 4);
            const f32x4 v = *(const f32x4*)(W + (size_t)k * ldw + 4096 + 4 * c4);
            const int j = k >> 8, l = (k & 255) >> 2, e = k & 3;
            thin[c4 * 1024 + (j * 4 + e) * 64 + l] = v; }
        __syncthreads();
    }
    constexpr int NR = (NT == 16) ? 2 : 4;
    f32x4 nwv[4];
#pragma unroll
    for (int j = 0; j < 4; ++j) nwv[j] = *((const f32x4*)nw + lane + 64 * j);
    for (int row0 = gw * NR; row0 < TT; row0 += NGW * NR) {
        f32x4 vv[NR][4];
#pragma unroll
        for (int rr = 0; rr < NR; ++rr) {
            if constexpr (XBF) { const v2u* xr = (const v2u*)((const bf16*)X + (size_t)(row0 + rr) * DM) + lane;
#pragma unroll
                for (int j = 0; j < 4; ++j) { const v2u u = xr[64 * j]; vv[rr][j] = (f32x4){bflo(u.x), bfhi(u.x), bflo(u.y), bfhi(u.y)}; } }
            else { const f32x4* xr = (const f32x4*)(X + (size_t)(row0 + rr) * DM) + lane;
#pragma unroll
                for (int j = 0; j < 4; ++j) vv[rr][j] = xr[64 * j]; } }
#pragma unroll
        for (int rr = 0; rr < NR; ++rr) {
        const int row = row0 + rr;
        f32x4 v[4]; float s = 0.f;
#pragma unroll
        for (int j = 0; j < 4; ++j) { v[j] = vv[rr][j]; s += (v[j].x * v[j].x + v[j].y * v[j].y) + (v[j].z * v[j].z + v[j].w * v[j].w); }
        const float r = rsqrtf(wave_sum(s) * (1.f / DM) + EPS);
#pragma unroll
        for (int j = 0; j < 4; ++j) { v[j] = v[j] * r * nwv[j]; vv[rr][j] = v[j]; }
        if constexpr (MODE == 4) {
            f32x4* o = (f32x4*)(OUTF + (size_t)row * DM) + lane;
#pragma unroll
            for (int j = 0; j < 4; ++j) o[64 * j] = v[j];
        } else {
            unsigned long long* o8 = (unsigned long long*)(H + (size_t)row * DM) + lane;
#pragma unroll
            for (int j = 0; j < 4; ++j) o8[64 * j] = (unsigned long long)pk2(v[j].x, v[j].y) | ((unsigned long long)pk2(v[j].z, v[j].w) << 32);
        }
        if constexpr (MODE == 3) {
            if (lane < 32) { const float inv = powf(10000.f, -(float)lane * (1.f / 32.f)); const float ang = (float)pos[row] * inv; float sn, cs; sincosf(ang, &sn, &cs);
                oa[(size_t)row * 64 + lane] = cs; oa[(size_t)row * 64 + 32 + lane] = sn; }
        }
        }
        if constexpr (NT > 0) {
            constexpr int RG = (NT == 16) ? 1 : NR;
#pragma unroll
            for (int r0 = 0; r0 < NR; r0 += RG) {
            f32x4 a[RG][NT / 4];
#pragma unroll
            for (int rr = 0; rr < RG; ++rr)
#pragma unroll
                for (int c = 0; c < NT / 4; ++c) a[rr][c] = (f32x4){0.f, 0.f, 0.f, 0.f};
#pragma unroll
            for (int j = 0; j < 4; ++j)
#pragma unroll
                for (int e = 0; e < 4; ++e) {
#pragma unroll
                    for (int c = 0; c < NT / 4; ++c) { const f32x4 w = thin[c * 1024 + (j * 4 + e) * 64 + lane];
#pragma unroll
                        for (int rr = 0; rr < RG; ++rr) a[rr][c] += w * vv[r0 + rr][j][e]; }
                    __builtin_amdgcn_sched_barrier(0); }
#pragma unroll
            for (int rr = 0; rr < RG; ++rr) {
                const int row = row0 + r0 + rr;
                float t8[NT / 2];
#pragma unroll
                for (int i = 0; i < NT / 2; ++i) { const float x0 = a[rr][(2 * i) >> 2][(2 * i) & 3], x1 = a[rr][(2 * i + 1) >> 2][(2 * i + 1) & 3];
                    const bool bb = lane & 1; const float mine = bb ? x1 : x0, send = bb ? x0 : x1; t8[i] = mine + __shfl_xor(send, 1); }
                float t4[NT / 4];
#pragma unroll
                for (int i = 0; i < NT / 4; ++i) { const bool bb = lane & 2; const float mine = bb ? t8[2 * i + 1] : t8[2 * i], send = bb ? t8[2 * i] : t8[2 * i + 1]; t4[i] = mine + __shfl_xor(send, 2); }
                float t2[NT / 8];
#pragma unroll
                for (int i = 0; i < NT / 8; ++i) { const bool bb = lane & 4; const float mine = bb ? t4[2 * i + 1] : t4[2 * i], send = bb ? t4[2 * i] : t4[2 * i + 1]; t2[i] = mine + __shfl_xor(send, 4); }
                float tc;
                if constexpr (NT == 16) { const bool bb = lane & 8; const float mine = bb ? t2[1] : t2[0], send = bb ? t2[0] : t2[1]; tc = mine + __shfl_xor(send, 8); }
                else { tc = t2[0]; tc += __shfl_xor(tc, 8); }
                tc += __shfl_xor(tc, 16); tc += __shfl_xor(tc, 32);
                if constexpr (MODE == 1) {
                    if (lane < 8) { const float xx = tc + p0[lane]; oa[(size_t)row * 8 + lane] = fminf(xx, 0.f) - log1pf(__expf(-fabsf(xx))); }
                } else {
                    const float ma = __shfl(tc, (lane + 8) & 63);
                    if (lane < 8) { oa[(size_t)row * 8 + lane] = 1.f / (1.f + __expf(-tc));
                        ob[(size_t)row * 8 + lane] = -__expf(p0[lane]) * softplus_f(ma + p1[lane]); }
                }
            }
            }
        }
    }
    if constexpr (NT > 0) __syncthreads();
}

DI void convgate_phase(const bf16* PROJ, const float* wconv, bf16* Y, int gtid, int NG) {
    for (int it = gtid; it < (TT / 32) * 128; it += NG) {
        const int oct = it & 127, chunk = it >> 7, r0 = chunk * 32, c0 = oct * 8;
        float w0[8], w1[8], w2[8];
#pragma unroll
        for (int e = 0; e < 8; ++e) { w0[e] = wconv[c0 + e]; w1[e] = wconv[1024 + c0 + e]; w2[e] = wconv[2048 + c0 + e]; }
        float p2[8], p1[8];
#pragma unroll
        for (int e = 0; e < 8; ++e) { p2[e] = 0.f; p1[e] = 0.f; }
        if ((r0 & (SEQ - 1)) != 0) {
#pragma unroll
            for (int d = 2; d >= 1; --d) { const bf16* rp = PROJ + (size_t)(r0 - d) * 4096 + c0;
                const v4u cc = *(const v4u*)(rp + 1024), vv = *(const v4u*)(rp + 2048);
#pragma unroll
                for (int e = 0; e < 4; ++e) { const float a = bflo(cc[e]) * bflo(vv[e]), b = bfhi(cc[e]) * bfhi(vv[e]);
                    if (d == 2) { p2[2 * e] = a; p2[2 * e + 1] = b; } else { p1[2 * e] = a; p1[2 * e + 1] = b; } } }
        }
#pragma unroll 4
        for (int r = 0; r < 32; ++r) {
            const bf16* rp = PROJ + (size_t)(r0 + r) * 4096 + c0;
            const v4u bb = *(const v4u*)(rp), cc = *(const v4u*)(rp + 1024), vv = *(const v4u*)(rp + 2048), zz = *(const v4u*)(rp + 3072);
            float y[8];
#pragma unroll
            for (int e = 0; e < 4; ++e) {
                const float cv0 = bflo(cc[e]) * bflo(vv[e]), cv1 = bfhi(cc[e]) * bfhi(vv[e]);
                const float o0 = w0[2 * e] * p2[2 * e] + w1[2 * e] * p1[2 * e] + w2[2 * e] * cv0;
                const float o1 = w0[2 * e + 1] * p2[2 * e + 1] + w1[2 * e + 1] * p1[2 * e + 1] + w2[2 * e + 1] * cv1;
                p2[2 * e] = p1[2 * e]; p1[2 * e] = cv0; p2[2 * e + 1] = p1[2 * e + 1]; p1[2 * e + 1] = cv1;
                y[2 * e] = bflo(bb[e]) * o0 * silu_f(bflo(zz[e])); y[2 * e + 1] = bfhi(bb[e]) * o1 * silu_f(bfhi(zz[e]));
            }
            v4u o; o.x = pk2(y[0], y[1]); o.y = pk2(y[2], y[3]); o.z = pk2(y[4], y[5]); o.w = pk2(y[6], y[7]);
            *(v4u*)(Y + (size_t)(r0 + r) * 1024 + c0) = o;
        }
    }
}

DI void convfix_phase(const float* CVH, const float* BND, const float* wconv, bf16* Y, int gtid, int NG) {
    for (int it = gtid; it < 512 * 2 * 256; it += NG) {
        const int c4 = it & 255, r = (it >> 8) & 1, g = it >> 9, ch0 = 4 * c4;
        const float* bp = BND + ((size_t)g * 2 + r) * 3 * 1024 + ch0;
        const f32x4 b = *(const f32x4*)bp, z = *(const f32x4*)(bp + 1024), cv = *(const f32x4*)(bp + 2048);
        f32x4 cm1 = (f32x4){0.f, 0.f, 0.f, 0.f}, cm2 = (f32x4){0.f, 0.f, 0.f, 0.f};
        const bool first = (g & 255) == 0;
        if (r == 0) { if (!first) { cm1 = *(const f32x4*)(CVH + ((size_t)(g - 1) * 2 + 1) * 1024 + ch0); cm2 = *(const f32x4*)(CVH + ((size_t)(g - 1) * 2) * 1024 + ch0); } }
        else { cm1 = *(const f32x4*)(BND + ((size_t)g * 2) * 3 * 1024 + 2048 + ch0); if (!first) cm2 = *(const f32x4*)(CVH + ((size_t)(g - 1) * 2 + 1) * 1024 + ch0); }
        const f32x4 w0 = *(const f32x4*)(wconv + ch0), w1 = *(const f32x4*)(wconv + 1024 + ch0), w2 = *(const f32x4*)(wconv + 2048 + ch0);
        float y[4];
#pragma unroll
        for (int e = 0; e < 4; ++e) y[e] = b[e] * (w0[e] * cm2[e] + w1[e] * cm1[e] + w2[e] * cv[e]) * silu_f(z[e]);
        v2u o; o.x = pk2(y[0], y[1]); o.y = pk2(y[2], y[3]);
        *(v2u*)(Y + ((size_t)g * 64 + r) * 1024 + ch0) = o;
    }
}
DI int crow32(int i, int hi) { return (i & 3) + 8 * (i >> 2) + 4 * hi; }
DI int perm16(int p) { return (p & 3) | ((p & 4) << 1) | ((p & 8) >> 1); }
#define MFMA32(a, b, c) __builtin_amdgcn_mfma_f32_32x32x16_bf16((a), (b), (c), 0, 0, 0)
#define MFMA16(a, b, c) __builtin_amdgcn_mfma_f32_16x16x32_bf16((a), (b), (c), 0, 0, 0)

DI void fox_cumsum(const float* LOGF, float* CUM, int bh, LAS unsigned char* lds, int tid) {
    LAS double* tot = (LAS double*)lds;
    const int b = bh >> 3, h = bh & 7;
    const float* src = LOGF + ((size_t)b * SEQ + 32 * tid) * 8 + h;
    float v[32]; double s = 0.0;
#pragma unroll
    for (int i = 0; i < 32; ++i) { v[i] = src[i * 8]; s += (double)v[i]; }
    double inc = s;
    const int ln = tid & 63, wv = tid >> 6;
#pragma unroll
    for (int o = 1; o < 64; o <<= 1) { const double t = __shfl_up(inc, o); if (ln >= o) inc += t; }
    if (ln == 63) tot[wv] = inc;
    __syncthreads();
    double pre = inc - s;
    for (int i = 0; i < wv; ++i) pre += tot[i];
    float* dst = CUM + (size_t)bh * SEQ + 32 * tid;
#pragma unroll
    for (int i = 0; i < 32; ++i) { pre += (double)v[i]; dst[i] = (float)pre; }
    __syncthreads();
}

DI void fox_norms_phase(const float* KP, float* NRMT, int gw, int NGW, int lane) {
    for (int it = gw; it < 16 * 256; it += NGW) {
        const int bh = it >> 8, tl = it & 255, b = bh >> 3, h = bh & 7;
        const size_t row = (size_t)b * SEQ + 64 * tl + lane;
        const f32x4 p = *(const f32x4*)(KP + (row * 8 + h) * 4);
        float mk = (p[0] + p[1]) + (p[2] + p[3]);
#pragma unroll
        for (int o = 1; o < 64; o <<= 1) mk = fmaxf(mk, __shfl_xor(mk, o));
        if (lane == 0) NRMT[(size_t)it * 2 + 1] = mk;
    }
}

constexpr int FX_KB = 64 * 272, FX_VB = 64 * 320;
typedef short v4i16_t __attribute__((ext_vector_type(4)));
DI v4i16_t fx_vtr(const LAS unsigned char* p) { return __builtin_amdgcn_ds_read_tr16_b64_v4i16((LAS v4i16_t*)p); }
DI void fox_attn_phase(const bf16* PROJ, const float* CUM, bf16* Y, const float* NRMT, unsigned* QCTR, LAS unsigned char* lds, int bid, int G, int tid, int wave, int lane) {
    LAS unsigned char* Kb = lds; LAS unsigned char* Vb = lds + 2 * FX_KB; LAS float* Bs = (LAS float*)(lds + 2 * FX_KB + 2 * FX_VB);
    const int r = lane & 31, hi = lane >> 5;
    const float SQD = 11.313708498984761f;
    const float c2 = 0.08838834764831845f * 1.4426950408889634f;
    LAS unsigned* Qs = (LAS unsigned*)(lds + 2 * FX_KB + 2 * FX_VB + 512);
    LAS float* Mq = (LAS float*)(lds + 2 * FX_KB + 2 * FX_VB + 704);
    LAS float* Ms = (LAS float*)(lds + 2 * FX_KB + 2 * FX_VB + 576);
    for (;;) {
        if (tid == 0) Qs[0] = atomicAdd(QCTR, 1u);
        __syncthreads();
        const int e = (int)Qs[0];
        __syncthreads();
        if (e >= 1024) break;
        {
            const int bh = e & 15, qb = 63 - (e >> 4), b = bh >> 3, h = bh & 7;
            const int q0 = qb * 256, ntiles = 4 * (qb + 1);
            const float cref = CUM[(size_t)bh * SEQ + q0];
            const int qmin = q0 + 32 * wave;
            bf16x8 Qf[8];
            { const bf16* qp = PROJ + ((size_t)b * SEQ + qmin + r) * 4096 + h * 128 + 8 * hi;
#pragma unroll
              for (int ks = 0; ks < 8; ++ks) Qf[ks] = *(const bf16x8*)(qp + 16 * ks); }
            { float qn = 0.f;
#pragma unroll
              for (int ks = 0; ks < 8; ++ks) { const v4u w = __builtin_bit_cast(v4u, Qf[ks]);
#pragma unroll
                  for (int e = 0; e < 4; ++e) qn += bflo(w[e]) * bflo(w[e]) + bfhi(w[e]) * bfhi(w[e]); }
              qn += __shfl_xor(qn, 32);
#pragma unroll
              for (int o = 1; o < 32; o <<= 1) qn = fmaxf(qn, __shfl_xor(qn, o));
              if (lane == 0) Mq[wave] = qn; }
            __syncthreads();
            int jstart; float Bq;
            { float mq = Mq[0], mk = 0.f;
#pragma unroll
              for (int w = 1; w < 8; ++w) mq = fmaxf(mq, Mq[w]);
#pragma unroll
              for (int u = 0; u < 4; ++u) mk = fmaxf(mk, NRMT[((size_t)bh * 256 + lane + 64 * u) * 2 + 1]);
#pragma unroll
              for (int o = 1; o < 64; o <<= 1) mk = fmaxf(mk, __shfl_xor(mk, o));
              Bq = sqrtf(mq * mk);
              const float B2 = 2.f * Bq * 0.08838834764831845f;
              const float thr = -(30.f + B2);
              const int jc = (lane * (4 * qb)) >> 6;
              const bool live = (qb == 0) ? true : ((cref - CUM[(size_t)bh * SEQ + 64 * jc + 63]) > thr);
              const unsigned long long m = __ballot(live);
              const int fl = (m == 0ull) ? 64 : (__ffsll((long long)m) - 1);
              const int pl = fl > 0 ? fl - 1 : 0;
              jstart = (qb == 0) ? 0 : ((pl * (4 * qb)) >> 6);
              jstart = __builtin_amdgcn_readfirstlane(jstart); }
            f32x16 O[4];
#pragma unroll
            for (int dt = 0; dt < 4; ++dt)
#pragma unroll
                for (int i = 0; i < 16; ++i) O[dt][i] = 0.f;
            float m_old = -INFINITY, lsum = 0.f;
            const bf16* kg[2]; const bf16* vg[2]; int klds[2], vlds[2];
#pragma unroll
            for (int u = 0; u < 2; ++u) { const int p = tid + 512 * u;
                kg[u] = PROJ + ((size_t)b * SEQ + (p >> 4)) * 4096 + 1024 + h * 128 + 8 * (p & 15); klds[u] = (p >> 4) * 272 + (p & 15) * 16;
                vg[u] = PROJ + ((size_t)b * SEQ + (p >> 4)) * 4096 + 2048 + h * 128 + 8 * (p & 15); vlds[u] = (p >> 4) * 320 + (p & 15) * 16; }
            v4u kr[2], vr[2]; float br = 0.f;
            const int jlast = ntiles - 1;
#pragma unroll
            for (int u = 0; u < 2; ++u) { kr[u] = *(const v4u*)(kg[u] + (size_t)jlast * 64 * 4096); vr[u] = *(const v4u*)(vg[u] + (size_t)jlast * 64 * 4096); }
            if (tid < 64) br = (cref - CUM[(size_t)bh * SEQ + jlast * 64 + tid]) * SQD;
#pragma unroll
            for (int u = 0; u < 2; ++u) { *(LAS v4u*)(Kb + (jlast & 1) * FX_KB + klds[u]) = kr[u]; *(LAS v4u*)(Vb + (jlast & 1) * FX_VB + vlds[u]) = vr[u]; }
            if (tid < 64) Bs[(jlast & 1) * 64 + tid] = br;
            __syncthreads();
            for (int j = jlast; j >= jstart; --j) {
                const int cur = j & 1, nxt = cur ^ 1;
                if (j > jstart) {
#pragma unroll
                    for (int u = 0; u < 2; ++u) { kr[u] = *(const v4u*)(kg[u] + (size_t)(j - 1) * 64 * 4096); vr[u] = *(const v4u*)(vg[u] + (size_t)(j - 1) * 64 * 4096); }
                    if (tid < 64) br = (cref - CUM[(size_t)bh * SEQ + (j - 1) * 64 + tid]) * SQD;
                }
                if (64 * j <= qmin + 31) {
                    LAS unsigned char* Kc = Kb + cur * FX_KB; LAS unsigned char* Vc = Vb + cur * FX_VB; LAS float* Bc = Bs + cur * 64;
                    f32x16 S[2];
#pragma unroll
                    for (int sub = 0; sub < 2; ++sub) {
#pragma unroll
                        for (int g = 0; g < 4; ++g) { const f32x4 bv = *(const LAS f32x4*)(Bc + 32 * sub + 8 * g + 4 * hi);
                            S[sub][4 * g] = bv.x; S[sub][4 * g + 1] = bv.y; S[sub][4 * g + 2] = bv.z; S[sub][4 * g + 3] = bv.w; }
#pragma unroll
                        for (int ks = 0; ks < 8; ++ks) { const bf16x8 a = *(const LAS bf16x8*)(Kc + (32 * sub + r) * 272 + (16 * ks + 8 * hi) * 2);
                            S[sub] = MFMA32(a, Qf[ks], S[sub]); }
                    }
                    if (64 * j + 63 > qmin) {
                        const int qi = qmin + r;
#pragma unroll
                        for (int sub = 0; sub < 2; ++sub)
#pragma unroll
                            for (int i = 0; i < 16; ++i) { const int key = 64 * j + 32 * sub + crow32(i, hi); if (key > qi) S[sub][i] = -INFINITY; }
                    }
                    float mx = S[0][0];
#pragma unroll
                    for (int i = 1; i < 16; ++i) mx = fmaxf(mx, S[0][i]);
#pragma unroll
                    for (int i = 0; i < 16; ++i) mx = fmaxf(mx, S[1][i]);
                    mx = fmaxf(mx, __shfl_xor(mx, 32));
                    const float m_new = fmaxf(m_old, mx);
                    const float alpha = __builtin_amdgcn_exp2f((m_old - m_new) * c2);
                    const float nm = -m_new * c2;
                    m_old = m_new;
                    float ps = 0.f;
#pragma unroll
                    for (int sub = 0; sub < 2; ++sub)
#pragma unroll
                        for (int i = 0; i < 16; ++i) { const float p = __builtin_amdgcn_exp2f(fmaf(S[sub][i], c2, nm)); S[sub][i] = p; ps += p; }
                    lsum = lsum * alpha + ps;
                    if (!__all(alpha == 1.f)) {
#pragma unroll
                        for (int dt = 0; dt < 4; ++dt)
#pragma unroll
                            for (int i = 0; i < 16; ++i) O[dt][i] *= alpha;
                    }
                    __builtin_amdgcn_sched_barrier(0);
                    bf16x8 Pf[4];
#pragma unroll
                    for (int kk = 0; kk < 4; ++kk) { const int sub = kk >> 1, s = kk & 1; v4u w;
                        w.x = pk2(S[sub][8 * s], S[sub][8 * s + 1]); w.y = pk2(S[sub][8 * s + 2], S[sub][8 * s + 3]);
                        w.z = pk2(S[sub][8 * s + 4], S[sub][8 * s + 5]); w.w = pk2(S[sub][8 * s + 6], S[sub][8 * s + 7]);
                        Pf[kk] = __builtin_bit_cast(bf16x8, w); }
#pragma unroll
                    for (int dt = 0; dt < 4; ++dt) { __builtin_amdgcn_sched_barrier(0);
#pragma unroll
                        for (int kk = 0; kk < 4; ++kk) {
                            const LAS unsigned char* vp = Vc + (16 * kk + 4 * hi + ((lane & 15) >> 2)) * 320 + 64 * dt + 32 * ((lane >> 4) & 1) + 8 * (lane & 3);
                            const v4i16_t lo = fx_vtr(vp), hi4 = fx_vtr(vp + 8 * 320);
                            const bf16x8 a = __builtin_shufflevector(lo, hi4, 0, 1, 2, 3, 4, 5, 6, 7);
                            O[dt] = MFMA32(a, Pf[kk], O[dt]); } }
                }
                { float mm = m_old;
#pragma unroll
                  for (int o = 1; o < 32; o <<= 1) mm = fminf(mm, __shfl_xor(mm, o));
                  if (lane == 0) Ms[cur * 8 + wave] = mm; }
                if (j > jstart) {
#pragma unroll
                    for (int u = 0; u < 2; ++u) { *(LAS v4u*)(Kb + nxt * FX_KB + klds[u]) = kr[u]; *(LAS v4u*)(Vb + nxt * FX_VB + vlds[u]) = vr[u]; }
                    if (tid < 64) Bs[nxt * 64 + tid] = br;
                }
                __syncthreads();
                if (j > jstart) { float mn = Ms[cur * 8];
#pragma unroll
                    for (int w = 1; w < 8; ++w) mn = fminf(mn, Ms[cur * 8 + w]);
                    if ((Bq + Bs[nxt * 64 + 63] - mn) * 0.08838834764831845f <= -30.f) break; }
            }
            const float lt = lsum + __shfl_xor(lsum, 32);
            const float inv = 1.f / lt;
            const size_t trow = (size_t)b * SEQ + qmin + r;
#pragma unroll
            for (int dt = 0; dt < 4; ++dt)
#pragma unroll
                for (int g = 0; g < 4; ++g) { const int d = 32 * dt + 8 * g + 4 * hi;
                    const v2u z = *(const v2u*)(PROJ + trow * 4096 + 3072 + h * 128 + d);
                    const float y0 = O[dt][4 * g] * inv * silu_f(bflo(z.x)), y1 = O[dt][4 * g + 1] * inv * silu_f(bfhi(z.x));
                    const float y2 = O[dt][4 * g + 2] * inv * silu_f(bflo(z.y)), y3 = O[dt][4 * g + 3] * inv * silu_f(bfhi(z.y));
                    v2u o; o.x = pk2(y0, y1); o.y = pk2(y2, y3);
                    *(v2u*)(Y + trow * 1024 + h * 128 + d) = o; }
        }
    }
}
DI int kperm(int s, int q, int jj) { return 32 * s + 16 * (jj >> 2) + 4 * q + (jj & 3); }
DI bf16x8 pack_acc2(const f32x4& X, const f32x4& Y) { v4u w; w.x = pk2(X[0], X[1]); w.y = pk2(X[2], X[3]); w.z = pk2(Y[0], Y[1]); w.w = pk2(Y[2], Y[3]); return __builtin_bit_cast(bf16x8, w); }

DI void st16_wt(void* p, v4u v) {
    __hip_atomic_store((unsigned long long*)p, (unsigned long long)v.x | ((unsigned long long)v.y << 32), __ATOMIC_RELAXED, __HIP_MEMORY_SCOPE_AGENT);
    __hip_atomic_store((unsigned long long*)p + 1, (unsigned long long)v.z | ((unsigned long long)v.w << 32), __ATOMIC_RELAXED, __HIP_MEMORY_SCOPE_AGENT);
}
template <bool DRY>
DI void gdn_prep_phase(bf16* PROJ, bf16* DRYBUF, const bf16* HALO, const float* wconv, const float* BETA, const float* GG, unsigned char* EX, float* GL, unsigned* FLAG,
                       LAS unsigned char* lds, int bid, int G, int FIRST, int tid, int wave, int lane) {
    LAS bf16* QB = (LAS bf16*)lds; LAS bf16* KB = (LAS bf16*)(lds + 17408); LAS bf16* VBt = (LAS bf16*)(lds + 34816);
    LAS float* Lm = (LAS float*)(lds + 52224); LAS float* Tm = (LAS float*)(lds + 68864); LAS float* QKm = (LAS float*)(lds + 85504);
    LAS float* gcS = (LAS float*)(lds + 102144); LAS float* btS = (LAS float*)(lds + 102400); LAS float* Mt = (LAS float*)(lds + 102656);
    for (int e0 = bid - FIRST; e0 < 4096; e0 += G - FIRST) {
        const int bh = e0 & 15, n = e0 >> 4, it = bh * 256 + n, b = bh >> 3, h = bh & 7;
        const size_t t0 = (size_t)b * SEQ + 64 * n;
        if (tid < 64) { float gv = GG[(t0 + tid) * 8 + h]; btS[tid] = BETA[(t0 + tid) * 8 + h];
#pragma unroll
            for (int o = 1; o < 64; o <<= 1) { const float tv = __shfl_up(gv, o); if (lane >= o) gv += tv; }
            gcS[tid] = gv; }
        for (int e = tid; e < 6 * 256; e += NTHR) { const int bq = e >> 8, r = (e >> 4) & 15, c = e & 15;
            const int bi = (bq < 3) ? 0 : (bq < 5 ? 1 : 2), bj = (bq < 3) ? bq + 1 : (bq < 5 ? bq - 1 : 3);
            Tm[(16 * bi + r) * 65 + 16 * bj + c] = 0.f; }
#pragma unroll 3
        for (int st = 0; st < 6; ++st) {
            const int idx = wave * 6 + st, mat = idx >> 4, rg = idx & 15;
            const int row = 4 * rg + (lane >> 4), oct = lane & 15, colg = mat * 1024 + h * 128 + 8 * oct;
            float a[8];
#pragma unroll
            for (int e = 0; e < 8; ++e) a[e] = 0.f;
#pragma unroll
            for (int kk = 0; kk < 4; ++kk) {
                const int rr = row - 3 + kk;
                v4u v = (v4u){0u, 0u, 0u, 0u};
                if (rr >= 0) v = *(const v4u*)(PROJ + (t0 + rr) * 4096 + colg);
                else if (n > 0) v = *(const v4u*)(HALO + ((size_t)(b * 256 + n - 1) * 3 + (rr + 3)) * 3072 + colg);
                const f32x4 w0 = *(const f32x4*)(wconv + kk * 3072 + colg), w1 = *(const f32x4*)(wconv + kk * 3072 + colg + 4);
                a[0] += w0.x * bflo(v.x); a[1] += w0.y * bfhi(v.x); a[2] += w0.z * bflo(v.y); a[3] += w0.w * bfhi(v.y);
                a[4] += w1.x * bflo(v.z); a[5] += w1.y * bfhi(v.z); a[6] += w1.z * bflo(v.w); a[7] += w1.w * bfhi(v.w);
            }
            float ss = 0.f;
#pragma unroll
            for (int e = 0; e < 8; ++e) { a[e] = silu_f(a[e]); ss += a[e] * a[e]; }
            ss += __shfl_xor(ss, 1); ss += __shfl_xor(ss, 2); ss += __shfl_xor(ss, 4); ss += __shfl_xor(ss, 8);
            float rs = 1.f;
            if (mat == 0) rs = rsqrtf(ss + EPS) * 0.08838834764831845f; else if (mat == 1) rs = rsqrtf(ss + EPS);
            v4u o; o.x = pk2(a[0] * rs, a[1] * rs); o.y = pk2(a[2] * rs, a[3] * rs); o.z = pk2(a[4] * rs, a[5] * rs); o.w = pk2(a[6] * rs, a[7] * rs);
            LAS bf16* dst = (mat == 0 ? QB : (mat == 1 ? KB : VBt)) + row * 136 + 8 * oct;
            *(LAS v4u*)dst = o;
        }
        __syncthreads();
        { const int isq = wave >> 2, m = wave & 3, r16 = lane & 15, q = lane >> 4;
          LAS bf16* As = isq ? QB : KB;
          bf16x8 af[4];
#pragma unroll
          for (int s = 0; s < 4; ++s) af[s] = *(const LAS bf16x8*)(As + (16 * m + r16) * 136 + 32 * s + 8 * q);
#pragma unroll
          for (int nt = 0; nt < 4; ++nt) { f32x4 acc = (f32x4){0.f, 0.f, 0.f, 0.f};
#pragma unroll
              for (int s = 0; s < 4; ++s) { const bf16x8 bfr = *(const LAS bf16x8*)(KB + (16 * nt + r16) * 136 + 32 * s + 8 * q); acc = MFMA16(af[s], bfr, acc); }
#pragma unroll
              for (int jj = 0; jj < 4; ++jj) { const int i = 16 * m + 4 * q + jj, j = 16 * nt + r16;
                  const float dec = __expf(fminf(gcS[i] - gcS[j], 0.f));
                  if (!isq) Lm[i * 65 + j] = (i > j) ? acc[jj] * btS[i] * dec : 0.f;
                  else QKm[i * 65 + j] = (i >= j) ? acc[jj] * dec : 0.f; } }
        }
        __syncthreads();
        const float gl = gcS[63];
        if (wave == 0) {
            const int blk = lane >> 4, col = lane & 15; const LAS float* Lb = Lm + (16 * blk) * 65 + 16 * blk;
            float t[16];
#pragma unroll
            for (int r = 0; r < 16; ++r) { float a = (r == col) ? 1.f : 0.f;
#pragma unroll
                for (int x = 0; x < r; ++x) a -= Lb[r * 65 + x] * t[x];
                t[r] = a; }
#pragma unroll
            for (int r = 0; r < 16; ++r) Tm[(16 * blk + r) * 65 + 16 * blk + col] = t[r];
        } else {
#pragma unroll 1
            for (int p0 = tid - 64; p0 < 4608; p0 += 448) {
                const int sect = p0 >> 10, p = p0 & 1023, l = p & 63, f = p >> 6, q = l >> 4, r16 = l & 15;
                v4u o;
                bf16* dst;
                if (sect < 2) {
                    const int m = f >> 2, s = f & 3, i = 16 * m + r16, c0 = 32 * s + 4 * q;
                    LAS bf16* src = (sect == 0 ? QB : KB) + i * 136 + c0;
                    const v2u x0 = *(const LAS v2u*)src, x1 = *(const LAS v2u*)(src + 16);
                    const float eg = __expf(gcS[i]); const float sc = (sect == 0) ? eg : -btS[i] * eg;
                    o.x = pk2(bflo(x0.x) * sc, bfhi(x0.x) * sc); o.y = pk2(bflo(x0.y) * sc, bfhi(x0.y) * sc);
                    o.z = pk2(bflo(x1.x) * sc, bfhi(x1.x) * sc); o.w = pk2(bflo(x1.y) * sc, bfhi(x1.y) * sc);
                    dst = PROJ + (t0 + (p >> 4)) * 4096 + (sect == 0 ? 0 : 1024) + h * 128 + (p & 15) * 8;
                } else if (sect == 2) {
                    const int w = p >> 7, ll = (p & 127) >> 1, half = p & 1; float y[8];
#pragma unroll
                    for (int jj = 0; jj < 8; ++jj) { const int m = half * 2 + (jj >> 2), rowi = 16 * m + 4 * (ll >> 4) + (jj & 3);
                        y[jj] = bf2f(VBt[rowi * 136 + 16 * w + (ll & 15)]) * btS[rowi]; }
                    o.x = pk2(y[0], y[1]); o.y = pk2(y[2], y[3]); o.z = pk2(y[4], y[5]); o.w = pk2(y[6], y[7]);
                    dst = PROJ + (t0 + (p >> 4)) * 4096 + 2048 + h * 128 + (p & 15) * 8;
                } else if (sect == 3) {
                    const int m8 = f >> 1, s = f & 1, dk = 16 * m8 + r16; float y[8];
#pragma unroll
                    for (int jj = 0; jj < 8; ++jj) { const int i = kperm(s, q, jj); y[jj] = bf2f(KB[i * 136 + dk]) * __expf(gl - gcS[i]); }
                    o.x = pk2(y[0], y[1]); o.y = pk2(y[2], y[3]); o.z = pk2(y[4], y[5]); o.w = pk2(y[6], y[7]);
                    dst = (bf16*)(EX + (size_t)it * 32768 + p * 16);
                } else {
                    const int m = f >> 1, s = f & 1, i = 16 * m + r16; float y[8];
#pragma unroll
                    for (int jj = 0; jj < 8; ++jj) y[jj] = QKm[i * 65 + kperm(s, q, jj)];
                    o.x = pk2(y[0], y[1]); o.y = pk2(y[2], y[3]); o.z = pk2(y[4], y[5]); o.w = pk2(y[6], y[7]);
                    dst = (bf16*)(EX + (size_t)it * 32768 + 24576 + p * 16);
                }
                if (DRY) { dst = DRYBUF + (size_t)(it & 255) * 40960 + p0 * 8; *(v4u*)dst = o; } else st16_wt(dst, o);
            }
        }
        __syncthreads();
#pragma unroll 1
        for (int d = 1; d <= 3; ++d) {
            const int nel = (4 - d) * 256;
            for (int e = tid; e < nel; e += NTHR) { const int bj = e >> 8, r = (e >> 4) & 15, c = e & 15, bi = bj + d;
                const LAS float* Lr = Lm + (16 * bi + r) * 65; const LAS float* Tc = Tm + 16 * bj + c; float a = 0.f;
#pragma unroll 16
                for (int y = 16 * bj; y < 16 * bi; ++y) a += Lr[y] * Tc[y * 65];
                Mt[(16 * bi + r) * 65 + 16 * bj + c] = a; }
            __syncthreads();
            for (int e = tid; e < nel; e += NTHR) { const int bj = e >> 8, r = (e >> 4) & 15, c = e & 15, bi = bj + d;
                const LAS float* Dr = Tm + (16 * bi + r) * 65 + 16 * bi; const LAS float* Mc = Mt + (16 * bi) * 65 + 16 * bj + c; float a = 0.f;
#pragma unroll
                for (int x = 0; x < 16; ++x) a += Dr[x] * Mc[x * 65];
                Tm[(16 * bi + r) * 65 + 16 * bj + c] = -a; }
            __syncthreads();
        }
        { const int p = tid, l = p & 63, f = p >> 6, q = l >> 4, r16 = l & 15, m = f >> 1, s = f & 1, i = 16 * m + r16; float y[8];
#pragma unroll
          for (int jj = 0; jj < 8; ++jj) y[jj] = Tm[i * 65 + kperm(s, q, jj)];
          v4u o; o.x = pk2(y[0], y[1]); o.y = pk2(y[2], y[3]); o.z = pk2(y[4], y[5]); o.w = pk2(y[6], y[7]);
          if (DRY) *(v4u*)(DRYBUF + (size_t)(it & 255) * 40960 + 36864 + p * 8) = o; else st16_wt(EX + (size_t)it * 32768 + 16384 + p * 16, o);
          if (tid == 0 && !DRY) __hip_atomic_store(GL + it, __expf(gl), __ATOMIC_RELAXED, __HIP_MEMORY_SCOPE_AGENT); }
        asm volatile("s_waitcnt vmcnt(0)" ::: "memory");
        __syncthreads();
        if (tid == 0 && !DRY) __hip_atomic_store(FLAG + it, 1u, __ATOMIC_RELAXED, __HIP_MEMORY_SCOPE_AGENT);
    }
}

constexpr int GS_BUF = 69632;
DI void gdn_scan_phase(const bf16* PROJ, const unsigned char* EX, const float* GL, const unsigned* FLAG, bf16* ORAW, LAS unsigned char* lds, int bid, int tid, int wave, int lane) {
    if (bid >= 64) return;
    const int bh = bid >> 2, sub = bid & 3, b = bh >> 3, h = bh & 7, q = lane >> 4, r16 = lane & 15;
    LAS unsigned char* OB = lds + 2 * GS_BUF;
    LAS float* GLs = (LAS float*)(lds + 2 * GS_BUF + 8192);
    if (wave >= 2) {
        const int g = (wave - 2) >> 1, i = tid & 127, rowi = i >> 4, pc = i & 15;
        v4u R0[12], R1[12], R2[12]; float G0, G1, G2;
#define GS_LD(R_, G_, n_) do { G_ = GL[bh * 256 + (n_)]; const size_t t0_ = (size_t)b * SEQ + 64 * (n_); const unsigned char* ex_ = EX + (size_t)(bh * 256 + (n_)) * 32768; \
        _Pragma("unroll") for (int u = 0; u < 12; ++u) { int k = g + 3 * u; k = k < 34 ? k : 33; \
            const unsigned char* base_; size_t stride_; \
            if (k < 8) { base_ = (const unsigned char*)(PROJ + (t0_ + 8 * k) * 4096 + 1024 + h * 128); stride_ = 8192; } \
            else if (k < 16) { base_ = (const unsigned char*)(PROJ + (t0_ + 8 * (k - 8)) * 4096 + h * 128); stride_ = 8192; } \
            else if (k < 32) { base_ = ex_ + (size_t)(k - 16) * 2048; stride_ = 256; } \
            else { base_ = (const unsigned char*)(PROJ + (t0_ + 8 * (2 * sub + (k - 32))) * 4096 + 2048 + h * 128); stride_ = 8192; } \
            R_[u] = *(const v4u*)(base_ + (size_t)rowi * stride_ + pc * 16); } } while (0)
#define GS_ST(R_, G_, n_, buf_) do { if (g == 0 && i == 0) GLs[(n_)] = G_; _Pragma("unroll") for (int u = 0; u < 12; ++u) { const int k = g + 3 * u; if (k < 34) *(LAS v4u*)((buf_) + k * 2048 + i * 16) = R_[u]; } } while (0)
#define GS_OUT(n_) do { if (g == 2) { const size_t t0_ = (size_t)b * SEQ + 64 * (n_); \
        _Pragma("unroll") for (int u = 0; u < 2; ++u) { const int p = i + 128 * u, row = p >> 2, c = p & 3; \
            const v4u v = *(const LAS v4u*)(OB + ((n_) & 1) * 4096 + row * 64 + c * 16); \
            *(v4u*)(ORAW + (t0_ + row) * 1024 + h * 128 + 32 * sub + 8 * c) = v; } } } while (0)
        __syncthreads();
        GS_LD(R0, G0, 0); GS_LD(R1, G1, 1); GS_LD(R2, G2, 2);
        GS_ST(R0, G0, 0, lds);
        __syncthreads();
#define GS_STEP(n_, Rst_, Gst_, Rld_, Gld_) do { if ((n_) < 256) { if ((n_) + 3 < 256) GS_LD(Rld_, Gld_, (n_) + 3); if ((n_) >= 1) GS_OUT((n_) - 1); \
            if ((n_) + 1 < 256) GS_ST(Rst_, Gst_, (n_) + 1, lds + (((n_) + 1) & 1) * GS_BUF); __syncthreads(); } } while (0)
#pragma unroll 1
        for (int n = 0; n < 258; n += 3) {
            GS_STEP(n, R1, G1, R0, G0);
            GS_STEP(n + 1, R2, G2, R1, G1);
            GS_STEP(n + 2, R0, G0, R2, G2);
        }
        GS_OUT(255);
#undef GS_LD
#undef GS_ST
#undef GS_OUT
#undef GS_STEP
        return;
    }
    f32x4 S[8];
#pragma unroll
    for (int i = 0; i < 8; ++i) S[i] = (f32x4){0.f, 0.f, 0.f, 0.f};
    const unsigned* fl = FLAG + bh * 256;
#define GS_POLL(c_) do { unsigned sp_ = 0; while (__builtin_amdgcn_readfirstlane(__hip_atomic_load(fl + (c_), __ATOMIC_RELAXED, __HIP_MEMORY_SCOPE_AGENT)) == 0u) { __builtin_amdgcn_s_sleep(2); if (++sp_ > (1u << 22)) break; } } while (0)
    if (wave == 0) { GS_POLL(0); GS_POLL(1); GS_POLL(2); GS_POLL(3); __builtin_amdgcn_fence(__ATOMIC_ACQUIRE, "agent"); asm volatile("s_waitcnt vmcnt(0)" ::: "memory"); }
    __syncthreads();
    __syncthreads();
#pragma unroll 1
    for (int n = 0; n < 256; ++n) {
        LAS unsigned char* buf = lds + (n & 1) * GS_BUF;
        const float egl = GLs[n];
        unsigned fnext = 1u;
        if (wave == 0 && n + 4 < 256) fnext = __hip_atomic_load(fl + n + 4, __ATOMIC_RELAXED, __HIP_MEMORY_SCOPE_AGENT);
        f32x4 rhs[4];
        { const v4u vb0 = *(const LAS v4u*)(buf + 65536 + wave * 2048 + lane * 32), vb1 = *(const LAS v4u*)(buf + 65536 + wave * 2048 + lane * 32 + 16);
          rhs[0] = (f32x4){bflo(vb0.x), bfhi(vb0.x), bflo(vb0.y), bfhi(vb0.y)}; rhs[1] = (f32x4){bflo(vb0.z), bfhi(vb0.z), bflo(vb0.w), bfhi(vb0.w)};
          rhs[2] = (f32x4){bflo(vb1.x), bfhi(vb1.x), bflo(vb1.y), bfhi(vb1.y)}; rhs[3] = (f32x4){bflo(vb1.z), bfhi(vb1.z), bflo(vb1.w), bfhi(vb1.w)}; }
        bf16x8 Sb[4];
#pragma unroll
        for (int s = 0; s < 4; ++s) Sb[s] = pack_acc2(S[2 * s], S[2 * s + 1]);
#pragma unroll
        for (int s = 0; s < 4; ++s)
#pragma unroll
            for (int m = 0; m < 4; ++m) { const bf16x8 a = *(const LAS bf16x8*)(buf + (m * 4 + s) * 1024 + lane * 16); rhs[m] = MFMA16(a, Sb[s], rhs[m]); }
        __builtin_amdgcn_sched_barrier(0);
        bf16x8 Rb[2];
#pragma unroll
        for (int s = 0; s < 2; ++s) Rb[s] = pack_acc2(rhs[2 * s], rhs[2 * s + 1]);
        f32x4 vn[4];
#pragma unroll
        for (int m = 0; m < 4; ++m) vn[m] = (f32x4){0.f, 0.f, 0.f, 0.f};
#pragma unroll
        for (int s = 0; s < 2; ++s)
#pragma unroll
            for (int m = 0; m < 4; ++m) { const bf16x8 a = *(const LAS bf16x8*)(buf + 49152 + (m * 2 + s) * 1024 + lane * 16); vn[m] = MFMA16(a, Rb[s], vn[m]); }
        __builtin_amdgcn_sched_barrier(0);
        bf16x8 Vb[2];
#pragma unroll
        for (int s = 0; s < 2; ++s) Vb[s] = pack_acc2(vn[2 * s], vn[2 * s + 1]);
#pragma unroll
        for (int m8 = 0; m8 < 8; ++m8) S[m8] = S[m8] * egl;
#pragma unroll
        for (int s = 0; s < 2; ++s)
#pragma unroll
            for (int m8 = 0; m8 < 8; ++m8) { const bf16x8 a = *(const LAS bf16x8*)(buf + 32768 + (m8 * 2 + s) * 1024 + lane * 16); S[m8] = MFMA16(a, Vb[s], S[m8]); }
        __builtin_amdgcn_sched_barrier(0);
        f32x4 o[4];
#pragma unroll
        for (int m = 0; m < 4; ++m) o[m] = (f32x4){0.f, 0.f, 0.f, 0.f};
#pragma unroll
        for (int s = 0; s < 4; ++s)
#pragma unroll
            for (int m = 0; m < 4; ++m) { const bf16x8 a = *(const LAS bf16x8*)(buf + 16384 + (m * 4 + s) * 1024 + lane * 16); o[m] = MFMA16(a, Sb[s], o[m]); }
#pragma unroll
        for (int s = 0; s < 2; ++s)
#pragma unroll
            for (int m = 0; m < 4; ++m) { const bf16x8 a = *(const LAS bf16x8*)(buf + 57344 + (m * 2 + s) * 1024 + lane * 16); o[m] = MFMA16(a, Vb[s], o[m]); }
        __builtin_amdgcn_sched_barrier(0);
        { LAS bf16* ob = (LAS bf16*)(OB + (n & 1) * 4096);
#pragma unroll
          for (int m = 0; m < 4; ++m)
#pragma unroll
              for (int j = 0; j < 4; ++j) ob[(16 * m + 4 * q + j) * 32 + 16 * wave + r16] = (bf16)f2bf(o[m][j]); }
        if (wave == 0 && n + 4 < 256) { if (__builtin_amdgcn_readfirstlane(fnext) == 0u) GS_POLL(n + 4);
            __builtin_amdgcn_fence(__ATOMIC_ACQUIRE, "agent"); asm volatile("s_waitcnt vmcnt(0)" ::: "memory"); }
        __syncthreads();
    }
#undef GS_POLL
}

DI void gdn_onorm_phase(bf16* OY, const bf16* PROJ, const float* wn, float* ROPE, const int* pos, int gw, int NGW, int lane) {
    constexpr int NR = 4;
    for (int row = gw; row < TT; row += NGW) {
        if (lane < 32) { const float inv = powf(10000.f, -(float)lane * (1.f / 32.f)); const float ang = (float)pos[row] * inv; float sn, cs; sincosf(ang, &sn, &cs);
            ROPE[(size_t)row * 64 + lane] = cs; ROPE[(size_t)row * 64 + 32 + lane] = sn; } }
    float wv[16];
#pragma unroll
    for (int e = 0; e < 16; ++e) wv[e] = wn[16 * (lane & 7) + e];
    for (int row0 = gw * NR; row0 < TT; row0 += NGW * NR) {
        v4u o0[NR], o1[NR], z0[NR], z1[NR];
#pragma unroll
        for (int rr = 0; rr < NR; ++rr) { const bf16* op = OY + (size_t)(row0 + rr) * 1024 + 16 * lane; const bf16* zp = PROJ + (size_t)(row0 + rr) * 4096 + 3072 + 16 * lane;
            o0[rr] = *(const v4u*)op; o1[rr] = *(const v4u*)(op + 8); z0[rr] = *(const v4u*)zp; z1[rr] = *(const v4u*)(zp + 8); }
#pragma unroll
        for (int rr = 0; rr < NR; ++rr) {
            bf16* op = OY + (size_t)(row0 + rr) * 1024 + 16 * lane;
            float ov[16], zv[16];
#pragma unroll
            for (int e = 0; e < 4; ++e) { ov[2 * e] = bflo(o0[rr][e]); ov[2 * e + 1] = bfhi(o0[rr][e]); ov[8 + 2 * e] = bflo(o1[rr][e]); ov[8 + 2 * e + 1] = bfhi(o1[rr][e]);
                zv[2 * e] = bflo(z0[rr][e]); zv[2 * e + 1] = bfhi(z0[rr][e]); zv[8 + 2 * e] = bflo(z1[rr][e]); zv[8 + 2 * e + 1] = bfhi(z1[rr][e]); }
            float ss = 0.f;
#pragma unroll
            for (int e = 0; e < 16; ++e) ss += ov[e] * ov[e];
            ss += __shfl_xor(ss, 1); ss += __shfl_xor(ss, 2); ss += __shfl_xor(ss, 4);
            const float rs = rsqrtf(ss * (1.f / 128.f) + EPS);
            float y[16];
#pragma unroll
            for (int e = 0; e < 16; ++e) y[e] = ov[e] * rs * wv[e] * silu_f(zv[e]);
            v4u a, c; a.x = pk2(y[0], y[1]); a.y = pk2(y[2], y[3]); a.z = pk2(y[4], y[5]); a.w = pk2(y[6], y[7]);
            c.x = pk2(y[8], y[9]); c.y = pk2(y[10], y[11]); c.z = pk2(y[12], y[13]); c.w = pk2(y[14], y[15]);
            *(v4u*)op = a; *(v4u*)(op + 8) = c;
        }
    }
}
DI void swa_phase(const bf16* PROJ, const float* ROPE, const float* sinks, bf16* Y, LAS unsigned char* lds, int bid, int G, int tid, int wave, int lane) {
    LAS bf16* Ks = (LAS bf16*)lds;
    LAS bf16* Vs = (LAS bf16*)(lds + 36864);
    const int r = lane & 31, hi = lane >> 5;
    const float LOG2E = 1.4426950408889634f, c2 = 0.125f * LOG2E;
    for (int it = bid; it < 1024; it += G) {
        const int hk = it & 3, nb = (it >> 2) & 127, b = it >> 9;
        const long tb0 = (long)b * SEQ + (long)(nb - 1) * 128;
#pragma unroll
        for (int u = 0; u < 2; ++u) { const int p = tid + 512 * u, kk = p >> 2, o = p & 3;
            v4u w1 = (v4u){0u, 0u, 0u, 0u}, w2 = (v4u){0u, 0u, 0u, 0u};
            if (nb > 0 || kk >= 128) {
                const size_t t = (size_t)(tb0 + kk);
                const bf16* kp = PROJ + t * 2560 + 1024 + hk * 64 + 8 * o;
                const v4u a = *(const v4u*)kp, c = *(const v4u*)(kp + 32);
                const f32x4 cs0 = *(const f32x4*)(ROPE + t * 64 + 8 * o), cs1 = *(const f32x4*)(ROPE + t * 64 + 8 * o + 4);
                const f32x4 sn0 = *(const f32x4*)(ROPE + t * 64 + 32 + 8 * o), sn1 = *(const f32x4*)(ROPE + t * 64 + 32 + 8 * o + 4);
                float x1[8], x2[8], cs[8], sn[8];
#pragma unroll
                for (int e = 0; e < 4; ++e) { x1[2 * e] = bflo(a[e]); x1[2 * e + 1] = bfhi(a[e]); x2[2 * e] = bflo(c[e]); x2[2 * e + 1] = bfhi(c[e]);
                    cs[e] = cs0[e]; cs[4 + e] = cs1[e]; sn[e] = sn0[e]; sn[4 + e] = sn1[e]; }
                float y1[8], y2[8];
#pragma unroll
                for (int e = 0; e < 8; ++e) { y1[e] = x1[e] * cs[e] - x2[e] * sn[e]; y2[e] = x2[e] * cs[e] + x1[e] * sn[e]; }
                w1.x = pk2(y1[0], y1[1]); w1.y = pk2(y1[2], y1[3]); w1.z = pk2(y1[4], y1[5]); w1.w = pk2(y1[6], y1[7]);
                w2.x = pk2(y2[0], y2[1]); w2.y = pk2(y2[2], y2[3]); w2.z = pk2(y2[4], y2[5]); w2.w = pk2(y2[6], y2[7]);
            }
            *(LAS v4u*)(Ks + kk * 72 + 8 * o) = w1; *(LAS v4u*)(Ks + kk * 72 + 32 + 8 * o) = w2; }
#pragma unroll
        for (int u = 0; u < 4; ++u) { const int p = tid + 512 * u, kk = p >> 3, o8 = p & 7;
            v4u v = (v4u){0u, 0u, 0u, 0u};
            if (nb > 0 || kk >= 128) v = *(const v4u*)(PROJ + (size_t)(tb0 + kk) * 2560 + 1280 + hk * 64 + 8 * o8);
            const int pos = (kk & ~15) + perm16(kk & 15);
            LAS bf16* d = Vs + (8 * o8) * 264 + pos;
            d[0] = (bf16)(v.x & 0xffffu); d[264] = (bf16)(v.x >> 16); d[2 * 264] = (bf16)(v.y & 0xffffu); d[3 * 264] = (bf16)(v.y >> 16);
            d[4 * 264] = (bf16)(v.z & 0xffffu); d[5 * 264] = (bf16)(v.z >> 16); d[6 * 264] = (bf16)(v.w & 0xffffu); d[7 * 264] = (bf16)(v.w >> 16); }
        __syncthreads();
        const int g = wave >> 1, qh = wave & 1, head = hk * 4 + g;
        const float sink2 = sinks[head] * LOG2E;
        for (int sb = 0; sb < 2; ++sb) {
            const int qs = 64 * qh + 32 * sb, qi = qs + r, tbase = qs >> 5;
            const size_t t = (size_t)b * SEQ + (size_t)nb * 128 + qi;
            bf16x8 Qf[4];
            { const bf16* qp = PROJ + t * 2560 + head * 64 + 8 * hi;
              v4u qa[4];
#pragma unroll
              for (int ks = 0; ks < 4; ++ks) qa[ks] = *(const v4u*)(qp + 16 * ks);
#pragma unroll
              for (int k2 = 0; k2 < 2; ++k2) {
                  const f32x4 cs0 = *(const f32x4*)(ROPE + t * 64 + 16 * k2 + 8 * hi), cs1 = *(const f32x4*)(ROPE + t * 64 + 16 * k2 + 8 * hi + 4);
                  const f32x4 sn0 = *(const f32x4*)(ROPE + t * 64 + 32 + 16 * k2 + 8 * hi), sn1 = *(const f32x4*)(ROPE + t * 64 + 32 + 16 * k2 + 8 * hi + 4);
                  float y1[8], y2[8];
#pragma unroll
                  for (int e = 0; e < 4; ++e) {
                      const float a0 = bflo(qa[k2][e]), a1 = bfhi(qa[k2][e]), c0 = bflo(qa[k2 + 2][e]), c1 = bfhi(qa[k2 + 2][e]);
                      const float cA = (e < 2) ? cs0[2 * e] : cs1[2 * e - 4], cB = (e < 2) ? cs0[2 * e + 1] : cs1[2 * e - 3];
                      const float sA = (e < 2) ? sn0[2 * e] : sn1[2 * e - 4], sB = (e < 2) ? sn0[2 * e + 1] : sn1[2 * e - 3];
                      y1[2 * e] = a0 * cA - c0 * sA; y2[2 * e] = c0 * cA + a0 * sA;
                      y1[2 * e + 1] = a1 * cB - c1 * sB; y2[2 * e + 1] = c1 * cB + a1 * sB; }
                  v4u w1, w2;
                  w1.x = pk2(y1[0], y1[1]); w1.y = pk2(y1[2], y1[3]); w1.z = pk2(y1[4], y1[5]); w1.w = pk2(y1[6], y1[7]);
                  w2.x = pk2(y2[0], y2[1]); w2.y = pk2(y2[2], y2[3]); w2.z = pk2(y2[4], y2[5]); w2.w = pk2(y2[6], y2[7]);
                  Qf[k2] = __builtin_bit_cast(bf16x8, w1); Qf[k2 + 2] = __builtin_bit_cast(bf16x8, w2); } }
            f32x16 S[5];
            float mx = sink2;
#pragma unroll
            for (int tk = 0; tk < 5; ++tk) {
#pragma unroll
                for (int i = 0; i < 16; ++i) S[tk][i] = 0.f;
                const int kt = tbase + tk;
#pragma unroll
                for (int ks = 0; ks < 4; ++ks) { const bf16x8 a = *(const LAS bf16x8*)(Ks + (32 * kt + r) * 72 + 16 * ks + 8 * hi); S[tk] = MFMA32(a, Qf[ks], S[tk]); }
#pragma unroll
                for (int i = 0; i < 16; ++i) { const int kk = 32 * kt + crow32(i, hi);
                    const bool ok = (kk > qi) && (kk <= qi + 128) && (nb > 0 || kk >= 128);
                    const float xv = ok ? S[tk][i] * c2 : -INFINITY; S[tk][i] = xv; mx = fmaxf(mx, xv); }
            }
            mx = fmaxf(mx, __shfl_xor(mx, 32));
            float ps = 0.f;
#pragma unroll
            for (int tk = 0; tk < 5; ++tk)
#pragma unroll
                for (int i = 0; i < 16; ++i) { const float p = __builtin_amdgcn_exp2f(S[tk][i] - mx); S[tk][i] = p; ps += p; }
            const float tot = ps + __shfl_xor(ps, 32) + __builtin_amdgcn_exp2f(sink2 - mx);
            const float inv = 1.f / tot;
            f32x16 O[2];
#pragma unroll
            for (int dt = 0; dt < 2; ++dt)
#pragma unroll
                for (int i = 0; i < 16; ++i) O[dt][i] = 0.f;
#pragma unroll
            for (int tk = 0; tk < 5; ++tk)
#pragma unroll
                for (int s = 0; s < 2; ++s) { v4u w;
                    w.x = pk2(S[tk][8 * s], S[tk][8 * s + 1]); w.y = pk2(S[tk][8 * s + 2], S[tk][8 * s + 3]);
                    w.z = pk2(S[tk][8 * s + 4], S[tk][8 * s + 5]); w.w = pk2(S[tk][8 * s + 6], S[tk][8 * s + 7]);
                    const bf16x8 pf = __builtin_bit_cast(bf16x8, w);
                    const int kt = tbase + tk;
#pragma unroll
                    for (int dt = 0; dt < 2; ++dt) { const bf16x8 a = *(const LAS bf16x8*)(Vs + (32 * dt + r) * 264 + 32 * kt + 16 * s + 8 * hi); O[dt] = MFMA32(a, pf, O[dt]); } }
#pragma unroll
            for (int dt = 0; dt < 2; ++dt)
#pragma unroll
                for (int g4 = 0; g4 < 4; ++g4) { const int d = 32 * dt + 8 * g4 + 4 * hi;
                    const v2u z = *(const v2u*)(PROJ + t * 2560 + 1536 + head * 64 + d);
                    const float y0 = O[dt][4 * g4] * inv * silu_f(bflo(z.x)), y1 = O[dt][4 * g4 + 1] * inv * silu_f(bfhi(z.x));
                    const float y2 = O[dt][4 * g4 + 2] * inv * silu_f(bflo(z.y)), y3 = O[dt][4 * g4 + 3] * inv * silu_f(bfhi(z.y));
                    v2u o; o.x = pk2(y0, y1); o.y = pk2(y2, y3);
                    *(v2u*)(Y + t * 1024 + head * 64 + d) = o; }
        }
        __syncthreads();
    }
}
#ifndef LAYER_MASK
#define LAYER_MASK 15
#endif
__global__ void __launch_bounds__(NTHR, 2) mega_fwd(Ptrs P) {
    extern __shared__ __attribute__((aligned(16))) unsigned char lds_raw[];
    LAS unsigned char* lds = (LAS unsigned char*)lds_raw;
    cg::grid_group grid = cg::this_grid();
    int tid_o = threadIdx.x; int tid = tid_o, lane = tid & 63; const int wave = __builtin_amdgcn_readfirstlane(tid >> 6);
    const int G = gridDim.x, bid = blockIdx.x;
    const int gw = bid * NWAVES + wave, NGW = G * NWAVES, NG = G * NTHR; int gtid = bid * NTHR + tid;
    unsigned char* ws = P.ws;
    const float* x_in = P.in[0]; const int* positions = (const int*)P.in[1];
    const float* norm_w = P.in[2]; const float* fnorm_w = P.in[3];
    float* X = P.out;
    bf16* XB = (bf16*)P.out;
    bf16* XB3 = (bf16*)(ws + WS_EX + 64 * MiB);
    bf16* HY = (bf16*)(ws + WS_HY); bf16* PROJ = (bf16*)(ws + WS_PROJ);
#define RELAUNDER() do { asm volatile("" : "+v"(tid_o)); tid = tid_o; lane = tid & 63; gtid = bid * NTHR + tid; } while (0)
#define GSYNC() do { xcd_barrier(xbar); RELAUNDER(); } while (0)

    unsigned* CTL = (unsigned*)(ws + WS_GL + 65536);
    if (bid == 0 && tid < 128) CTL[tid] = 0u;
    unsigned* FLAGS = (unsigned*)(ws + WS_GL + 131072);
    for (int i = gtid; i < 4096; i += NG) FLAGS[i] = 0u;
    unsigned* XBW = (unsigned*)(ws + WS_GL + 262144);
    volatile LAS unsigned* xst = (volatile LAS unsigned*)(lds + LDS_BYTES - 16);
    if (bid == 0) for (int i = tid; i < XCD_BAR_WORDS; i += NTHR) XBW[i] = 0u;
    if (tid < 2) xst[tid] = 0u;
    p0_prologue(P, lds, gw, NGW, wave, lane);
#ifdef DBL_P0
    p0_prologue(P, lds, gw, NGW, wave, lane);
#endif
    norm_phase<0>(x_in, norm_w, HY, nullptr, nullptr, 0, nullptr, nullptr, nullptr, nullptr, nullptr, nullptr, lds, gw, NGW, tid, lane);
    grid.sync();
    RELAUNDER();
    const XcdBarrier xbar = xcd_barrier_post(XBW, xst);
    if (LAYER_MASK & 1) {
        bf16* Y0 = (bf16*)(ws + WS_EX); float* CVH = (float*)(ws + WS_PROJ); float* BND = (float*)(ws + WS_PROJ + 8 * MiB);
        { pg8::Gemm g{HY, (const bf16*)(ws + WS_W0I), TT, 4096, 1024}; pg8::StaticOrder S; S.init(TT, 4096, G, bid);
          pg8::EpiConvGate E{Y0, P.in[5], CVH, BND};
          pg8::gemm_phase<pg8::EpiConvGate, pg8::StaticOrder, true, true>(lds, g, S, E); }
        GSYNC();
        convfix_phase(CVH, BND, P.in[5], Y0, gtid, NG);
        GSYNC();
        { pg8::Gemm g{Y0, (const bf16*)(ws + WS_W0O), TT, 1024, 1024}; pg8::StaticOrder S; S.init(TT, 1024, G, bid);
          pg8::EpiRes<false, true> E{x_in, XB, nullptr};
          pg8::gemm_phase<pg8::EpiRes<false, true>, pg8::StaticOrder, true, true>(lds, g, S, E);
        }
    } else {
        for (size_t i = gtid; i < (size_t)TT * DM / 4; i += NG) { const f32x4 v = ((const f32x4*)x_in)[i]; v2u o; o.x = pk2(v.x, v.y); o.y = pk2(v.z, v.w); ((v2u*)XB)[i] = o; }
    }
    GSYNC();
    if (LAYER_MASK & 2) {
        float* LOGF = (float*)(ws + WS_LOGF); float* CUM = (float*)(ws + WS_CUM); float* KPF = (float*)(ws + WS_GL + MiB);
        norm_phase<1, true>((const float*)XB, norm_w + 1024, HY, nullptr, P.in[7], 4104, LOGF, nullptr, P.in[8], nullptr, nullptr, nullptr, lds, gw, NGW, tid, lane);
        GSYNC();
        if (bid < 16) fox_cumsum(LOGF, CUM, bid, lds, tid);
        { pg8::Gemm g{HY, (const bf16*)(ws + WS_W1I), TT, 4096, 1024}; pg8::StaticOrder S; S.init(TT, 4096, G, bid);
          pg8::EpiStore E{PROJ, 4096, nullptr, KPF};
          pg8::gemm_phase<pg8::EpiStore, pg8::StaticOrder, true, true>(lds, g, S, E); }
        GSYNC();
        fox_norms_phase(KPF, (float*)(CTL + 1024), gw, NGW, lane);
        GSYNC();
        fox_attn_phase(PROJ, CUM, HY, (const float*)(CTL + 1024), CTL + 64, lds, bid, G, tid, wave, lane);
#ifdef DBL_FOX
        fox_attn_phase(PROJ, CUM, HY, (const float*)(CTL + 1024), CTL + 65, lds, bid, G, tid, wave, lane);
#endif
        GSYNC();
        { pg8::Gemm g{HY, (const bf16*)(ws + WS_W1O), TT, 1024, 1024}; pg8::StaticOrder S; S.init(TT, 1024, G, bid);
          pg8::EpiRes<true, true> E{XB, XB, nullptr};
          pg8::gemm_phase<pg8::EpiRes<true, true>, pg8::StaticOrder, true, true>(lds, g, S, E); }
        GSYNC();
    }
    if (LAYER_MASK & 4) {
        float* BETA = (float*)(ws + WS_LOGF); float* GG = (float*)(ws + WS_CUM); float* GL = (float*)(ws + WS_GL); bf16* HALO = (bf16*)(ws + WS_HALO);
        norm_phase<2, true>((const float*)XB, norm_w + 2048, HY, nullptr, P.in[10], 4112, BETA, GG, P.in[12], P.in[13], nullptr, nullptr, lds, gw, NGW, tid, lane);
#ifdef DBL_NORM2
        norm_phase<2, true>((const float*)XB, norm_w + 2048, HY, nullptr, P.in[10], 4112, BETA, GG, P.in[12], P.in[13], nullptr, nullptr, lds, gw, NGW, tid, lane);
#endif
        GSYNC();
        { pg8::Gemm g{HY, (const bf16*)(ws + WS_W2I), TT, 4096, 1024}; pg8::StaticOrder S; S.init(TT, 4096, G, bid);
          pg8::EpiStore E{PROJ, 4096, HALO, nullptr};
          pg8::gemm_phase<pg8::EpiStore, pg8::StaticOrder, true, true>(lds, g, S, E); }
        GSYNC();
        if (bid >= 64) gdn_prep_phase<false>(PROJ, HY, HALO, P.in[11], BETA, GG, ws + WS_EX, GL, FLAGS, lds, bid, G, 64, tid, wave, lane);
        else gdn_scan_phase(PROJ, ws + WS_EX, GL, FLAGS, HY, lds, bid, tid, wave, lane);
        GSYNC();
        gdn_onorm_phase(HY, PROJ, P.in[14], (float*)(ws + WS_EX), positions, gw, NGW, lane);
        GSYNC();
        { pg8::Gemm g{HY, (const bf16*)(ws + WS_W2O), TT, 1024, 1024}; pg8::StaticOrder S; S.init(TT, 1024, G, bid);
          pg8::EpiRes<true, true, true> E{XB, XB3, (float*)(ws + WS_LOGF)};
          pg8::gemm_phase<pg8::EpiRes<true, true, true>, pg8::StaticOrder, true, true>(lds, g, S, E); }
        GSYNC();
    }
    if (LAYER_MASK & 8) {
        float* ROPE = (float*)(ws + WS_EX);
        { pg8::Gemm g{XB3, (const bf16*)(ws + WS_W3I), TT, 2560, 1024}; pg8::StaticOrder S; S.init(TT, 2560, G, bid);
          pg8::EpiStoreScaled E{PROJ, 2560, (const float*)(ws + WS_LOGF)};
          pg8::gemm_phase<pg8::EpiStoreScaled, pg8::StaticOrder, true, true>(lds, g, S, E); }
        GSYNC();
        swa_phase(PROJ, ROPE, P.in[17], HY, lds, bid, G, tid, wave, lane);
#ifdef DBL_SWA
        swa_phase(PROJ, ROPE, P.in[17], HY, lds, bid, G, tid, wave, lane);
#endif
        GSYNC();
        { pg8::Gemm g{HY, (const bf16*)(ws + WS_W3O), TT, 1024, 1024}; pg8::StaticOrder S; S.init(TT, 1024, G, bid);
          pg8::EpiRes<true, false> E{XB3, X, nullptr};
          pg8::gemm_phase<pg8::EpiRes<true, false>, pg8::StaticOrder, true, true>(lds, g, S, E); }
        GSYNC();
    }
#ifdef DBL_SYNC
    for (int i = 0; i < 10; ++i) GSYNC();
#endif
#ifdef DBL_FINAL
    norm_phase<0>(X, fnorm_w, HY, nullptr, nullptr, 0, nullptr, nullptr, nullptr, nullptr, nullptr, nullptr, lds, gw, NGW, tid, lane);
#endif
    norm_phase<4>(X, fnorm_w, nullptr, X, nullptr, 0, nullptr, nullptr, nullptr, nullptr, nullptr, nullptr, lds, gw, NGW, tid, lane);
}

extern "C" void kernel_launch(void* const* d_in, const int* in_sizes, int n_in, void* d_out, int out_size, void* d_ws, size_t ws_size, hipStream_t stream) {
    static int grid = 0;
    if (grid == 0) {
        int dev = 0, cus = 0, per_cu = 0;
        hipGetDevice(&dev);
        hipDeviceGetAttribute(&cus, hipDeviceAttributeMultiprocessorCount, dev);
        if (hipFuncSetAttribute((const void*)mega_fwd, hipFuncAttributeMaxDynamicSharedMemorySize, LDS_BYTES) != hipSuccess) fprintf(stderr, "kernel_launch: hipFuncSetAttribute failed\n");
        if (hipOccupancyMaxActiveBlocksPerMultiprocessor(&per_cu, (const void*)mega_fwd, NTHR, LDS_BYTES) != hipSuccess || per_cu < 1) { fprintf(stderr, "kernel_launch: occupancy query says %d\n", per_cu); per_cu = 1; }
        (void)hipGetLastError();
        grid = cus;
        if (ws_size < WS_END) fprintf(stderr, "kernel_launch: workspace %zu < %zu\n", ws_size, (size_t)WS_END);
    }
    Ptrs p{};
    for (int i = 0; i < 19; ++i) p.in[i] = (const float*)d_in[i];
    p.out = (float*)d_out; p.ws = (unsigned char*)d_ws; p.ph_lo = 0; p.ph_hi = 0;
    void* args[] = {&p};
    hipError_t e = hipLaunchCooperativeKernel((const void*)mega_fwd, dim3(grid), dim3(NTHR), args, LDS_BYTES, stream);
    if (e != hipSuccess) fprintf(stderr, "cooperative launch failed: %s (grid %d)\n", hipGetErrorString(e), grid);
}
```

```cpp
#include <hip/hip_runtime.h>
#include <hip/hip_cooperative_groups.h>
#include <cstdio>
#include <cstdint>
namespace cg = cooperative_groups;

#define DI __device__ __forceinline__
#define LAS __attribute__((address_space(3)))
#define GAS __attribute__((address_space(1)))
typedef unsigned short bf16;
typedef unsigned v4u __attribute__((ext_vector_type(4)));
typedef unsigned v2u __attribute__((ext_vector_type(2)));
typedef float f32x4 __attribute__((ext_vector_type(4)));
typedef float f32x16 __attribute__((ext_vector_type(16)));
typedef short bf16x8 __attribute__((ext_vector_type(8)));

constexpr int NBATCH = 2, SEQ = 16384, TT = NBATCH * SEQ, DM = 1024;
constexpr float EPS = 1e-6f;
constexpr int NWAVES = 8, NTHR = 512;
constexpr size_t MiB = 1u << 20;
constexpr size_t WS_W0I = 0, WS_W0O = 8 * MiB, WS_W1I = 10 * MiB, WS_W1O = 18 * MiB, WS_W2I = 20 * MiB, WS_W2O = 28 * MiB, WS_W3I = 30 * MiB, WS_W3O = 35 * MiB;
constexpr size_t WS_LOGF = 38 * MiB;
constexpr size_t WS_CUM = 39 * MiB;
constexpr size_t WS_GL = 40 * MiB;
constexpr size_t WS_HALO = 48 * MiB;
constexpr size_t WS_HY = 64 * MiB;
constexpr size_t WS_PROJ = 128 * MiB;
constexpr size_t WS_EX = 384 * MiB;
constexpr size_t WS_END = 512 * MiB;
constexpr int LDS_BYTES = 155648;

DI unsigned f2bf(float f) { unsigned u = __builtin_bit_cast(unsigned, f); return (u + 0x7fffu + ((u >> 16) & 1u)) >> 16; }
typedef float f32x2_t __attribute__((ext_vector_type(2)));
typedef __bf16 bf16x2_t __attribute__((ext_vector_type(2)));
DI unsigned pk2(float lo, float hi) { f32x2_t v = {lo, hi}; bf16x2_t b = __builtin_convertvector(v, bf16x2_t); return __builtin_bit_cast(unsigned, b); }
DI float bflo(unsigned u) { return __builtin_bit_cast(float, u << 16); }
DI float bfhi(unsigned u) { return __builtin_bit_cast(float, u & 0xffff0000u); }
DI float bf2f(bf16 b) { return __builtin_bit_cast(float, (unsigned)b << 16); }
DI float wave_sum(float v) {
#pragma unroll
    for (int o = 1; o < 64; o <<= 1) v += __shfl_xor(v, o);
    return v;
}
DI float silu_f(float x) { return x / (1.f + __expf(-x)); }
DI float softplus_f(float x) { return fmaxf(x, 0.f) + log1pf(__expf(-fabsf(x))); }
namespace pg8 {
#define PG8_LAS __attribute__((address_space(3)))
typedef unsigned short bf16_t;
typedef short bf16x8 __attribute__((ext_vector_type(8)));
typedef float f32x4 __attribute__((ext_vector_type(4)));
typedef unsigned u32x4 __attribute__((ext_vector_type(4)));
constexpr int BM = 256, BK = 64, HALF = 128, HTB = HALF * BK * 2  , STAGE_BYTES = 8 * HTB, NXCD = 8, WGM = 8;

__host__ __device__ __forceinline__ int lds_byte(int r, int c) { const int st = (r >> 4) * 2 + (c >> 5), rr = r & 15, cc = c & 31, ob = rr * 64 + cc * 2; return st * 1024 + (ob ^ (((ob >> 9) & 1) << 5)); }
__host__ __device__ __forceinline__ void stage_rc(int b, int& R, int& C) { const int st = b / 1024, sb = b % 1024, swz = sb ^ (((sb >> 9) & 1) << 5); R = (st >> 1) * 16 + swz / 64; C = (st & 1) * 32 + (swz % 64) / 2; }
__host__ __device__ __forceinline__ int perm32(int rho) { const int n = rho >> 4, i = rho & 15; return 8 * (i >> 2) + 4 * n + (i & 3); }

struct Unit { int pm, pn; };
struct Gemm { const bf16_t* A; const bf16_t* Bt; int M, N, K; };

struct StaticOrder {
    int nM, nN, nwg, G, c;
    __host__ __device__ void init(int M, int N, int G_, int c_) { nM = M / BM; nN = N / BM; nwg = nM * nN; G = G_; c = c_; }
    __host__ __device__ bool next(int i, Unit& u) const {
        const long L = (long)i * G + c; if (L >= nwg) return false;
        int wgid = (int)L; { const int q = nwg / NXCD, r = nwg % NXCD, xcd = wgid % NXCD, off = wgid / NXCD; wgid = (xcd < r ? xcd * (q + 1) : r * (q + 1) + (xcd - r) * q) + off; }
        const int nig = WGM * nN, gid = wgid / nig, fm = gid * WGM, gsz = (nM - fm) < WGM ? (nM - fm) : WGM;
        u.pm = fm + ((wgid % nig) % gsz); u.pn = (wgid % nig) / gsz; return true;
    }
    __device__ __forceinline__ void a_ready(const Unit&) const {}
    __device__ __forceinline__ void done(const Unit&) const {}
};

__device__ __forceinline__ unsigned cvt_pk_bf16(float lo, float hi) { unsigned r; asm volatile("v_cvt_pk_bf16_f32 %0, %1, %2" : "=v"(r) : "v"(lo), "v"(hi)); return r; }
struct EpiStore {
    static constexpr bool PERM = true, AFTER_DRAIN = false;
    bf16_t* O; int ldc; bf16_t* HALO;
    __device__ __forceinline__ void operator()(const f32x4 (&acc)[2][2][4][2], const Unit& u, int wr, int wc, int fr, int fq) const {
        const int row0 = u.pm * BM + wr * 64 + fr; const int col0 = u.pn * BM + wc * 32 + 8 * fq;
#pragma unroll
        for (int ai = 0; ai < 2; ++ai)
#pragma unroll
            for (int m = 0; m < 4; ++m) { const int row = row0 + ai * HALF + m * 16; bf16_t* rowp = O + (size_t)row * ldc + col0;
#pragma unroll
                for (int bj = 0; bj < 2; ++bj) { const f32x4 v0 = acc[ai][bj][m][0], v1 = acc[ai][bj][m][1];
                    u32x4 w; w.x = cvt_pk_bf16(v0[0], v0[1]); w.y = cvt_pk_bf16(v0[2], v0[3]); w.z = cvt_pk_bf16(v1[0], v1[1]); w.w = cvt_pk_bf16(v1[2], v1[3]);
                    *(u32x4*)(rowp + bj * HALF) = w;
                    if (HALO != nullptr && m == 3 && fr >= 13 && (col0 + bj * HALF) < 3072)
                        *(u32x4*)(HALO + ((size_t)(row >> 6) * 3 + (fr - 13)) * 3072 + col0 + bj * HALF) = w;
                } }
    }
};
template <bool RB, bool OB, bool PSUM = false>
struct EpiRes {
    static constexpr bool PERM = true, AFTER_DRAIN = false;
    const void* R; void* O; float* PS;
    __device__ __forceinline__ void operator()(const f32x4 (&acc)[2][2][4][2], const Unit& u, int wr, int wc, int fr, int fq) const {
        const int row0 = u.pm * BM + wr * 64 + fr; const int col0 = u.pn * BM + wc * 32 + 8 * fq;
#pragma unroll
        for (int ai = 0; ai < 2; ++ai)
#pragma unroll
            for (int m = 0; m < 4; ++m) { const size_t off = (size_t)(row0 + ai * HALF + m * 16) * 1024 + col0; float ssq = 0.f;
#pragma unroll
                for (int bj = 0; bj < 2; ++bj) {
                    f32x4 r0, r1;
                    if constexpr (RB) { const u32x4 w = *(const u32x4*)((const bf16_t*)R + off + bj * HALF);
                        r0 = (f32x4){__builtin_bit_cast(float, w.x << 16), __builtin_bit_cast(float, w.x & 0xffff0000u), __builtin_bit_cast(float, w.y << 16), __builtin_bit_cast(float, w.y & 0xffff0000u)};
                        r1 = (f32x4){__builtin_bit_cast(float, w.z << 16), __builtin_bit_cast(float, w.z & 0xffff0000u), __builtin_bit_cast(float, w.w << 16), __builtin_bit_cast(float, w.w & 0xffff0000u)}; }
                    else { r0 = *(const f32x4*)((const float*)R + off + bj * HALF); r1 = *(const f32x4*)((const float*)R + off + bj * HALF + 4); }
                    const f32x4 v0 = r0 + acc[ai][bj][m][0], v1 = r1 + acc[ai][bj][m][1];
                    if constexpr (OB) { u32x4 w; w.x = cvt_pk_bf16(v0[0], v0[1]); w.y = cvt_pk_bf16(v0[2], v0[3]); w.z = cvt_pk_bf16(v1[0], v1[1]); w.w = cvt_pk_bf16(v1[2], v1[3]);
                        *(u32x4*)((bf16_t*)O + off + bj * HALF) = w;
                        if constexpr (PSUM) {
#pragma unroll
                            for (int i = 0; i < 4; ++i) { const unsigned ww = (i == 0) ? w.x : (i == 1 ? w.y : (i == 2 ? w.z : w.w));
                                const float lo = __builtin_bit_cast(float, ww << 16), hi = __builtin_bit_cast(float, ww & 0xffff0000u); ssq += lo * lo + hi * hi; } } }
                    else { *(f32x4*)((float*)O + off + bj * HALF) = v0; *(f32x4*)((float*)O + off + bj * HALF + 4) = v1; }
                }
                if constexpr (PSUM) { ssq += __shfl_xor(ssq, 16); ssq += __shfl_xor(ssq, 32);
                    if (fq == 0) PS[(size_t)(row0 + ai * HALF + m * 16) * 16 + u.pn * 4 + wc] = ssq; } }
    }
};
struct EpiConvGate {
    static constexpr bool PERM = true, AFTER_DRAIN = false;
    bf16_t* Y; const float* wconv; float* CVH; float* BND;
    __device__ __forceinline__ void operator()(const f32x4 (&acc)[2][2][4][2], const Unit& u, int wr, int wc, int fr, int fq) const {
        const int ch0 = 64 * u.pn + 16 * wc + 4 * fq;
        const f32x4 w0 = *(const f32x4*)(wconv + ch0), w1 = *(const f32x4*)(wconv + 1024 + ch0), w2 = *(const f32x4*)(wconv + 2048 + ch0);
#pragma unroll
        for (int ai = 0; ai < 2; ++ai) {
            f32x4 p15 = (f32x4){0.f, 0.f, 0.f, 0.f}, p14 = (f32x4){0.f, 0.f, 0.f, 0.f};
#pragma unroll
            for (int m = 0; m < 4; ++m) {
                const int row = u.pm * BM + ai * HALF + wr * 64 + m * 16 + fr;
                const f32x4 b = acc[ai][0][m][0], c = acc[ai][0][m][1], v = acc[ai][1][m][0], z = acc[ai][1][m][1];
                const f32x4 cv = c * v;
                f32x4 y, n15, n14;
#pragma unroll
                for (int e = 0; e < 4; ++e) {
                    const float up1 = __shfl_up(cv[e], 1, 16), up2 = __shfl_up(cv[e], 2, 16);
                    const float cm1 = (fr >= 1) ? up1 : p15[e];
                    const float cm2 = (fr >= 2) ? up2 : ((fr == 1) ? p15[e] : p14[e]);
                    const float zz = z[e];
                    y[e] = b[e] * (w0[e] * cm2 + w1[e] * cm1 + w2[e] * cv[e]) * (zz / (1.f + __expf(-zz)));
                    n15[e] = __shfl(cv[e], 15, 16); n14[e] = __shfl(cv[e], 14, 16);
                }
                p15 = n15; p14 = n14;
                if (m > 0 || fr >= 2) {
                    unsigned long long o = (unsigned long long)cvt_pk_bf16(y[0], y[1]) | ((unsigned long long)cvt_pk_bf16(y[2], y[3]) << 32);
                    *(unsigned long long*)(Y + (size_t)row * 1024 + ch0) = o;
                } else {
                    float* bp = BND + ((size_t)(row >> 6) * 2 + fr) * 3 * 1024 + ch0;
                    *(f32x4*)bp = b; *(f32x4*)(bp + 1024) = z; *(f32x4*)(bp + 2048) = cv;
                }
                if (m == 3 && fr >= 14) *(f32x4*)(CVH + ((size_t)(row >> 6) * 2 + (fr - 14)) * 1024 + ch0) = cv;
            }
        }
    }
};
struct EpiStoreScaled {
    static constexpr bool PERM = true, AFTER_DRAIN = false;
    bf16_t* O; int ldc; const float* PS;
    __device__ __forceinline__ void operator()(const f32x4 (&acc)[2][2][4][2], const Unit& u, int wr, int wc, int fr, int fq) const {
        const int row0 = u.pm * BM + wr * 64 + fr; const int col0 = u.pn * BM + wc * 32 + 8 * fq;
#pragma unroll
        for (int ai = 0; ai < 2; ++ai)
#pragma unroll
            for (int m = 0; m < 4; ++m) { const int row = row0 + ai * HALF + m * 16; bf16_t* rowp = O + (size_t)row * ldc + col0;
                const f32x4* pp = (const f32x4*)(PS + (size_t)row * 16);
                const f32x4 s4 = (pp[0] + pp[1]) + (pp[2] + pp[3]);
                const float r = rsqrtf(((s4[0] + s4[1]) + (s4[2] + s4[3])) * (1.f / 1024.f) + 1e-6f);
#pragma unroll
                for (int bj = 0; bj < 2; ++bj) { const f32x4 v0 = acc[ai][bj][m][0] * r, v1 = acc[ai][bj][m][1] * r;
                    u32x4 w; w.x = cvt_pk_bf16(v0[0], v0[1]); w.y = cvt_pk_bf16(v0[2], v0[3]); w.z = cvt_pk_bf16(v1[0], v1[1]); w.w = cvt_pk_bf16(v1[2], v1[3]);
                    *(u32x4*)(rowp + bj * HALF) = w; } }
    }
};
template <class Epi, class Sched, bool ALIGN_EPI = false, bool SP2 = false>
__device__ __forceinline__ void gemm_phase(PG8_LAS unsigned char* lds, const Gemm g, const Sched& S, const Epi& E) {
    int tid_l = threadIdx.x; asm volatile("" : "+v"(tid_l));
    const int tid = tid_l, wid = __builtin_amdgcn_readfirstlane(tid >> 6), lane = tid & 63, wr = wid >> 2, wc = wid & 3, fr = lane & 15, fq = lane >> 4;
    const int K = g.K, nt = K / BK;
    unsigned voffA[2], voffB[2];
#pragma unroll
    for (int i = 0; i < 2; ++i) { int R, C; stage_rc(tid * 16 + i * 8192, R, C); const int Rb = Epi::PERM ? ((R & ~31) + perm32(R & 31)) : R;
        voffA[i] = (unsigned)(R * K + C) * 2u; voffB[i] = (unsigned)(Rb * K + C) * 2u; }
    const size_t kstep = (size_t)(BK * 2);
    const size_t hstep = (size_t)HALF * K * 2;
    const size_t tstep = 2 * hstep;
    const unsigned ldsw = (unsigned)wid * 1024u;
    const int aoff = lds_byte(wr * 64 + fr, fq * 8), boff = lds_byte(wc * 32 + fr, fq * 8);
#define PG8_SA(b, h) (((b) * 2 + (h)) * HTB)
#define PG8_SB(b, h) ((4 + (b) * 2 + (h)) * HTB)
#define PG8_STAGE(bufoff, gbase, voff) do { _Pragma("unroll") for (int _i = 0; _i < 2; ++_i) \
        __builtin_amdgcn_global_load_lds((const unsigned*)((const char*)(gbase) + (voff)[_i]), (PG8_LAS unsigned*)(lds + (bufoff) + ldsw + _i * 8192), 16, 0, 0); } while (0)
#define PG8_LDA(dst, b, h) do { _Pragma("unroll") for (int m = 0; m < 4; ++m) _Pragma("unroll") for (int k = 0; k < 2; ++k) dst[m][k] = *(const PG8_LAS bf16x8*)(lds + PG8_SA(b, h) + aoff + m * 2048 + k * 1024); } while (0)
#define PG8_LDB(dst, b, h) do { _Pragma("unroll") for (int n = 0; n < 2; ++n) _Pragma("unroll") for (int k = 0; k < 2; ++k) dst[n][k] = *(const PG8_LAS bf16x8*)(lds + PG8_SB(b, h) + boff + n * 2048 + k * 1024); } while (0)
#define PG8_MMA(ai, bj, At, Bt) do { __builtin_amdgcn_s_setprio(1); _Pragma("unroll") for (int m = 0; m < 4; ++m) _Pragma("unroll") for (int n = 0; n < 2; ++n) _Pragma("unroll") for (int k = 0; k < 2; ++k) \
        acc[ai][bj][m][n] = __builtin_amdgcn_mfma_f32_16x16x32_bf16(Bt[n][k], At[m][k], acc[ai][bj][m][n], 0, 0, 0); __builtin_amdgcn_s_setprio(0); } while (0)
#define PG8_WAIT_V(n) asm volatile("s_waitcnt vmcnt(" #n ")" ::: "memory")
#define PG8_WAIT_L(n) asm volatile("s_waitcnt lgkmcnt(" #n ")" ::: "memory")
#define PG8_BAR __builtin_amdgcn_s_barrier()
#define PG8_SCHED __builtin_amdgcn_sched_barrier(0)
    Unit cur, nxt; int ui = 0;
    if (!S.next(0, cur)) return;
    f32x4 acc[2][2][4][2];
#pragma unroll
    for (int a = 0; a < 2; ++a)
#pragma unroll
        for (int b = 0; b < 2; ++b)
#pragma unroll
            for (int m = 0; m < 4; ++m)
#pragma unroll
                for (int n = 0; n < 2; ++n) acc[a][b][m][n] = (f32x4){0.f, 0.f, 0.f, 0.f};
    bf16x8 At[4][2], B0[2][2], B1[2][2];
    const char* cA = (const char*)g.A + (size_t)cur.pm * tstep; const char* cB = (const char*)g.Bt + (size_t)cur.pn * tstep;
    S.a_ready(cur);
    if constexpr (SP2) {
        PG8_STAGE(PG8_SB(0, 0), cB, voffB); PG8_STAGE(PG8_SB(0, 1), cB + hstep, voffB); PG8_STAGE(PG8_SA(0, 0), cA, voffA); PG8_STAGE(PG8_SA(0, 1), cA + hstep, voffA);
        if (wr == 1) PG8_BAR;
        PG8_WAIT_V(2); PG8_BAR;
        PG8_STAGE(PG8_SB(1, 0), cB + kstep, voffB); PG8_STAGE(PG8_SA(1, 0), cA + kstep, voffA); PG8_STAGE(PG8_SB(1, 1), cB + hstep + kstep, voffB);
        PG8_WAIT_V(6); PG8_BAR;
    } else {
        PG8_STAGE(PG8_SB(0, 0), cB, voffB); PG8_STAGE(PG8_SA(0, 0), cA, voffA); PG8_STAGE(PG8_SB(0, 1), cB + hstep, voffB); PG8_STAGE(PG8_SA(0, 1), cA + hstep, voffA);
        if (wr == 1) PG8_BAR;
        PG8_WAIT_V(4); PG8_BAR;
        PG8_STAGE(PG8_SB(1, 0), cB + kstep, voffB); PG8_STAGE(PG8_SA(1, 0), cA + kstep, voffA); PG8_STAGE(PG8_SB(1, 1), cB + hstep + kstep, voffB);
        PG8_WAIT_V(6); PG8_BAR;
    }
    for (;;) {
        const bool has_next = S.next(ui + 1, nxt);
        const char* nA = has_next ? (const char*)g.A + (size_t)nxt.pm * tstep : cA; const char* nB = has_next ? (const char*)g.Bt + (size_t)nxt.pn * tstep : cB;
        for (int t = 0; t < nt; t += 2) {
            const bool last = (t == nt - 2);
            const char* a1 = cA + (size_t)(t + 1) * kstep;
            const char* a2 = last ? nA : cA + (size_t)(t + 2) * kstep; const char* b2 = last ? nB : cB + (size_t)(t + 2) * kstep;
            const char* a3 = a2 + kstep; const char* b3 = b2 + kstep;
            if (last && has_next) S.a_ready(nxt);
            if constexpr (SP2) {
            PG8_LDB(B0, 0, 0); PG8_LDB(B1, 0, 1); PG8_SCHED; PG8_LDA(At, 0, 0); PG8_STAGE(PG8_SA(1, 1), a1 + hstep, voffA);
            PG8_WAIT_V(8); PG8_WAIT_L(0); PG8_BAR; PG8_MMA(0, 0, At, B0); PG8_MMA(0, 1, At, B1); PG8_BAR; PG8_SCHED;
            PG8_LDA(At, 0, 1); PG8_STAGE(PG8_SB(0, 0), b2, voffB); PG8_STAGE(PG8_SB(0, 1), b2 + hstep, voffB); PG8_STAGE(PG8_SA(0, 0), a2, voffA);
            PG8_WAIT_V(8); PG8_WAIT_L(0); PG8_BAR; PG8_MMA(1, 0, At, B0); PG8_MMA(1, 1, At, B1); PG8_BAR; PG8_SCHED;
            PG8_LDB(B0, 1, 0); PG8_LDB(B1, 1, 1); PG8_SCHED; PG8_LDA(At, 1, 0); PG8_STAGE(PG8_SA(0, 1), a2 + hstep, voffA);
            PG8_WAIT_V(8); PG8_WAIT_L(0); PG8_BAR; PG8_MMA(0, 0, At, B0); PG8_MMA(0, 1, At, B1); PG8_BAR; PG8_SCHED;
            PG8_LDA(At, 1, 1); PG8_STAGE(PG8_SB(1, 0), b3, voffB); PG8_STAGE(PG8_SB(1, 1), b3 + hstep, voffB); PG8_STAGE(PG8_SA(1, 0), a3, voffA);
            PG8_WAIT_V(8); PG8_WAIT_L(0); PG8_BAR; PG8_MMA(1, 0, At, B0); PG8_MMA(1, 1, At, B1); PG8_BAR; PG8_SCHED;
            } else {
            PG8_LDB(B0, 0, 0); PG8_SCHED; PG8_LDA(At, 0, 0); PG8_STAGE(PG8_SA(1, 1), a1 + hstep, voffA);
            PG8_WAIT_L(8); PG8_BAR; PG8_WAIT_L(0); PG8_MMA(0, 0, At, B0); PG8_BAR; PG8_SCHED;
            PG8_LDB(B1, 0, 1); PG8_STAGE(PG8_SB(0, 0), b2, voffB);
            PG8_BAR; PG8_WAIT_L(0); PG8_MMA(0, 1, At, B1); PG8_BAR;
            PG8_LDA(At, 0, 1); PG8_STAGE(PG8_SA(0, 0), a2, voffA);
            PG8_BAR; PG8_WAIT_L(0); PG8_MMA(1, 0, At, B0); PG8_BAR; PG8_SCHED;
            PG8_STAGE(PG8_SB(0, 1), b2 + hstep, voffB);
            PG8_WAIT_V(6); PG8_BAR; PG8_MMA(1, 1, At, B1); PG8_BAR;
            PG8_LDB(B0, 1, 0); PG8_SCHED; PG8_LDA(At, 1, 0); PG8_STAGE(PG8_SA(0, 1), a2 + hstep, voffA);
            PG8_WAIT_L(8); PG8_BAR; PG8_WAIT_L(0); PG8_MMA(0, 0, At, B0); PG8_BAR; PG8_SCHED;
            PG8_LDB(B1, 1, 1); PG8_STAGE(PG8_SB(1, 0), b3, voffB);
            PG8_BAR; PG8_WAIT_L(0); PG8_MMA(0, 1, At, B1); PG8_BAR;
            PG8_LDA(At, 1, 1); PG8_STAGE(PG8_SA(1, 0), a3, voffA);
            PG8_BAR; PG8_WAIT_L(0); PG8_MMA(1, 0, At, B0); PG8_BAR; PG8_SCHED;
            PG8_STAGE(PG8_SB(1, 1), b3 + hstep, voffB);
            PG8_WAIT_V(6); PG8_BAR; PG8_MMA(1, 1, At, B1); PG8_BAR;
            }
        }
        if constexpr (ALIGN_EPI) { if (wr == 0) PG8_BAR; }
        if constexpr (!Epi::AFTER_DRAIN) { E(acc, cur, wr, wc, fr, fq); S.done(cur); }
        if (!has_next) break;
#pragma unroll
        for (int a = 0; a < 2; ++a)
#pragma unroll
            for (int b = 0; b < 2; ++b)
#pragma unroll
                for (int m = 0; m < 4; ++m)
#pragma unroll
                    for (int n = 0; n < 2; ++n) acc[a][b][m][n] = (f32x4){0.f, 0.f, 0.f, 0.f};
        cur = nxt; cA = nA; cB = nB; ++ui;
        if constexpr (ALIGN_EPI) { if (wr == 1) PG8_BAR; }
    }
    PG8_WAIT_V(0);
    if constexpr (!ALIGN_EPI) { if (wr == 0) PG8_BAR; }
    PG8_BAR;
    if constexpr (Epi::AFTER_DRAIN) { E.fused(acc, cur, wr, wc, fr, fq, lds, wid, lane); S.done(cur); }
#undef PG8_SA
#undef PG8_SB
#undef PG8_STAGE
#undef PG8_LDA
#undef PG8_LDB
#undef PG8_MMA
#undef PG8_WAIT_V
#undef PG8_WAIT_L
#undef PG8_BAR
#undef PG8_SCHED
}
}
#define XB_TMO      128
#define XB_XCNT(j)  (256  + 64 * (j))
#define XB_XSUB(j)  (1280 + 64 * (j))
#define XB_XGEN(j)  (2304 + 64 * (j))
#define XB_TOP      3328
#define XB_TOPGEN   3392
#define XCD_BAR_WORDS 3456
#define XB_SPIN_CAP (1u << 18)

__device__ __forceinline__ unsigned xb_ld(unsigned* p)              { return __hip_atomic_load(p, __ATOMIC_RELAXED, __HIP_MEMORY_SCOPE_AGENT); }
__device__ __forceinline__ unsigned xb_add(unsigned* p, unsigned v) { return __hip_atomic_fetch_add(p, v, __ATOMIC_RELAXED, __HIP_MEMORY_SCOPE_AGENT); }
__device__ __forceinline__ unsigned xb_xcc_id() { return (unsigned)__builtin_amdgcn_s_getreg((3 << 11) | 20) & 0xFu; }
#define XB_SPIN(cond, bar) do { unsigned _sp = 0; while (cond) { __builtin_amdgcn_s_sleep(1); \
    if ((++_sp & 255u) == 0u) { if (xb_ld(&(bar)[XB_TMO])) break; if (_sp > XB_SPIN_CAP) { atomicAdd(&(bar)[XB_TMO], 1u); break; } } } } while (0)

struct XcdBarrier {
    unsigned* bar; unsigned x;
    volatile LAS unsigned* st;
};

__device__ __forceinline__ XcdBarrier xcd_barrier_post(unsigned* bar, volatile LAS unsigned* st) {
    XcdBarrier b; b.bar = bar; b.x = xb_xcc_id(); b.st = st;
    if (threadIdx.x == 0) (void)xb_add(&bar[XB_XCNT(b.x)], 1u);
    return b;
}
__device__ __forceinline__ void xcd_barrier_complete(unsigned* bar, unsigned x, unsigned& nloc, unsigned& nx) {
    const unsigned G = gridDim.x * gridDim.y * gridDim.z;
    unsigned sum, cnt, mine, sp = 0u;
    for (;;) {
        sum = 0u; cnt = 0u; mine = 0u;
#pragma unroll
        for (unsigned j = 0; j < 16; ++j) { const unsigned c = xb_ld(&bar[XB_XCNT(j)]); sum += c; cnt += (c > 0u) ? 1u : 0u; mine = (j == x) ? c : mine; }
        if (sum == G) break;
        __builtin_amdgcn_s_sleep(1);
        if ((++sp & 255u) == 0u) { if (xb_ld(&bar[XB_TMO])) break; if (sp > XB_SPIN_CAP) { atomicAdd(&bar[XB_TMO], 1u); break; } }
    }
    nloc = mine > 0u ? mine : 1u; nx = cnt > 0u ? cnt : 1u;
}

__device__ __forceinline__ void xcd_barrier(const XcdBarrier& b) {
    asm volatile("s_waitcnt vmcnt(0)" ::: "memory");
    __syncthreads();
    if (threadIdx.x == 0) {
        unsigned* bar = b.bar;
        __builtin_amdgcn_s_waitcnt(0);
        unsigned nloc = b.st[0], nx = b.st[1];
        if (nloc == 0u) { xcd_barrier_complete(bar, b.x, nloc, nx); b.st[0] = nloc; b.st[1] = nx; }
        const unsigned old = xb_add(&bar[XB_XSUB(b.x)], 1u);
        const unsigned gen = old / nloc;
        if (old + 1u == (gen + 1u) * nloc) {
            __builtin_amdgcn_fence(__ATOMIC_RELEASE, "agent");
            asm volatile("s_waitcnt vmcnt(0)" ::: "memory");
            const unsigned og = xb_add(&bar[XB_TOP], 1u);
            const unsigned tg = og / nx;
            if (og + 1u == (tg + 1u) * nx) xb_add(&bar[XB_TOPGEN], 1u);
            else XB_SPIN(xb_ld(&bar[XB_TOPGEN]) == tg, bar);
            __builtin_amdgcn_fence(__ATOMIC_ACQUIRE, "agent");
            xb_add(&bar[XB_XGEN(b.x)], 1u);
            asm volatile("s_waitcnt vmcnt(0)" ::: "memory");
        } else {
            XB_SPIN(xb_ld(&bar[XB_XGEN(b.x)]) == gen, bar);
            __builtin_amdgcn_fence(__ATOMIC_ACQUIRE, "agent");
            asm volatile("s_waitcnt vmcnt(0)" ::: "memory");
        }
    }
    __syncthreads();
}

template <bool CONVPERM = false>
DI void p0_transpose_item(const float* W, int K, int ldw, int ncols, bf16* WT, LAS float* scr, int item, int lane, const float* rowscale = nullptr) {
    const int nblk = ncols / 32, kb = item / nblk, nb = item % nblk, k0 = 64 * kb, n0 = 32 * nb;
#pragma unroll 8
    for (int i = 0; i < 32; ++i) { const int kk = 2 * i + (lane >> 5); float wv = W[(size_t)(k0 + kk) * ldw + n0 + (lane & 31)]; if (rowscale != nullptr) wv *= rowscale[k0 + kk];
        scr[kk * 33 + (lane & 31)] = wv; }
    asm volatile("s_waitcnt lgkmcnt(0)" ::: "memory");
    const int c = lane & 7;
#pragma unroll
    for (int j = 0; j < 4; ++j) { const int n = (lane >> 3) + 8 * j; const LAS float* s = scr + (8 * c) * 33 + n;
        v4u o; o.x = pk2(s[0 * 33], s[1 * 33]); o.y = pk2(s[2 * 33], s[3 * 33]); o.z = pk2(s[4 * 33], s[5 * 33]); o.w = pk2(s[6 * 33], s[7 * 33]);
        int orow = n0 + n;
        if constexpr (CONVPERM) { const int sct = orow >> 10, ch = orow & 1023;
            orow = 256 * (ch >> 6) + 128 * (sct >> 1) + 32 * ((ch >> 4) & 3) + 8 * ((ch >> 2) & 3) + 4 * (sct & 1) + (ch & 3); }
        *(v4u*)(WT + (size_t)orow * K + k0 + 8 * c) = o; }
    asm volatile("s_waitcnt lgkmcnt(0)" ::: "memory");
}

struct Ptrs {
    const float* in[19]; float* out; unsigned char* ws; int ph_lo, ph_hi;
};

DI void p0_prologue(const Ptrs& P, LAS unsigned char* lds, int gw, int NGW, int wave, int lane) {
    LAS float* scr = (LAS float*)(lds + wave * 16384);
    unsigned char* ws = P.ws;
    constexpr int I_IN = 16 * 128, I_OUT = 16 * 32, I_SWA = 16 * 80;
    constexpr int NIT = 3 * I_IN + I_SWA + 4 * I_OUT;
    for (int it = gw; it < NIT; it += NGW) {
        int r = it;
        if (r < I_IN) { p0_transpose_item<true>(P.in[4], 1024, 4096, 4096, (bf16*)(ws + WS_W0I), scr, r, lane); continue; } r -= I_IN;
        if (r < I_IN) { p0_transpose_item(P.in[7], 1024, 4104, 4096, (bf16*)(ws + WS_W1I), scr, r, lane); continue; } r -= I_IN;
        if (r < I_IN) { p0_transpose_item(P.in[10], 1024, 4112, 4096, (bf16*)(ws + WS_W2I), scr, r, lane); continue; } r -= I_IN;
        if (r < I_SWA) { p0_transpose_item(P.in[16], 1024, 2560, 2560, (bf16*)(ws + WS_W3I), scr, r, lane, P.in[2] + 3072); continue; } r -= I_SWA;
        if (r < I_OUT) { p0_transpose_item(P.in[6], 1024, 1024, 1024, (bf16*)(ws + WS_W0O), scr, r, lane); continue; } r -= I_OUT;
        if (r < I_OUT) { p0_transpose_item(P.in[9], 1024, 1024, 1024, (bf16*)(ws + WS_W1O), scr, r, lane); continue; } r -= I_OUT;
        if (r < I_OUT) { p0_transpose_item(P.in[15], 1024, 1024, 1024, (bf16*)(ws + WS_W2O), scr, r, lane); continue; } r -= I_OUT;
        p0_transpose_item(P.in[18], 1024, 1024, 1024, (bf16*)(ws + WS_W3O), scr, r, lane);
    }
}

template <int MODE, bool XBF = false>
DI void norm_phase(const float* X, const float* nw, bf16* H, float* OUTF, const float* W, int ldw, float* oa, float* ob, const float* p0, const float* p1, const float* p2,
                   const int* pos, LAS unsigned char* lds, int gw, int NGW, int tid, int lane) {
    constexpr int NT = (MODE == 1) ? 8 : (MODE == 2 ? 16 : 0);
    LAS f32x4* thin = (LAS f32x4*)lds;
    if constexpr (NT > 0) {
        for (int i = tid; i < 1024 * (NT / 4); i += NTHR) { const int k = i / (NT / 4), c4 = i % (NT / 4);
            const f32x4 v = *(const f32x4*)(W + (size_t)k * ldw + 4096 + 4 * c4);
            const int j = k >> 8, l = (k & 255) >> 2, e = k & 3;
            thin[c4 * 1024 + (j * 4 + e) * 64 + l] = v; }
        __syncthreads();
    }
    constexpr int NR = (NT == 16) ? 2 : 4;
    f32x4 nwv[4];
#pragma unroll
    for (int j = 0; j < 4; ++j) nwv[j] = *((const f32x4*)nw + lane + 64 * j);
    for (int row0 = gw * NR; row0 < TT; row0 += NGW * NR) {
        f32x4 vv[NR][4];
#pragma unroll
        for (int rr = 0; rr < NR; ++rr) {
            if constexpr (XBF) { const v2u* xr = (const v2u*)((const bf16*)X + (size_t)(row0 + rr) * DM) + lane;
#pragma unroll
                for (int j = 0; j < 4; ++j) { const v2u u = xr[64 * j]; vv[rr][j] = (f32x4){bflo(u.x), bfhi(u.x), bflo(u.y), bfhi(u.y)}; } }
            else { const f32x4* xr = (const f32x4*)(X + (size_t)(row0 + rr) * DM) + lane;
#pragma unroll
                for (int j = 0; j < 4; ++j) vv[rr][j] = xr[64 * j]; } }
#pragma unroll
        for (int rr = 0; rr < NR; ++rr) {
        const int row = row0 + rr;
        f32x4 v[4]; float s = 0.f;
#pragma unroll
        for (int j = 0; j < 4; ++j) { v[j] = vv[rr][j]; s += (v[j].x * v[j].x + v[j].y * v[j].y) + (v[j].z * v[j].z + v[j].w * v[j].w); }
        const float r = rsqrtf(wave_sum(s) * (1.f / DM) + EPS);
#pragma unroll
        for (int j = 0; j < 4; ++j) { v[j] = v[j] * r * nwv[j]; vv[rr][j] = v[j]; }
        if constexpr (MODE == 4) {
            f32x4* o = (f32x4*)(OUTF + (size_t)row * DM) + lane;
#pragma unroll
            for (int j = 0; j < 4; ++j) o[64 * j] = v[j];
        } else {
            unsigned long long* o8 = (unsigned long long*)(H + (size_t)row * DM) + lane;
#pragma unroll
            for (int j = 0; j < 4; ++j) o8[64 * j] = (unsigned long long)pk2(v[j].x, v[j].y) | ((unsigned long long)pk2(v[j].z, v[j].w) << 32);
        }
        if constexpr (MODE == 3) {
            if (lane < 32) { const float inv = powf(10000.f, -(float)lane * (1.f / 32.f)); const float ang = (float)pos[row] * inv; float sn, cs; sincosf(ang, &sn, &cs);
                oa[(size_t)row * 64 + lane] = cs; oa[(size_t)row * 64 + 32 + lane] = sn; }
        }
        }
        if constexpr (NT > 0) {
            constexpr int RG = (NT == 16) ? 1 : NR;
#pragma unroll
            for (int r0 = 0; r0 < NR; r0 += RG) {
            f32x4 a[RG][NT / 4];
#pragma unroll
            for (int rr = 0; rr < RG; ++rr)
#pragma unroll
                for (int c = 0; c < NT / 4; ++c) a[rr][c] = (f32x4){0.f, 0.f, 0.f, 0.f};
#pragma unroll
            for (int j = 0; j < 4; ++j)
#pragma unroll
                for (int e = 0; e < 4; ++e) {
#pragma unroll
                    for (int c = 0; c < NT / 4; ++c) { const f32x4 w = thin[c * 1024 + (j * 4 + e) * 64 + lane];
#pragma unroll
                        for (int rr = 0; rr < RG; ++rr) a[rr][c] += w * vv[r0 + rr][j][e]; }
                    __builtin_amdgcn_sched_barrier(0); }
#pragma unroll
            for (int rr = 0; rr < RG; ++rr) {
                const int row = row0 + r0 + rr;
                float t8[NT / 2];
#pragma unroll
                for (int i = 0; i < NT / 2; ++i) { const float x0 = a[rr][(2 * i) >> 2][(2 * i) & 3], x1 = a[rr][(2 * i + 1) >> 2][(2 * i + 1) & 3];
                    const bool bb = lane & 1; const float mine = bb ? x1 : x0, send = bb ? x0 : x1; t8[i] = mine + __shfl_xor(send, 1); }
                float t4[NT / 4];
#pragma unroll
                for (int i = 0; i < NT / 4; ++i) { const bool bb = lane & 2; const float mine = bb ? t8[2 * i + 1] : t8[2 * i], send = bb ? t8[2 * i] : t8[2 * i + 1]; t4[i] = mine + __shfl_xor(send, 2); }
                float t2[NT / 8];
#pragma unroll
                for (int i = 0; i < NT / 8; ++i) { const bool bb = lane & 4; const float mine = bb ? t4[2 * i + 1] : t4[2 * i], send = bb ? t4[2 * i] : t4[2 * i + 1]; t2[i] = mine + __shfl_xor(send, 4); }
                float tc;
                if constexpr (NT == 16) { const bool bb = lane & 8; const float mine = bb ? t2[1] : t2[0], send = bb ? t2[0] : t2[1]; tc = mine + __shfl_xor(send, 8); }
                else { tc = t2[0]; tc += __shfl_xor(tc, 8); }
                tc += __shfl_xor(tc, 16); tc += __shfl_xor(tc, 32);
                if constexpr (MODE == 1) {
                    if (lane < 8) { const float xx = tc + p0[lane]; oa[(size_t)row * 8 + lane] = fminf(xx, 0.f) - log1pf(__expf(-fabsf(xx))); }
                } else {
                    const float ma = __shfl(tc, (lane + 8) & 63);
                    if (lane < 8) { oa[(size_t)row * 8 + lane] = 1.f / (1.f + __expf(-tc));
                        ob[(size_t)row * 8 + lane] = -__expf(p0[lane]) * softplus_f(ma + p1[lane]); }
                }
            }
            }
        }
    }
    if constexpr (NT > 0) __syncthreads();
}

DI void convgate_phase(const bf16* PROJ, const float* wconv, bf16* Y, int gtid, int NG) {
    for (int it = gtid; it < (TT / 32) * 128; it += NG) {
        const int oct = it & 127, chunk = it >> 7, r0 = chunk * 32, c0 = oct * 8;
        float w0[8], w1[8], w2[8];
#pragma unroll
        for (int e = 0; e < 8; ++e) { w0[e] = wconv[c0 + e]; w1[e] = wconv[1024 + c0 + e]; w2[e] = wconv[2048 + c0 + e]; }
        float p2[8], p1[8];
#pragma unroll
        for (int e = 0; e < 8; ++e) { p2[e] = 0.f; p1[e] = 0.f; }
        if ((r0 & (SEQ - 1)) != 0) {
#pragma unroll
            for (int d = 2; d >= 1; --d) { const bf16* rp = PROJ + (size_t)(r0 - d) * 4096 + c0;
                const v4u cc = *(const v4u*)(rp + 1024), vv = *(const v4u*)(rp + 2048);
#pragma unroll
                for (int e = 0; e < 4; ++e) { const float a = bflo(cc[e]) * bflo(vv[e]), b = bfhi(cc[e]) * bfhi(vv[e]);
                    if (d == 2) { p2[2 * e] = a; p2[2 * e + 1] = b; } else { p1[2 * e] = a; p1[2 * e + 1] = b; } } }
        }
#pragma unroll 4
        for (int r = 0; r < 32; ++r) {
            const bf16* rp = PROJ + (size_t)(r0 + r) * 4096 + c0;
            const v4u bb = *(const v4u*)(rp), cc = *(const v4u*)(rp + 1024), vv = *(const v4u*)(rp + 2048), zz = *(const v4u*)(rp + 3072);
            float y[8];
#pragma unroll
            for (int e = 0; e < 4; ++e) {
                const float cv0 = bflo(cc[e]) * bflo(vv[e]), cv1 = bfhi(cc[e]) * bfhi(vv[e]);
                const float o0 = w0[2 * e] * p2[2 * e] + w1[2 * e] * p1[2 * e] + w2[2 * e] * cv0;
                const float o1 = w0[2 * e + 1] * p2[2 * e + 1] + w1[2 * e + 1] * p1[2 * e + 1] + w2[2 * e + 1] * cv1;
                p2[2 * e] = p1[2 * e]; p1[2 * e] = cv0; p2[2 * e + 1] = p1[2 * e + 1]; p1[2 * e + 1] = cv1;
                y[2 * e] = bflo(bb[e]) * o0 * silu_f(bflo(zz[e])); y[2 * e + 1] = bfhi(bb[e]) * o1 * silu_f(bfhi(zz[e]));
            }
            v4u o; o.x = pk2(y[0], y[1]); o.y = pk2(y[2], y[3]); o.z = pk2(y[4], y[5]); o.w = pk2(y[6], y[7]);
            *(v4u*)(Y + (size_t)(r0 + r) * 1024 + c0) = o;
        }
    }
}

DI void convfix_phase(const float* CVH, const float* BND, const float* wconv, bf16* Y, int gtid, int NG) {
    for (int it = gtid; it < 512 * 2 * 256; it += NG) {
        const int c4 = it & 255, r = (it >> 8) & 1, g = it >> 9, ch0 = 4 * c4;
        const float* bp = BND + ((size_t)g * 2 + r) * 3 * 1024 + ch0;
        const f32x4 b = *(const f32x4*)bp, z = *(const f32x4*)(bp + 1024), cv = *(const f32x4*)(bp + 2048);
        f32x4 cm1 = (f32x4){0.f, 0.f, 0.f, 0.f}, cm2 = (f32x4){0.f, 0.f, 0.f, 0.f};
        const bool first = (g & 255) == 0;
        if (r == 0) { if (!first) { cm1 = *(const f32x4*)(CVH + ((size_t)(g - 1) * 2 + 1) * 1024 + ch0); cm2 = *(const f32x4*)(CVH + ((size_t)(g - 1) * 2) * 1024 + ch0); } }
        else { cm1 = *(const f32x4*)(BND + ((size_t)g * 2) * 3 * 1024 + 2048 + ch0); if (!first) cm2 = *(const f32x4*)(CVH + ((size_t)(g - 1) * 2 + 1) * 1024 + ch0); }
        const f32x4 w0 = *(const f32x4*)(wconv + ch0), w1 = *(const f32x4*)(wconv + 1024 + ch0), w2 = *(const f32x4*)(wconv + 2048 + ch0);
        float y[4];
#pragma unroll
        for (int e = 0; e < 4; ++e) y[e] = b[e] * (w0[e] * cm2[e] + w1[e] * cm1[e] + w2[e] * cv[e]) * silu_f(z[e]);
        v2u o; o.x = pk2(y[0], y[1]); o.y = pk2(y[2], y[3]);
        *(v2u*)(Y + ((size_t)g * 64 + r) * 1024 + ch0) = o;
    }
}
DI int crow32(int i, int hi) { return (i & 3) + 8 * (i >> 2) + 4 * hi; }
DI int perm16(int p) { return (p & 3) | ((p & 4) << 1) | ((p & 8) >> 1); }
#define MFMA32(a, b, c) __builtin_amdgcn_mfma_f32_32x32x16_bf16((a), (b), (c), 0, 0, 0)
#define MFMA16(a, b, c) __builtin_amdgcn_mfma_f32_16x16x32_bf16((a), (b), (c), 0, 0, 0)

DI void fox_cumsum(const float* LOGF, float* CUM, int bh, LAS unsigned char* lds, int tid) {
    LAS double* tot = (LAS double*)lds;
    const int b = bh >> 3, h = bh & 7;
    const float* src = LOGF + ((size_t)b * SEQ + 32 * tid) * 8 + h;
    float v[32]; double s = 0.0;
#pragma unroll
    for (int i = 0; i < 32; ++i) { v[i] = src[i * 8]; s += (double)v[i]; }
    double inc = s;
    const int ln = tid & 63, wv = tid >> 6;
#pragma unroll
    for (int o = 1; o < 64; o <<= 1) { const double t = __shfl_up(inc, o); if (ln >= o) inc += t; }
    if (ln == 63) tot[wv] = inc;
    __syncthreads();
    double pre = inc - s;
    for (int i = 0; i < wv; ++i) pre += tot[i];
    float* dst = CUM + (size_t)bh * SEQ + 32 * tid;
#pragma unroll
    for (int i = 0; i < 32; ++i) { pre += (double)v[i]; dst[i] = (float)pre; }
    __syncthreads();
}

DI void fox_norms_phase(const bf16* PROJ, float* NRMT, int gw, int NGW, int lane) {
    for (int it = gw; it < 16 * 256; it += NGW) {
        const int bh = it >> 8, tl = it & 255, b = bh >> 3, h = bh & 7;
        const size_t r0 = (size_t)b * SEQ + 64 * tl;
        float mk = 0.f;
#pragma unroll
        for (int rr = 0; rr < 8; ++rr) {
            const int row = 8 * rr + (lane >> 3), seg = lane & 7; const bf16* qp = PROJ + (r0 + row) * 4096 + h * 128 + 16 * seg;
            const v4u b0 = *(const v4u*)(qp + 1024), b1 = *(const v4u*)(qp + 1032);
            float sk = 0.f;
#pragma unroll
            for (int e = 0; e < 4; ++e) sk += bflo(b0[e]) * bflo(b0[e]) + bfhi(b0[e]) * bfhi(b0[e]) + bflo(b1[e]) * bflo(b1[e]) + bfhi(b1[e]) * bfhi(b1[e]);
#pragma unroll
            for (int o = 1; o < 8; o <<= 1) sk += __shfl_xor(sk, o);
            mk = fmaxf(mk, sk);
        }
#pragma unroll
        for (int o = 8; o < 64; o <<= 1) mk = fmaxf(mk, __shfl_xor(mk, o));
        if (lane == 0) NRMT[(size_t)it * 2 + 1] = mk;
    }
}

constexpr int FX_KB = 64 * 272, FX_VB = 64 * 320;
typedef short v4i16_t __attribute__((ext_vector_type(4)));
DI v4i16_t fx_vtr(const LAS unsigned char* p) { return __builtin_amdgcn_ds_read_tr16_b64_v4i16((LAS v4i16_t*)p); }
DI void fox_attn_phase(const bf16* PROJ, const float* CUM, bf16* Y, const float* NRMT, unsigned* QCTR, LAS unsigned char* lds, int bid, int G, int tid, int wave, int lane) {
    LAS unsigned char* Kb = lds; LAS unsigned char* Vb = lds + 2 * FX_KB; LAS float* Bs = (LAS float*)(lds + 2 * FX_KB + 2 * FX_VB);
    const int r = lane & 31, hi = lane >> 5;
    const float SQD = 11.313708498984761f;
    const float c2 = 0.08838834764831845f * 1.4426950408889634f;
    LAS unsigned* Qs = (LAS unsigned*)(lds + 2 * FX_KB + 2 * FX_VB + 512);
    LAS float* Mq = (LAS float*)(lds + 2 * FX_KB + 2 * FX_VB + 704);
    LAS float* Ms = (LAS float*)(lds + 2 * FX_KB + 2 * FX_VB + 576);
    for (;;) {
        if (tid == 0) Qs[0] = atomicAdd(QCTR, 1u);
        __syncthreads();
        const int e = (int)Qs[0];
        __syncthreads();
        if (e >= 1024) break;
        {
            const int bh = e & 15, qb = 63 - (e >> 4), b = bh >> 3, h = bh & 7;
            const int q0 = qb * 256, ntiles = 4 * (qb + 1);
            const float cref = CUM[(size_t)bh * SEQ + q0];
            const int qmin = q0 + 32 * wave;
            bf16x8 Qf[8];
            { const bf16* qp = PROJ + ((size_t)b * SEQ + qmin + r) * 4096 + h * 128 + 8 * hi;
#pragma unroll
              for (int ks = 0; ks < 8; ++ks) Qf[ks] = *(const bf16x8*)(qp + 16 * ks); }
            { float qn = 0.f;
#pragma unroll
              for (int ks = 0; ks < 8; ++ks) { const v4u w = __builtin_bit_cast(v4u, Qf[ks]);
#pragma unroll
                  for (int e = 0; e < 4; ++e) qn += bflo(w[e]) * bflo(w[e]) + bfhi(w[e]) * bfhi(w[e]); }
              qn += __shfl_xor(qn, 32);
#pragma unroll
              for (int o = 1; o < 32; o <<= 1) qn = fmaxf(qn, __shfl_xor(qn, o));
              if (lane == 0) Mq[wave] = qn; }
            __syncthreads();
            int jstart; float Bq;
            { float mq = Mq[0], mk = 0.f;
#pragma unroll
              for (int w = 1; w < 8; ++w) mq = fmaxf(mq, Mq[w]);
#pragma unroll
              for (int u = 0; u < 4; ++u) mk = fmaxf(mk, NRMT[((size_t)bh * 256 + lane + 64 * u) * 2 + 1]);
#pragma unroll
              for (int o = 1; o < 64; o <<= 1) mk = fmaxf(mk, __shfl_xor(mk, o));
              Bq = sqrtf(mq * mk);
              const float B2 = 2.f * Bq * 0.08838834764831845f;
              const float thr = -(30.f + B2);
              const int jc = (lane * (4 * qb)) >> 6;
              const bool live = (qb == 0) ? true : ((cref - CUM[(size_t)bh * SEQ + 64 * jc + 63]) > thr);
              const unsigned long long m = __ballot(live);
              const int fl = (m == 0ull) ? 64 : (__ffsll((long long)m) - 1);
              const int pl = fl > 0 ? fl - 1 : 0;
              jstart = (qb == 0) ? 0 : ((pl * (4 * qb)) >> 6);
              jstart = __builtin_amdgcn_readfirstlane(jstart); }
            f32x16 O[4];
#pragma unroll
            for (int dt = 0; dt < 4; ++dt)
#pragma unroll
                for (int i = 0; i < 16; ++i) O[dt][i] = 0.f;
            float m_old = -INFINITY, lsum = 0.f;
            const bf16* kg[2]; const bf16* vg[2]; int klds[2], vlds[2];
#pragma unroll
            for (int u = 0; u < 2; ++u) { const int p = tid + 512 * u;
                kg[u] = PROJ + ((size_t)b * SEQ + (p >> 4)) * 4096 + 1024 + h * 128 + 8 * (p & 15); klds[u] = (p >> 4) * 272 + (p & 15) * 16;
                vg[u] = PROJ + ((size_t)b * SEQ + (p >> 4)) * 4096 + 2048 + h * 128 + 8 * (p & 15); vlds[u] = (p >> 4) * 320 + (p & 15) * 16; }
            v4u kr[2], vr[2]; float br = 0.f;
            const int jlast = ntiles - 1;
#pragma unroll
            for (int u = 0; u < 2; ++u) { kr[u] = *(const v4u*)(kg[u] + (size_t)jlast * 64 * 4096); vr[u] = *(const v4u*)(vg[u] + (size_t)jlast * 64 * 4096); }
            if (tid < 64) br = (cref - CUM[(size_t)bh * SEQ + jlast * 64 + tid]) * SQD;
#pragma unroll
            for (int u = 0; u < 2; ++u) { *(LAS v4u*)(Kb + (jlast & 1) * FX_KB + klds[u]) = kr[u]; *(LAS v4u*)(Vb + (jlast & 1) * FX_VB + vlds[u]) = vr[u]; }
            if (tid < 64) Bs[(jlast & 1) * 64 + tid] = br;
            __syncthreads();
            for (int j = jlast; j >= jstart; --j) {
                const int cur = j & 1, nxt = cur ^ 1;
                if (j > jstart) {
#pragma unroll
                    for (int u = 0; u < 2; ++u) { kr[u] = *(const v4u*)(kg[u] + (size_t)(j - 1) * 64 * 4096); vr[u] = *(const v4u*)(vg[u] + (size_t)(j - 1) * 64 * 4096); }
                    if (tid < 64) br = (cref - CUM[(size_t)bh * SEQ + (j - 1) * 64 + tid]) * SQD;
                }
                if (64 * j <= qmin + 31) {
                    LAS unsigned char* Kc = Kb + cur * FX_KB; LAS unsigned char* Vc = Vb + cur * FX_VB; LAS float* Bc = Bs + cur * 64;
                    f32x16 S[2];
#pragma unroll
                    for (int sub = 0; sub < 2; ++sub) {
#pragma unroll
                        for (int g = 0; g < 4; ++g) { const f32x4 bv = *(const LAS f32x4*)(Bc + 32 * sub + 8 * g + 4 * hi);
                            S[sub][4 * g] = bv.x; S[sub][4 * g + 1] = bv.y; S[sub][4 * g + 2] = bv.z; S[sub][4 * g + 3] = bv.w; }
#pragma unroll
                        for (int ks = 0; ks < 8; ++ks) { const bf16x8 a = *(const LAS bf16x8*)(Kc + (32 * sub + r) * 272 + (16 * ks + 8 * hi) * 2);
                            S[sub] = MFMA32(a, Qf[ks], S[sub]); }
                    }
                    if (64 * j + 63 > qmin) {
                        const int qi = qmin + r;
#pragma unroll
                        for (int sub = 0; sub < 2; ++sub)
#pragma unroll
                            for (int i = 0; i < 16; ++i) { const int key = 64 * j + 32 * sub + crow32(i, hi); if (key > qi) S[sub][i] = -INFINITY; }
                    }
                    float mx = S[0][0];
#pragma unroll
                    for (int i = 1; i < 16; ++i) mx = fmaxf(mx, S[0][i]);
#pragma unroll
                    for (int i = 0; i < 16; ++i) mx = fmaxf(mx, S[1][i]);
                    mx = fmaxf(mx, __shfl_xor(mx, 32));
                    const float m_new = fmaxf(m_old, mx);
                    const float alpha = __builtin_amdgcn_exp2f((m_old - m_new) * c2);
                    const float nm = -m_new * c2;
                    m_old = m_new;
                    float ps = 0.f;
#pragma unroll
                    for (int sub = 0; sub < 2; ++sub)
#pragma unroll
                        for (int i = 0; i < 16; ++i) { const float p = __builtin_amdgcn_exp2f(fmaf(S[sub][i], c2, nm)); S[sub][i] = p; ps += p; }
                    lsum = lsum * alpha + ps;
                    if (!__all(alpha == 1.f)) {
#pragma unroll
                        for (int dt = 0; dt < 4; ++dt)
#pragma unroll
                            for (int i = 0; i < 16; ++i) O[dt][i] *= alpha;
                    }
                    __builtin_amdgcn_sched_barrier(0);
                    bf16x8 Pf[4];
#pragma unroll
                    for (int kk = 0; kk < 4; ++kk) { const int sub = kk >> 1, s = kk & 1; v4u w;
                        w.x = pk2(S[sub][8 * s], S[sub][8 * s + 1]); w.y = pk2(S[sub][8 * s + 2], S[sub][8 * s + 3]);
                        w.z = pk2(S[sub][8 * s + 4], S[sub][8 * s + 5]); w.w = pk2(S[sub][8 * s + 6], S[sub][8 * s + 7]);
                        Pf[kk] = __builtin_bit_cast(bf16x8, w); }
#pragma unroll
                    for (int dt = 0; dt < 4; ++dt) { __builtin_amdgcn_sched_barrier(0);
#pragma unroll
                        for (int kk = 0; kk < 4; ++kk) {
                            const LAS unsigned char* vp = Vc + (16 * kk + 4 * hi + ((lane & 15) >> 2)) * 320 + 64 * dt + 32 * ((lane >> 4) & 1) + 8 * (lane & 3);
                            const v4i16_t lo = fx_vtr(vp), hi4 = fx_vtr(vp + 8 * 320);
                            const bf16x8 a = __builtin_shufflevector(lo, hi4, 0, 1, 2, 3, 4, 5, 6, 7);
                            O[dt] = MFMA32(a, Pf[kk], O[dt]); } }
                }
                { float mm = m_old;
#pragma unroll
                  for (int o = 1; o < 32; o <<= 1) mm = fminf(mm, __shfl_xor(mm, o));
                  if (lane == 0) Ms[cur * 8 + wave] = mm; }
                if (j > jstart) {
#pragma unroll
                    for (int u = 0; u < 2; ++u) { *(LAS v4u*)(Kb + nxt * FX_KB + klds[u]) = kr[u]; *(LAS v4u*)(Vb + nxt * FX_VB + vlds[u]) = vr[u]; }
                    if (tid < 64) Bs[nxt * 64 + tid] = br;
                }
                __syncthreads();
                if (j > jstart) { float mn = Ms[cur * 8];
#pragma unroll
                    for (int w = 1; w < 8; ++w) mn = fminf(mn, Ms[cur * 8 + w]);
                    if ((Bq + Bs[nxt * 64 + 63] - mn) * 0.08838834764831845f <= -30.f) break; }
            }
            const float lt = lsum + __shfl_xor(lsum, 32);
            const float inv = 1.f / lt;
            const size_t trow = (size_t)b * SEQ + qmin + r;
#pragma unroll
            for (int dt = 0; dt < 4; ++dt)
#pragma unroll
                for (int g = 0; g < 4; ++g) { const int d = 32 * dt + 8 * g + 4 * hi;
                    const v2u z = *(const v2u*)(PROJ + trow * 4096 + 3072 + h * 128 + d);
                    const float y0 = O[dt][4 * g] * inv * silu_f(bflo(z.x)), y1 = O[dt][4 * g + 1] * inv * silu_f(bfhi(z.x));
                    const float y2 = O[dt][4 * g + 2] * inv * silu_f(bflo(z.y)), y3 = O[dt][4 * g + 3] * inv * silu_f(bfhi(z.y));
                    v2u o; o.x = pk2(y0, y1); o.y = pk2(y2, y3);
                    *(v2u*)(Y + trow * 1024 + h * 128 + d) = o; }
        }
    }
}
DI int kperm(int s, int q, int jj) { return 32 * s + 16 * (jj >> 2) + 4 * q + (jj & 3); }
DI bf16x8 pack_acc2(const f32x4& X, const f32x4& Y) { v4u w; w.x = pk2(X[0], X[1]); w.y = pk2(X[2], X[3]); w.z = pk2(Y[0], Y[1]); w.w = pk2(Y[2], Y[3]); return __builtin_bit_cast(bf16x8, w); }

DI void st16_wt(void* p, v4u v) {
    __hip_atomic_store((unsigned long long*)p, (unsigned long long)v.x | ((unsigned long long)v.y << 32), __ATOMIC_RELAXED, __HIP_MEMORY_SCOPE_AGENT);
    __hip_atomic_store((unsigned long long*)p + 1, (unsigned long long)v.z | ((unsigned long long)v.w << 32), __ATOMIC_RELAXED, __HIP_MEMORY_SCOPE_AGENT);
}
template <bool DRY>
DI void gdn_prep_phase(bf16* PROJ, bf16* DRYBUF, const bf16* HALO, const float* wconv, const float* BETA, const float* GG, unsigned char* EX, float* GL, unsigned* FLAG,
                       LAS unsigned char* lds, int bid, int G, int FIRST, int tid, int wave, int lane) {
    LAS bf16* QB = (LAS bf16*)lds; LAS bf16* KB = (LAS bf16*)(lds + 17408); LAS bf16* VBt = (LAS bf16*)(lds + 34816);
    LAS float* Lm = (LAS float*)(lds + 52224); LAS float* Tm = (LAS float*)(lds + 68864); LAS float* QKm = (LAS float*)(lds + 85504);
    LAS float* gcS = (LAS float*)(lds + 102144); LAS float* btS = (LAS float*)(lds + 102400); LAS float* Mt = (LAS float*)(lds + 102656);
    for (int e0 = bid - FIRST; e0 < 4096; e0 += G - FIRST) {
        const int bh = e0 & 15, n = e0 >> 4, it = bh * 256 + n, b = bh >> 3, h = bh & 7;
        const size_t t0 = (size_t)b * SEQ + 64 * n;
        if (tid < 64) { float gv = GG[(t0 + tid) * 8 + h]; btS[tid] = BETA[(t0 + tid) * 8 + h];
#pragma unroll
            for (int o = 1; o < 64; o <<= 1) { const float tv = __shfl_up(gv, o); if (lane >= o) gv += tv; }
            gcS[tid] = gv; }
        for (int e = tid; e < 6 * 256; e += NTHR) { const int bq = e >> 8, r = (e >> 4) & 15, c = e & 15;
            const int bi = (bq < 3) ? 0 : (bq < 5 ? 1 : 2), bj = (bq < 3) ? bq + 1 : (bq < 5 ? bq - 1 : 3);
            Tm[(16 * bi + r) * 65 + 16 * bj + c] = 0.f; }
#pragma unroll 3
        for (int st = 0; st < 6; ++st) {
            const int idx = wave * 6 + st, mat = idx >> 4, rg = idx & 15;
            const int row = 4 * rg + (lane >> 4), oct = lane & 15, colg = mat * 1024 + h * 128 + 8 * oct;
            float a[8];
#pragma unroll
            for (int e = 0; e < 8; ++e) a[e] = 0.f;
#pragma unroll
            for (int kk = 0; kk < 4; ++kk) {
                const int rr = row - 3 + kk;
                v4u v = (v4u){0u, 0u, 0u, 0u};
                if (rr >= 0) v = *(const v4u*)(PROJ + (t0 + rr) * 4096 + colg);
                else if (n > 0) v = *(const v4u*)(HALO + ((size_t)(b * 256 + n - 1) * 3 + (rr + 3)) * 3072 + colg);
                const f32x4 w0 = *(const f32x4*)(wconv + kk * 3072 + colg), w1 = *(const f32x4*)(wconv + kk * 3072 + colg + 4);
                a[0] += w0.x * bflo(v.x); a[1] += w0.y * bfhi(v.x); a[2] += w0.z * bflo(v.y); a[3] += w0.w * bfhi(v.y);
                a[4] += w1.x * bflo(v.z); a[5] += w1.y * bfhi(v.z); a[6] += w1.z * bflo(v.w); a[7] += w1.w * bfhi(v.w);
            }
            float ss = 0.f;
#pragma unroll
            for (int e = 0; e < 8; ++e) { a[e] = silu_f(a[e]); ss += a[e] * a[e]; }
            ss += __shfl_xor(ss, 1); ss += __shfl_xor(ss, 2); ss += __shfl_xor(ss, 4); ss += __shfl_xor(ss, 8);
            float rs = 1.f;
            if (mat == 0) rs = rsqrtf(ss + EPS) * 0.08838834764831845f; else if (mat == 1) rs = rsqrtf(ss + EPS);
            v4u o; o.x = pk2(a[0] * rs, a[1] * rs); o.y = pk2(a[2] * rs, a[3] * rs); o.z = pk2(a[4] * rs, a[5] * rs); o.w = pk2(a[6] * rs, a[7] * rs);
            LAS bf16* dst = (mat == 0 ? QB : (mat == 1 ? KB : VBt)) + row * 136 + 8 * oct;
            *(LAS v4u*)dst = o;
        }
        __syncthreads();
        { const int isq = wave >> 2, m = wave & 3, r16 = lane & 15, q = lane >> 4;
          LAS bf16* As = isq ? QB : KB;
          bf16x8 af[4];
#pragma unroll
          for (int s = 0; s < 4; ++s) af[s] = *(const LAS bf16x8*)(As + (16 * m + r16) * 136 + 32 * s + 8 * q);
#pragma unroll
          for (int nt = 0; nt < 4; ++nt) { f32x4 acc = (f32x4){0.f, 0.f, 0.f, 0.f};
#pragma unroll
              for (int s = 0; s < 4; ++s) { const bf16x8 bfr = *(const LAS bf16x8*)(KB + (16 * nt + r16) * 136 + 32 * s + 8 * q); acc = MFMA16(af[s], bfr, acc); }
#pragma unroll
              for (int jj = 0; jj < 4; ++jj) { const int i = 16 * m + 4 * q + jj, j = 16 * nt + r16;
                  const float dec = __expf(fminf(gcS[i] - gcS[j], 0.f));
                  if (!isq) Lm[i * 65 + j] = (i > j) ? acc[jj] * btS[i] * dec : 0.f;
                  else QKm[i * 65 + j] = (i >= j) ? acc[jj] * dec : 0.f; } }
        }
        __syncthreads();
        const float gl = gcS[63];
        if (wave == 0) {
            const int blk = lane >> 4, col = lane & 15; const LAS float* Lb = Lm + (16 * blk) * 65 + 16 * blk;
            float t[16];
#pragma unroll
            for (int r = 0; r < 16; ++r) { float a = (r == col) ? 1.f : 0.f;
#pragma unroll
                for (int x = 0; x < r; ++x) a -= Lb[r * 65 + x] * t[x];
                t[r] = a; }
#pragma unroll
            for (int r = 0; r < 16; ++r) Tm[(16 * blk + r) * 65 + 16 * blk + col] = t[r];
        } else {
#pragma unroll 1
            for (int p0 = tid - 64; p0 < 4608; p0 += 448) {
                const int sect = p0 >> 10, p = p0 & 1023, l = p & 63, f = p >> 6, q = l >> 4, r16 = l & 15;
                v4u o;
                bf16* dst;
                if (sect == 0) {
                    const int m = f >> 2, s = f & 3, i = 16 * m + r16, c0 = 32 * s + 4 * q;
                    LAS bf16* src = QB + i * 136 + c0;
                    const v2u x0 = *(const LAS v2u*)src, x1 = *(const LAS v2u*)(src + 16);
                    const float sc = __expf(gcS[i]);
                    o.x = pk2(bflo(x0.x) * sc, bfhi(x0.x) * sc); o.y = pk2(bflo(x0.y) * sc, bfhi(x0.y) * sc);
                    o.z = pk2(bflo(x1.x) * sc, bfhi(x1.x) * sc); o.w = pk2(bflo(x1.y) * sc, bfhi(x1.y) * sc);
                    dst = PROJ + (t0 + (p >> 4)) * 4096 + h * 128 + (p & 15) * 8;
                } else if (sect == 1) {
                    o = *(const LAS v4u*)(KB + (p >> 4) * 136 + (p & 15) * 8);
                    dst = PROJ + (t0 + (p >> 4)) * 4096 + 1024 + h * 128 + (p & 15) * 8;
                } else if (sect == 2) {
                    const int w = p >> 7, ll = (p & 127) >> 1, half = p & 1; float y[8];
#pragma unroll
                    for (int jj = 0; jj < 8; ++jj) { const int m = half * 2 + (jj >> 2), rowi = 16 * m + 4 * (ll >> 4) + (jj & 3);
                        y[jj] = bf2f(VBt[rowi * 136 + 16 * w + (ll & 15)]) * btS[rowi]; }
                    o.x = pk2(y[0], y[1]); o.y = pk2(y[2], y[3]); o.z = pk2(y[4], y[5]); o.w = pk2(y[6], y[7]);
                    dst = PROJ + (t0 + (p >> 4)) * 4096 + 2048 + h * 128 + (p & 15) * 8;
                } else if (sect == 3) {
                    if (p >= 32) continue;
                    float y[4];
#pragma unroll
                    for (int jj = 0; jj < 4; ++jj) { const int i = 4 * (p & 15) + jj; y[jj] = (p < 16) ? -btS[i] * __expf(gcS[i]) : __expf(gl - gcS[i]); }
                    o.x = __builtin_bit_cast(unsigned, y[0]); o.y = __builtin_bit_cast(unsigned, y[1]); o.z = __builtin_bit_cast(unsigned, y[2]); o.w = __builtin_bit_cast(unsigned, y[3]);
                    dst = (bf16*)(EX + (size_t)it * 32768 + p * 16);
                } else {
                    const int m = f >> 1, s = f & 1, i = 16 * m + r16; float y[8];
#pragma unroll
                    for (int jj = 0; jj < 8; ++jj) y[jj] = QKm[i * 65 + kperm(s, q, jj)];
                    o.x = pk2(y[0], y[1]); o.y = pk2(y[2], y[3]); o.z = pk2(y[4], y[5]); o.w = pk2(y[6], y[7]);
                    dst = (bf16*)(EX + (size_t)it * 32768 + 24576 + p * 16);
                }
                if (DRY) { dst = DRYBUF + (size_t)(it & 255) * 40960 + p0 * 8; *(v4u*)dst = o; } else st16_wt(dst, o);
            }
        }
        __syncthreads();
#pragma unroll 1
        for (int d = 1; d <= 3; ++d) {
            const int nel = (4 - d) * 256;
            for (int e = tid; e < nel; e += NTHR) { const int bj = e >> 8, r = (e >> 4) & 15, c = e & 15, bi = bj + d;
                const LAS float* Lr = Lm + (16 * bi + r) * 65; const LAS float* Tc = Tm + 16 * bj + c; float a = 0.f;
#pragma unroll 16
                for (int y = 16 * bj; y < 16 * bi; ++y) a += Lr[y] * Tc[y * 65];
                Mt[(16 * bi + r) * 65 + 16 * bj + c] = a; }
            __syncthreads();
            for (int e = tid; e < nel; e += NTHR) { const int bj = e >> 8, r = (e >> 4) & 15, c = e & 15, bi = bj + d;
                const LAS float* Dr = Tm + (16 * bi + r) * 65 + 16 * bi; const LAS float* Mc = Mt + (16 * bi) * 65 + 16 * bj + c; float a = 0.f;
#pragma unroll
                for (int x = 0; x < 16; ++x) a += Dr[x] * Mc[x * 65];
                Tm[(16 * bi + r) * 65 + 16 * bj + c] = -a; }
            __syncthreads();
        }
        { const int p = tid, l = p & 63, f = p >> 6, q = l >> 4, r16 = l & 15, m = f >> 1, s = f & 1, i = 16 * m + r16; float y[8];
#pragma unroll
          for (int jj = 0; jj < 8; ++jj) y[jj] = Tm[i * 65 + kperm(s, q, jj)];
          v4u o; o.x = pk2(y[0], y[1]); o.y = pk2(y[2], y[3]); o.z = pk2(y[4], y[5]); o.w = pk2(y[6], y[7]);
          if (DRY) *(v4u*)(DRYBUF + (size_t)(it & 255) * 40960 + 36864 + p * 8) = o; else st16_wt(EX + (size_t)it * 32768 + 16384 + p * 16, o);
          if (tid == 0 && !DRY) __hip_atomic_store(GL + it, __expf(gl), __ATOMIC_RELAXED, __HIP_MEMORY_SCOPE_AGENT); }
        asm volatile("s_waitcnt vmcnt(0)" ::: "memory");
        __syncthreads();
        if (tid == 0 && !DRY) __hip_atomic_store(FLAG + it, 1u, __ATOMIC_RELAXED, __HIP_MEMORY_SCOPE_AGENT);
    }
}

constexpr int GS_BUF = 57344;
constexpr int GS_QA = 18432, GS_SC = 34816, GS_TA = 36864, GS_QK = 45056, GS_VB = 53248;
DI void gdn_scan_phase(const bf16* PROJ, const unsigned char* EX, const float* GL, const unsigned* FLAG, bf16* ORAW, LAS unsigned char* lds, int bid, int tid, int wave, int lane) {
    if (bid >= 64) return;
    const int bh = bid >> 2, sub = bid & 3, b = bh >> 3, h = bh & 7, q = lane >> 4, r16 = lane & 15;
    LAS unsigned char* OB = lds + 2 * GS_BUF;
    LAS float* GLs = (LAS float*)(lds + 2 * GS_BUF + 8192);
    if (wave >= 2) {
        const int g = (wave - 2) >> 1, i = tid & 127, rowi = i >> 4, pc = i & 15;
        v4u R0[9], R1[9], R2[9]; float G0, G1, G2;
#define GS_LD(R_, G_, n_) do { G_ = GL[bh * 256 + (n_)]; const size_t t0_ = (size_t)b * SEQ + 64 * (n_); const unsigned char* ex_ = EX + (size_t)(bh * 256 + (n_)) * 32768; \
        _Pragma("unroll") for (int u = 0; u < 9; ++u) { const int c = g + 3 * u; const int k = c < 17 ? c : c + 7; \
            const unsigned char* base_; size_t stride_; \
            if (k < 8) { base_ = (const unsigned char*)(PROJ + (t0_ + 8 * k) * 4096 + 1024 + h * 128); stride_ = 8192; } \
            else if (k < 16) { base_ = (const unsigned char*)(PROJ + (t0_ + 8 * (k - 8)) * 4096 + h * 128); stride_ = 8192; } \
            else if (k < 32) { base_ = ex_ + (size_t)(k - 16) * 2048; stride_ = 256; } \
            else { base_ = (const unsigned char*)(PROJ + (t0_ + 8 * (2 * sub + (k - 32))) * 4096 + 2048 + h * 128); stride_ = 8192; } \
            R_[u] = *(const v4u*)(base_ + (size_t)rowi * stride_ + pc * 16); } } while (0)
#define GS_ST(R_, G_, n_, buf_) do { if (g == 0 && i == 0) GLs[(n_)] = G_; _Pragma("unroll") for (int u = 0; u < 9; ++u) { const int c = g + 3 * u; const int k = c < 17 ? c : c + 7; \
            int d_; if (k < 8) d_ = (8 * k + rowi) * 288 + pc * 16; else if (k < 16) d_ = GS_QA + (k - 8) * 2048 + i * 16; else if (k == 16) d_ = GS_SC + i * 16; \
            else if (k < 28) d_ = GS_TA + (k - 24) * 2048 + i * 16; else if (k < 32) d_ = GS_QK + (k - 28) * 2048 + i * 16; else d_ = GS_VB + (k - 32) * 2048 + i * 16; \
            *(LAS v4u*)((buf_) + d_) = R_[u]; } } while (0)
#define GS_OUT(n_) do { if (g == 2) { const size_t t0_ = (size_t)b * SEQ + 64 * (n_); \
        _Pragma("unroll") for (int u = 0; u < 2; ++u) { const int p = i + 128 * u, row = p >> 2, c = p & 3; \
            const v4u v = *(const LAS v4u*)(OB + ((n_) & 1) * 4096 + row * 64 + c * 16); \
            *(v4u*)(ORAW + (t0_ + row) * 1024 + h * 128 + 32 * sub + 8 * c) = v; } } } while (0)
        __syncthreads();
        GS_LD(R0, G0, 0); GS_LD(R1, G1, 1); GS_LD(R2, G2, 2);
        GS_ST(R0, G0, 0, lds);
        __syncthreads();
#define GS_STEP(n_, Rst_, Gst_, Rld_, Gld_) do { if ((n_) < 256) { if ((n_) + 3 < 256) GS_LD(Rld_, Gld_, (n_) + 3); if ((n_) >= 1) GS_OUT((n_) - 1); \
            if ((n_) + 1 < 256) GS_ST(Rst_, Gst_, (n_) + 1, lds + (((n_) + 1) & 1) * GS_BUF); __syncthreads(); } } while (0)
#pragma unroll 1
        for (int n = 0; n < 258; n += 3) {
            GS_STEP(n, R1, G1, R0, G0);
            GS_STEP(n + 1, R2, G2, R1, G1);
            GS_STEP(n + 2, R0, G0, R2, G2);
        }
        GS_OUT(255);
#undef GS_LD
#undef GS_ST
#undef GS_OUT
#undef GS_STEP
        return;
    }
    f32x4 S[8];
#pragma unroll
    for (int i = 0; i < 8; ++i) S[i] = (f32x4){0.f, 0.f, 0.f, 0.f};
    const unsigned* fl = FLAG + bh * 256;
#define GS_POLL(c_) do { unsigned sp_ = 0; while (__builtin_amdgcn_readfirstlane(__hip_atomic_load(fl + (c_), __ATOMIC_RELAXED, __HIP_MEMORY_SCOPE_AGENT)) == 0u) { __builtin_amdgcn_s_sleep(2); if (++sp_ > (1u << 22)) break; } } while (0)
    if (wave == 0) { GS_POLL(0); GS_POLL(1); GS_POLL(2); GS_POLL(3); __builtin_amdgcn_fence(__ATOMIC_ACQUIRE, "agent"); asm volatile("s_waitcnt vmcnt(0)" ::: "memory"); }
    __syncthreads();
    __syncthreads();
#pragma unroll 1
    for (int n = 0; n < 256; ++n) {
        LAS unsigned char* buf = lds + (n & 1) * GS_BUF;
        const float egl = GLs[n];
        unsigned fnext = 1u;
        if (wave == 0 && n + 4 < 256) fnext = __hip_atomic_load(fl + n + 4, __ATOMIC_RELAXED, __HIP_MEMORY_SCOPE_AGENT);
        f32x4 rhs[4];
        { const v4u vb0 = *(const LAS v4u*)(buf + GS_VB + wave * 2048 + lane * 32), vb1 = *(const LAS v4u*)(buf + GS_VB + wave * 2048 + lane * 32 + 16);
          rhs[0] = (f32x4){bflo(vb0.x), bfhi(vb0.x), bflo(vb0.y), bfhi(vb0.y)}; rhs[1] = (f32x4){bflo(vb0.z), bfhi(vb0.z), bflo(vb0.w), bfhi(vb0.w)};
          rhs[2] = (f32x4){bflo(vb1.x), bfhi(vb1.x), bflo(vb1.y), bfhi(vb1.y)}; rhs[3] = (f32x4){bflo(vb1.z), bfhi(vb1.z), bflo(vb1.w), bfhi(vb1.w)}; }
        bf16x8 Sb[4];
#pragma unroll
        for (int s = 0; s < 4; ++s) Sb[s] = pack_acc2(S[2 * s], S[2 * s + 1]);
        f32x4 tk[4];
#pragma unroll
        for (int m = 0; m < 4; ++m) tk[m] = (f32x4){0.f, 0.f, 0.f, 0.f};
#pragma unroll
        for (int s = 0; s < 4; ++s)
#pragma unroll
            for (int m = 0; m < 4; ++m) { const LAS unsigned char* kp = buf + (16 * m + r16) * 288 + (32 * s + 4 * q) * 2;
                const v2u lo = *(const LAS v2u*)kp, hi2 = *(const LAS v2u*)(kp + 32);
                v4u w; w.x = lo.x; w.y = lo.y; w.z = hi2.x; w.w = hi2.y;
                tk[m] = MFMA16(__builtin_bit_cast(bf16x8, w), Sb[s], tk[m]); }
#pragma unroll
        for (int m = 0; m < 4; ++m) { const f32x4 sc1 = *(const LAS f32x4*)(buf + GS_SC + (16 * m + 4 * q) * 4); rhs[m] = rhs[m] + sc1 * tk[m]; }
        __builtin_amdgcn_sched_barrier(0);
        bf16x8 Rb[2];
#pragma unroll
        for (int s = 0; s < 2; ++s) Rb[s] = pack_acc2(rhs[2 * s], rhs[2 * s + 1]);
        f32x4 vn[4];
#pragma unroll
        for (int m = 0; m < 4; ++m) vn[m] = (f32x4){0.f, 0.f, 0.f, 0.f};
#pragma unroll
        for (int s = 0; s < 2; ++s)
#pragma unroll
            for (int m = 0; m < 4; ++m) { const bf16x8 a = *(const LAS bf16x8*)(buf + GS_TA + (m * 2 + s) * 1024 + lane * 16); vn[m] = MFMA16(a, Rb[s], vn[m]); }
        __builtin_amdgcn_sched_barrier(0);
        bf16x8 Vb[2];
#pragma unroll
        for (int s = 0; s < 2; ++s) Vb[s] = pack_acc2(vn[2 * s], vn[2 * s + 1]);
        bf16x8 Vs[2];
        { f32x4 vsc[4];
#pragma unroll
          for (int m = 0; m < 4; ++m) { const f32x4 sc2 = *(const LAS f32x4*)(buf + GS_SC + 256 + (16 * m + 4 * q) * 4); vsc[m] = vn[m] * sc2; }
#pragma unroll
          for (int s = 0; s < 2; ++s) Vs[s] = pack_acc2(vsc[2 * s], vsc[2 * s + 1]); }
#pragma unroll
        for (int m8 = 0; m8 < 8; ++m8) S[m8] = S[m8] * egl;
#pragma unroll
        for (int s = 0; s < 2; ++s)
#pragma unroll
            for (int m8 = 0; m8 < 8; ++m8) {
                const LAS unsigned char* tp = buf + (32 * s + 4 * q + ((lane & 15) >> 2)) * 288 + 32 * m8 + 8 * (lane & 3);
                const v4i16_t lo = fx_vtr(tp), hi4 = fx_vtr(tp + 16 * 288);
                S[m8] = MFMA16(__builtin_shufflevector(lo, hi4, 0, 1, 2, 3, 4, 5, 6, 7), Vs[s], S[m8]); }
        __builtin_amdgcn_sched_barrier(0);
        f32x4 o[4];
#pragma unroll
        for (int m = 0; m < 4; ++m) o[m] = (f32x4){0.f, 0.f, 0.f, 0.f};
#pragma unroll
        for (int s = 0; s < 4; ++s)
#pragma unroll
            for (int m = 0; m < 4; ++m) { const bf16x8 a = *(const LAS bf16x8*)(buf + GS_QA + (m * 4 + s) * 1024 + lane * 16); o[m] = MFMA16(a, Sb[s], o[m]); }
#pragma unroll
        for (int s = 0; s < 2; ++s)
#pragma unroll
            for (int m = 0; m < 4; ++m) { const bf16x8 a = *(const LAS bf16x8*)(buf + GS_QK + (m * 2 + s) * 1024 + lane * 16); o[m] = MFMA16(a, Vb[s], o[m]); }
        __builtin_amdgcn_sched_barrier(0);
        { LAS bf16* ob = (LAS bf16*)(OB + (n & 1) * 4096);
#pragma unroll
          for (int m = 0; m < 4; ++m)
#pragma unroll
              for (int j = 0; j < 4; ++j) ob[(16 * m + 4 * q + j) * 32 + 16 * wave + r16] = (bf16)f2bf(o[m][j]); }
        if (wave == 0 && n + 4 < 256) { if (__builtin_amdgcn_readfirstlane(fnext) == 0u) GS_POLL(n + 4);
            __builtin_amdgcn_fence(__ATOMIC_ACQUIRE, "agent"); asm volatile("s_waitcnt vmcnt(0)" ::: "memory"); }
        __syncthreads();
    }
#undef GS_POLL
}

DI void gdn_onorm_phase(bf16* OY, const bf16* PROJ, const float* wn, float* ROPE, const int* pos, int gw, int NGW, int lane) {
    constexpr int NR = 4;
    for (int row = gw; row < TT; row += NGW) {
        if (lane < 32) { const float inv = powf(10000.f, -(float)lane * (1.f / 32.f)); const float ang = (float)pos[row] * inv; float sn, cs; sincosf(ang, &sn, &cs);
            ROPE[(size_t)row * 64 + lane] = cs; ROPE[(size_t)row * 64 + 32 + lane] = sn; } }
    float wv[16];
#pragma unroll
    for (int e = 0; e < 16; ++e) wv[e] = wn[16 * (lane & 7) + e];
    for (int row0 = gw * NR; row0 < TT; row0 += NGW * NR) {
        v4u o0[NR], o1[NR], z0[NR], z1[NR];
#pragma unroll
        for (int rr = 0; rr < NR; ++rr) { const bf16* op = OY + (size_t)(row0 + rr) * 1024 + 16 * lane; const bf16* zp = PROJ + (size_t)(row0 + rr) * 4096 + 3072 + 16 * lane;
            o0[rr] = *(const v4u*)op; o1[rr] = *(const v4u*)(op + 8); z0[rr] = *(const v4u*)zp; z1[rr] = *(const v4u*)(zp + 8); }
#pragma unroll
        for (int rr = 0; rr < NR; ++rr) {
            bf16* op = OY + (size_t)(row0 + rr) * 1024 + 16 * lane;
            float ov[16], zv[16];
#pragma unroll
            for (int e = 0; e < 4; ++e) { ov[2 * e] = bflo(o0[rr][e]); ov[2 * e + 1] = bfhi(o0[rr][e]); ov[8 + 2 * e] = bflo(o1[rr][e]); ov[8 + 2 * e + 1] = bfhi(o1[rr][e]);
                zv[2 * e] = bflo(z0[rr][e]); zv[2 * e + 1] = bfhi(z0[rr][e]); zv[8 + 2 * e] = bflo(z1[rr][e]); zv[8 + 2 * e + 1] = bfhi(z1[rr][e]); }
            float ss = 0.f;
#pragma unroll
            for (int e = 0; e < 16; ++e) ss += ov[e] * ov[e];
            ss += __shfl_xor(ss, 1); ss += __shfl_xor(ss, 2); ss += __shfl_xor(ss, 4);
            const float rs = rsqrtf(ss * (1.f / 128.f) + EPS);
            float y[16];
#pragma unroll
            for (int e = 0; e < 16; ++e) y[e] = ov[e] * rs * wv[e] * silu_f(zv[e]);
            v4u a, c; a.x = pk2(y[0], y[1]); a.y = pk2(y[2], y[3]); a.z = pk2(y[4], y[5]); a.w = pk2(y[6], y[7]);
            c.x = pk2(y[8], y[9]); c.y = pk2(y[10], y[11]); c.z = pk2(y[12], y[13]); c.w = pk2(y[14], y[15]);
            *(v4u*)op = a; *(v4u*)(op + 8) = c;
        }
    }
}
DI void swa_phase(const bf16* PROJ, const float* ROPE, const float* sinks, bf16* Y, LAS unsigned char* lds, int bid, int G, int tid, int wave, int lane) {
    LAS bf16* Ks = (LAS bf16*)lds;
    LAS bf16* Vs = (LAS bf16*)(lds + 36864);
    const int r = lane & 31, hi = lane >> 5;
    const float LOG2E = 1.4426950408889634f, c2 = 0.125f * LOG2E;
    for (int it = bid; it < 1024; it += G) {
        const int hk = it & 3, nb = (it >> 2) & 127, b = it >> 9;
        const long tb0 = (long)b * SEQ + (long)(nb - 1) * 128;
#pragma unroll
        for (int u = 0; u < 2; ++u) { const int p = tid + 512 * u, kk = p >> 2, o = p & 3;
            v4u w1 = (v4u){0u, 0u, 0u, 0u}, w2 = (v4u){0u, 0u, 0u, 0u};
            if (nb > 0 || kk >= 128) {
                const size_t t = (size_t)(tb0 + kk);
                const bf16* kp = PROJ + t * 2560 + 1024 + hk * 64 + 8 * o;
                const v4u a = *(const v4u*)kp, c = *(const v4u*)(kp + 32);
                const f32x4 cs0 = *(const f32x4*)(ROPE + t * 64 + 8 * o), cs1 = *(const f32x4*)(ROPE + t * 64 + 8 * o + 4);
                const f32x4 sn0 = *(const f32x4*)(ROPE + t * 64 + 32 + 8 * o), sn1 = *(const f32x4*)(ROPE + t * 64 + 32 + 8 * o + 4);
                float x1[8], x2[8], cs[8], sn[8];
#pragma unroll
                for (int e = 0; e < 4; ++e) { x1[2 * e] = bflo(a[e]); x1[2 * e + 1] = bfhi(a[e]); x2[2 * e] = bflo(c[e]); x2[2 * e + 1] = bfhi(c[e]);
                    cs[e] = cs0[e]; cs[4 + e] = cs1[e]; sn[e] = sn0[e]; sn[4 + e] = sn1[e]; }
                float y1[8], y2[8];
#pragma unroll
                for (int e = 0; e < 8; ++e) { y1[e] = x1[e] * cs[e] - x2[e] * sn[e]; y2[e] = x2[e] * cs[e] + x1[e] * sn[e]; }
                w1.x = pk2(y1[0], y1[1]); w1.y = pk2(y1[2], y1[3]); w1.z = pk2(y1[4], y1[5]); w1.w = pk2(y1[6], y1[7]);
                w2.x = pk2(y2[0], y2[1]); w2.y = pk2(y2[2], y2[3]); w2.z = pk2(y2[4], y2[5]); w2.w = pk2(y2[6], y2[7]);
            }
            *(LAS v4u*)(Ks + kk * 72 + 8 * o) = w1; *(LAS v4u*)(Ks + kk * 72 + 32 + 8 * o) = w2; }
#pragma unroll
        for (int u = 0; u < 4; ++u) { const int p = tid + 512 * u, kk = p >> 3, o8 = p & 7;
            v4u v = (v4u){0u, 0u, 0u, 0u};
            if (nb > 0 || kk >= 128) v = *(const v4u*)(PROJ + (size_t)(tb0 + kk) * 2560 + 1280 + hk * 64 + 8 * o8);
            const int pos = (kk & ~15) + perm16(kk & 15);
            LAS bf16* d = Vs + (8 * o8) * 264 + pos;
            d[0] = (bf16)(v.x & 0xffffu); d[264] = (bf16)(v.x >> 16); d[2 * 264] = (bf16)(v.y & 0xffffu); d[3 * 264] = (bf16)(v.y >> 16);
            d[4 * 264] = (bf16)(v.z & 0xffffu); d[5 * 264] = (bf16)(v.z >> 16); d[6 * 264] = (bf16)(v.w & 0xffffu); d[7 * 264] = (bf16)(v.w >> 16); }
        __syncthreads();
        const int g = wave >> 1, qh = wave & 1, head = hk * 4 + g;
        const float sink2 = sinks[head] * LOG2E;
        for (int sb = 0; sb < 2; ++sb) {
            const int qs = 64 * qh + 32 * sb, qi = qs + r, tbase = qs >> 5;
            const size_t t = (size_t)b * SEQ + (size_t)nb * 128 + qi;
            bf16x8 Qf[4];
            { const bf16* qp = PROJ + t * 2560 + head * 64 + 8 * hi;
              v4u qa[4];
#pragma unroll
              for (int ks = 0; ks < 4; ++ks) qa[ks] = *(const v4u*)(qp + 16 * ks);
#pragma unroll
              for (int k2 = 0; k2 < 2; ++k2) {
                  const f32x4 cs0 = *(const f32x4*)(ROPE + t * 64 + 16 * k2 + 8 * hi), cs1 = *(const f32x4*)(ROPE + t * 64 + 16 * k2 + 8 * hi + 4);
                  const f32x4 sn0 = *(const f32x4*)(ROPE + t * 64 + 32 + 16 * k2 + 8 * hi), sn1 = *(const f32x4*)(ROPE + t * 64 + 32 + 16 * k2 + 8 * hi + 4);
                  float y1[8], y2[8];
#pragma unroll
                  for (int e = 0; e < 4; ++e) {
                      const float a0 = bflo(qa[k2][e]), a1 = bfhi(qa[k2][e]), c0 = bflo(qa[k2 + 2][e]), c1 = bfhi(qa[k2 + 2][e]);
                      const float cA = (e < 2) ? cs0[2 * e] : cs1[2 * e - 4], cB = (e < 2) ? cs0[2 * e + 1] : cs1[2 * e - 3];
                      const float sA = (e < 2) ? sn0[2 * e] : sn1[2 * e - 4], sB = (e < 2) ? sn0[2 * e + 1] : sn1[2 * e - 3];
                      y1[2 * e] = a0 * cA - c0 * sA; y2[2 * e] = c0 * cA + a0 * sA;
                      y1[2 * e + 1] = a1 * cB - c1 * sB; y2[2 * e + 1] = c1 * cB + a1 * sB; }
                  v4u w1, w2;
                  w1.x = pk2(y1[0], y1[1]); w1.y = pk2(y1[2], y1[3]); w1.z = pk2(y1[4], y1[5]); w1.w = pk2(y1[6], y1[7]);
                  w2.x = pk2(y2[0], y2[1]); w2.y = pk2(y2[2], y2[3]); w2.z = pk2(y2[4], y2[5]); w2.w = pk2(y2[6], y2[7]);
                  Qf[k2] = __builtin_bit_cast(bf16x8, w1); Qf[k2 + 2] = __builtin_bit_cast(bf16x8, w2); } }
            f32x16 S[5];
            float mx = sink2;
#pragma unroll
            for (int tk = 0; tk < 5; ++tk) {
#pragma unroll
                for (int i = 0; i < 16; ++i) S[tk][i] = 0.f;
                const int kt = tbase + tk;
#pragma unroll
                for (int ks = 0; ks < 4; ++ks) { const bf16x8 a = *(const LAS bf16x8*)(Ks + (32 * kt + r) * 72 + 16 * ks + 8 * hi); S[tk] = MFMA32(a, Qf[ks], S[tk]); }
#pragma unroll
                for (int i = 0; i < 16; ++i) { const int kk = 32 * kt + crow32(i, hi);
                    const bool ok = (kk > qi) && (kk <= qi + 128) && (nb > 0 || kk >= 128);
                    const float xv = ok ? S[tk][i] * c2 : -INFINITY; S[tk][i] = xv; mx = fmaxf(mx, xv); }
            }
            mx = fmaxf(mx, __shfl_xor(mx, 32));
            float ps = 0.f;
#pragma unroll
            for (int tk = 0; tk < 5; ++tk)
#pragma unroll
                for (int i = 0; i < 16; ++i) { const float p = __builtin_amdgcn_exp2f(S[tk][i] - mx); S[tk][i] = p; ps += p; }
            const float tot = ps + __shfl_xor(ps, 32) + __builtin_amdgcn_exp2f(sink2 - mx);
            const float inv = 1.f / tot;
            f32x16 O[2];
#pragma unroll
            for (int dt = 0; dt < 2; ++dt)
#pragma unroll
                for (int i = 0; i < 16; ++i) O[dt][i] = 0.f;
#pragma unroll
            for (int tk = 0; tk < 5; ++tk)
#pragma unroll
                for (int s = 0; s < 2; ++s) { v4u w;
                    w.x = pk2(S[tk][8 * s], S[tk][8 * s + 1]); w.y = pk2(S[tk][8 * s + 2], S[tk][8 * s + 3]);
                    w.z = pk2(S[tk][8 * s + 4], S[tk][8 * s + 5]); w.w = pk2(S[tk][8 * s + 6], S[tk][8 * s + 7]);
                    const bf16x8 pf = __builtin_bit_cast(bf16x8, w);
                    const int kt = tbase + tk;
#pragma unroll
                    for (int dt = 0; dt < 2; ++dt) { const bf16x8 a = *(const LAS bf16x8*)(Vs + (32 * dt + r) * 264 + 32 * kt + 16 * s + 8 * hi); O[dt] = MFMA32(a, pf, O[dt]); } }
#pragma unroll
            for (int dt = 0; dt < 2; ++dt)
#pragma unroll
                for (int g4 = 0; g4 < 4; ++g4) { const int d = 32 * dt + 8 * g4 + 4 * hi;
                    const v2u z = *(const v2u*)(PROJ + t * 2560 + 1536 + head * 64 + d);
                    const float y0 = O[dt][4 * g4] * inv * silu_f(bflo(z.x)), y1 = O[dt][4 * g4 + 1] * inv * silu_f(bfhi(z.x));
                    const float y2 = O[dt][4 * g4 + 2] * inv * silu_f(bflo(z.y)), y3 = O[dt][4 * g4 + 3] * inv * silu_f(bfhi(z.y));
                    v2u o; o.x = pk2(y0, y1); o.y = pk2(y2, y3);
                    *(v2u*)(Y + t * 1024 + head * 64 + d) = o; }
        }
        __syncthreads();
    }
}
#ifndef LAYER_MASK
#define LAYER_MASK 15
#endif
__global__ void __launch_bounds__(NTHR, 2) mega_fwd(Ptrs P) {
    extern __shared__ __attribute__((aligned(16))) unsigned char lds_raw[];
    LAS unsigned char* lds = (LAS unsigned char*)lds_raw;
    cg::grid_group grid = cg::this_grid();
    int tid_o = threadIdx.x; int tid = tid_o, lane = tid & 63; const int wave = __builtin_amdgcn_readfirstlane(tid >> 6);
    const int G = gridDim.x, bid = blockIdx.x;
    const int gw = bid * NWAVES + wave, NGW = G * NWAVES, NG = G * NTHR; int gtid = bid * NTHR + tid;
    unsigned char* ws = P.ws;
    const float* x_in = P.in[0]; const int* positions = (const int*)P.in[1];
    const float* norm_w = P.in[2]; const float* fnorm_w = P.in[3];
    float* X = P.out;
    bf16* XB = (bf16*)P.out;
    bf16* XB3 = (bf16*)(ws + WS_EX + 64 * MiB);
    bf16* HY = (bf16*)(ws + WS_HY); bf16* PROJ = (bf16*)(ws + WS_PROJ);
#define RELAUNDER() do { asm volatile("" : "+v"(tid_o)); tid = tid_o; lane = tid & 63; gtid = bid * NTHR + tid; } while (0)
#define GSYNC() do { xcd_barrier(xbar); RELAUNDER(); } while (0)

    unsigned* CTL = (unsigned*)(ws + WS_GL + 65536);
    if (bid == 0 && tid < 128) CTL[tid] = 0u;
    unsigned* FLAGS = (unsigned*)(ws + WS_GL + 131072);
    for (int i = gtid; i < 4096; i += NG) FLAGS[i] = 0u;
    unsigned* XBW = (unsigned*)(ws + WS_GL + 262144);
    volatile LAS unsigned* xst = (volatile LAS unsigned*)(lds + LDS_BYTES - 16);
    if (bid == 0) for (int i = tid; i < XCD_BAR_WORDS; i += NTHR) XBW[i] = 0u;
    if (tid < 2) xst[tid] = 0u;
    p0_prologue(P, lds, gw, NGW, wave, lane);
#ifdef DBL_P0
    p0_prologue(P, lds, gw, NGW, wave, lane);
#endif
    norm_phase<0>(x_in, norm_w, HY, nullptr, nullptr, 0, nullptr, nullptr, nullptr, nullptr, nullptr, nullptr, lds, gw, NGW, tid, lane);
    grid.sync();
    RELAUNDER();
    const XcdBarrier xbar = xcd_barrier_post(XBW, xst);
    if (LAYER_MASK & 1) {
        bf16* Y0 = (bf16*)(ws + WS_EX); float* CVH = (float*)(ws + WS_PROJ); float* BND = (float*)(ws + WS_PROJ + 8 * MiB);
        { pg8::Gemm g{HY, (const bf16*)(ws + WS_W0I), TT, 4096, 1024}; pg8::StaticOrder S; S.init(TT, 4096, G, bid);
          pg8::EpiConvGate E{Y0, P.in[5], CVH, BND};
          pg8::gemm_phase<pg8::EpiConvGate, pg8::StaticOrder, true, true>(lds, g, S, E); }
        GSYNC();
        convfix_phase(CVH, BND, P.in[5], Y0, gtid, NG);
        GSYNC();
        { pg8::Gemm g{Y0, (const bf16*)(ws + WS_W0O), TT, 1024, 1024}; pg8::StaticOrder S; S.init(TT, 1024, G, bid);
          pg8::EpiRes<false, true> E{x_in, XB, nullptr};
          pg8::gemm_phase<pg8::EpiRes<false, true>, pg8::StaticOrder, true, true>(lds, g, S, E);
        }
    } else {
        for (size_t i = gtid; i < (size_t)TT * DM / 4; i += NG) { const f32x4 v = ((const f32x4*)x_in)[i]; v2u o; o.x = pk2(v.x, v.y); o.y = pk2(v.z, v.w); ((v2u*)XB)[i] = o; }
    }
    GSYNC();
    if (LAYER_MASK & 2) {
        float* LOGF = (float*)(ws + WS_LOGF); float* CUM = (float*)(ws + WS_CUM); bf16* VT = (bf16*)(ws + WS_EX);
        norm_phase<1, true>((const float*)XB, norm_w + 1024, HY, nullptr, P.in[7], 4104, LOGF, nullptr, P.in[8], nullptr, nullptr, nullptr, lds, gw, NGW, tid, lane);
        GSYNC();
        if (bid < 16) fox_cumsum(LOGF, CUM, bid, lds, tid);
        { pg8::Gemm g{HY, (const bf16*)(ws + WS_W1I), TT, 4096, 1024}; pg8::StaticOrder S; S.init(TT, 4096, G, bid);
          pg8::EpiStore E{PROJ, 4096, nullptr};
          pg8::gemm_phase<pg8::EpiStore, pg8::StaticOrder, true, true>(lds, g, S, E); }
        GSYNC();
        fox_norms_phase(PROJ, (float*)(CTL + 1024), gw, NGW, lane);
#ifdef DBL_VTRANS
        fox_norms_phase(PROJ, (float*)(CTL + 1024), gw, NGW, lane);
#endif
        GSYNC();
        fox_attn_phase(PROJ, CUM, HY, (const float*)(CTL + 1024), CTL + 64, lds, bid, G, tid, wave, lane);
#ifdef DBL_FOX
        fox_attn_phase(PROJ, CUM, HY, (const float*)(CTL + 1024), CTL + 65, lds, bid, G, tid, wave, lane);
#endif
        GSYNC();
        { pg8::Gemm g{HY, (const bf16*)(ws + WS_W1O), TT, 1024, 1024}; pg8::StaticOrder S; S.init(TT, 1024, G, bid);
          pg8::EpiRes<true, true> E{XB, XB, nullptr};
          pg8::gemm_phase<pg8::EpiRes<true, true>, pg8::StaticOrder, true, true>(lds, g, S, E); }
        GSYNC();
    }
    if (LAYER_MASK & 4) {
        float* BETA = (float*)(ws + WS_LOGF); float* GG = (float*)(ws + WS_CUM); float* GL = (float*)(ws + WS_GL); bf16* HALO = (bf16*)(ws + WS_HALO);
        norm_phase<2, true>((const float*)XB, norm_w + 2048, HY, nullptr, P.in[10], 4112, BETA, GG, P.in[12], P.in[13], nullptr, nullptr, lds, gw, NGW, tid, lane);
#ifdef DBL_NORM2
        norm_phase<2, true>((const float*)XB, norm_w + 2048, HY, nullptr, P.in[10], 4112, BETA, GG, P.in[12], P.in[13], nullptr, nullptr, lds, gw, NGW, tid, lane);
#endif
        GSYNC();
        { pg8::Gemm g{HY, (const bf16*)(ws + WS_W2I), TT, 4096, 1024}; pg8::StaticOrder S; S.init(TT, 4096, G, bid);
          pg8::EpiStore E{PROJ, 4096, HALO};
          pg8::gemm_phase<pg8::EpiStore, pg8::StaticOrder, true, true>(lds, g, S, E); }
        GSYNC();
        if (bid >= 64) gdn_prep_phase<false>(PROJ, HY, HALO, P.in[11], BETA, GG, ws + WS_EX, GL, FLAGS, lds, bid, G, 64, tid, wave, lane);
        else gdn_scan_phase(PROJ, ws + WS_EX, GL, FLAGS, HY, lds, bid, tid, wave, lane);
        GSYNC();
        gdn_onorm_phase(HY, PROJ, P.in[14], (float*)(ws + WS_EX), positions, gw, NGW, lane);
        GSYNC();
        { pg8::Gemm g{HY, (const bf16*)(ws + WS_W2O), TT, 1024, 1024}; pg8::StaticOrder S; S.init(TT, 1024, G, bid);
          pg8::EpiRes<true, true, true> E{XB, XB3, (float*)(ws + WS_LOGF)};
          pg8::gemm_phase<pg8::EpiRes<true, true, true>, pg8::StaticOrder, true, true>(lds, g, S, E); }
        GSYNC();
    }
    if (LAYER_MASK & 8) {
        float* ROPE = (float*)(ws + WS_EX);
        { pg8::Gemm g{XB3, (const bf16*)(ws + WS_W3I), TT, 2560, 1024}; pg8::StaticOrder S; S.init(TT, 2560, G, bid);
          pg8::EpiStoreScaled E{PROJ, 2560, (const float*)(ws + WS_LOGF)};
          pg8::gemm_phase<pg8::EpiStoreScaled, pg8::StaticOrder, true, true>(lds, g, S, E); }
        GSYNC();
        swa_phase(PROJ, ROPE, P.in[17], HY, lds, bid, G, tid, wave, lane);
#ifdef DBL_SWA
        swa_phase(PROJ, ROPE, P.in[17], HY, lds, bid, G, tid, wave, lane);
#endif
        GSYNC();
        { pg8::Gemm g{HY, (const bf16*)(ws + WS_W3O), TT, 1024, 1024}; pg8::StaticOrder S; S.init(TT, 1024, G, bid);
          pg8::EpiRes<true, false> E{XB3, X, nullptr};
          pg8::gemm_phase<pg8::EpiRes<true, false>, pg8::StaticOrder, true, true>(lds, g, S, E); }
        GSYNC();
    }
#ifdef DBL_SYNC
    for (int i = 0; i < 10; ++i) GSYNC();
#endif
#ifdef DBL_FINAL
    norm_phase<0>(X, fnorm_w, HY, nullptr, nullptr, 0, nullptr, nullptr, nullptr, nullptr, nullptr, nullptr, lds, gw, NGW, tid, lane);
#endif
    norm_phase<4>(X, fnorm_w, nullptr, X, nullptr, 0, nullptr, nullptr, nullptr, nullptr, nullptr, nullptr, lds, gw, NGW, tid, lane);
}

extern "C" void kernel_launch(void* const* d_in, const int* in_sizes, int n_in, void* d_out, int out_size, void* d_ws, size_t ws_size, hipStream_t stream) {
    static int grid = 0;
    if (grid == 0) {
        int dev = 0, cus = 0, per_cu = 0;
        hipGetDevice(&dev);
        hipDeviceGetAttribute(&cus, hipDeviceAttributeMultiprocessorCount, dev);
        if (hipFuncSetAttribute((const void*)mega_fwd, hipFuncAttributeMaxDynamicSharedMemorySize, LDS_BYTES) != hipSuccess) fprintf(stderr, "kernel_launch: hipFuncSetAttribute failed\n");
        if (hipOccupancyMaxActiveBlocksPerMultiprocessor(&per_cu, (const void*)mega_fwd, NTHR, LDS_BYTES) != hipSuccess || per_cu < 1) { fprintf(stderr, "kernel_launch: occupancy query says %d\n", per_cu); per_cu = 1; }
        (void)hipGetLastError();
        grid = cus;
        if (ws_size < WS_END) fprintf(stderr, "kernel_launch: workspace %zu < %zu\n", ws_size, (size_t)WS_END);
    }
    Ptrs p{};
    for (int i = 0; i < 19; ++i) p.in[i] = (const float*)d_in[i];
    p.out = (float*)d_out; p.ws = (unsigned char*)d_ws; p.ph_lo = 0; p.ph_hi = 0;
    void* args[] = {&p};
    hipError_t e = hipLaunchCooperativeKernel((const void*)mega_fwd, dim3(grid), dim3(NTHR), args, LDS_BYTES, stream);
    if (e != hipSuccess) fprintf(stderr, "cooperative launch failed: %s (grid %d)\n", hipGetErrorString(e), grid);
}
```

```cpp
#include <hip/hip_runtime.h>
#include <hip/hip_cooperative_groups.h>
#include <cstdio>
#include <cstdint>
namespace cg = cooperative_groups;

#define DI __device__ __forceinline__
#define LAS __attribute__((address_space(3)))
#define GAS __attribute__((address_space(1)))
typedef unsigned short bf16;
typedef unsigned v4u __attribute__((ext_vector_type(4)));
typedef unsigned v2u __attribute__((ext_vector_type(2)));
typedef float f32x4 __attribute__((ext_vector_type(4)));
typedef float f32x16 __attribute__((ext_vector_type(16)));
typedef short bf16x8 __attribute__((ext_vector_type(8)));

constexpr int NBATCH = 2, SEQ = 16384, TT = NBATCH * SEQ, DM = 1024;
constexpr float EPS = 1e-6f;
constexpr int NWAVES = 8, NTHR = 512;
constexpr size_t MiB = 1u << 20;
constexpr size_t WS_W0I = 0, WS_W0O = 8 * MiB, WS_W1I = 10 * MiB, WS_W1O = 18 * MiB, WS_W2I = 20 * MiB, WS_W2O = 28 * MiB, WS_W3I = 30 * MiB, WS_W3O = 35 * MiB;
constexpr size_t WS_LOGF = 38 * MiB;
constexpr size_t WS_CUM = 39 * MiB;
constexpr size_t WS_GL = 40 * MiB;
constexpr size_t WS_HALO = 48 * MiB;
constexpr size_t WS_HY = 64 * MiB;
constexpr size_t WS_PROJ = 128 * MiB;
constexpr size_t WS_EX = 384 * MiB;
constexpr size_t WS_END = 512 * MiB;
constexpr int LDS_BYTES = 155648;

DI unsigned f2bf(float f) { unsigned u = __builtin_bit_cast(unsigned, f); return (u + 0x7fffu + ((u >> 16) & 1u)) >> 16; }
typedef float f32x2_t __attribute__((ext_vector_type(2)));
typedef __bf16 bf16x2_t __attribute__((ext_vector_type(2)));
DI unsigned pk2(float lo, float hi) { f32x2_t v = {lo, hi}; bf16x2_t b = __builtin_convertvector(v, bf16x2_t); return __builtin_bit_cast(unsigned, b); }
DI float bflo(unsigned u) { return __builtin_bit_cast(float, u << 16); }
DI float bfhi(unsigned u) { return __builtin_bit_cast(float, u & 0xffff0000u); }
DI float bf2f(bf16 b) { return __builtin_bit_cast(float, (unsigned)b << 16); }
DI float wave_sum(float v) {
#pragma unroll
    for (int o = 1; o < 64; o <<= 1) v += __shfl_xor(v, o);
    return v;
}
DI float silu_f(float x) { return x / (1.f + __expf(-x)); }
DI float softplus_f(float x) { return fmaxf(x, 0.f) + log1pf(__expf(-fabsf(x))); }
namespace pg8 {
#define PG8_LAS __attribute__((address_space(3)))
typedef unsigned short bf16_t;
typedef short bf16x8 __attribute__((ext_vector_type(8)));
typedef float f32x4 __attribute__((ext_vector_type(4)));
typedef unsigned u32x4 __attribute__((ext_vector_type(4)));
constexpr int BM = 256, BK = 64, HALF = 128, HTB = HALF * BK * 2  , STAGE_BYTES = 8 * HTB, NXCD = 8, WGM = 8;

__host__ __device__ __forceinline__ int lds_byte(int r, int c) { const int st = (r >> 4) * 2 + (c >> 5), rr = r & 15, cc = c & 31, ob = rr * 64 + cc * 2; return st * 1024 + (ob ^ (((ob >> 9) & 1) << 5)); }
__host__ __device__ __forceinline__ void stage_rc(int b, int& R, int& C) { const int st = b / 1024, sb = b % 1024, swz = sb ^ (((sb >> 9) & 1) << 5); R = (st >> 1) * 16 + swz / 64; C = (st & 1) * 32 + (swz % 64) / 2; }
__host__ __device__ __forceinline__ int perm32(int rho) { const int n = rho >> 4, i = rho & 15; return 8 * (i >> 2) + 4 * n + (i & 3); }

struct Unit { int pm, pn; };
struct Gemm { const bf16_t* A; const bf16_t* Bt; int M, N, K; };

struct StaticOrder {
    int nM, nN, nwg, G, c;
    __host__ __device__ void init(int M, int N, int G_, int c_) { nM = M / BM; nN = N / BM; nwg = nM * nN; G = G_; c = c_; }
    __host__ __device__ bool next(int i, Unit& u) const {
        const long L = (long)i * G + c; if (L >= nwg) return false;
        int wgid = (int)L; { const int q = nwg / NXCD, r = nwg % NXCD, xcd = wgid % NXCD, off = wgid / NXCD; wgid = (xcd < r ? xcd * (q + 1) : r * (q + 1) + (xcd - r) * q) + off; }
        const int nig = WGM * nN, gid = wgid / nig, fm = gid * WGM, gsz = (nM - fm) < WGM ? (nM - fm) : WGM;
        u.pm = fm + ((wgid % nig) % gsz); u.pn = (wgid % nig) / gsz; return true;
    }
    __device__ __forceinline__ void a_ready(const Unit&) const {}
    __device__ __forceinline__ void done(const Unit&) const {}
};

__device__ __forceinline__ unsigned cvt_pk_bf16(float lo, float hi) { unsigned r; asm volatile("v_cvt_pk_bf16_f32 %0, %1, %2" : "=v"(r) : "v"(lo), "v"(hi)); return r; }
struct EpiStore {
    static constexpr bool PERM = true, AFTER_DRAIN = false;
    bf16_t* O; int ldc; bf16_t* HALO;
    __device__ __forceinline__ void operator()(const f32x4 (&acc)[2][2][4][2], const Unit& u, int wr, int wc, int fr, int fq) const {
        const int row0 = u.pm * BM + wr * 64 + fr; const int col0 = u.pn * BM + wc * 32 + 8 * fq;
#pragma unroll
        for (int ai = 0; ai < 2; ++ai)
#pragma unroll
            for (int m = 0; m < 4; ++m) { const int row = row0 + ai * HALF + m * 16; bf16_t* rowp = O + (size_t)row * ldc + col0;
#pragma unroll
                for (int bj = 0; bj < 2; ++bj) { const f32x4 v0 = acc[ai][bj][m][0], v1 = acc[ai][bj][m][1];
                    u32x4 w; w.x = cvt_pk_bf16(v0[0], v0[1]); w.y = cvt_pk_bf16(v0[2], v0[3]); w.z = cvt_pk_bf16(v1[0], v1[1]); w.w = cvt_pk_bf16(v1[2], v1[3]);
                    *(u32x4*)(rowp + bj * HALF) = w;
                    if (HALO != nullptr && m == 3 && fr >= 13 && (col0 + bj * HALF) < 3072)
                        *(u32x4*)(HALO + ((size_t)(row >> 6) * 3 + (fr - 13)) * 3072 + col0 + bj * HALF) = w;
                } }
    }
};
template <bool RB, bool OB, bool PSUM = false>
struct EpiRes {
    static constexpr bool PERM = true, AFTER_DRAIN = false;
    const void* R; void* O; float* PS;
    __device__ __forceinline__ void operator()(const f32x4 (&acc)[2][2][4][2], const Unit& u, int wr, int wc, int fr, int fq) const {
        const int row0 = u.pm * BM + wr * 64 + fr; const int col0 = u.pn * BM + wc * 32 + 8 * fq;
#pragma unroll
        for (int ai = 0; ai < 2; ++ai)
#pragma unroll
            for (int m = 0; m < 4; ++m) { const size_t off = (size_t)(row0 + ai * HALF + m * 16) * 1024 + col0; float ssq = 0.f;
#pragma unroll
                for (int bj = 0; bj < 2; ++bj) {
                    f32x4 r0, r1;
                    if constexpr (RB) { const u32x4 w = *(const u32x4*)((const bf16_t*)R + off + bj * HALF);
                        r0 = (f32x4){__builtin_bit_cast(float, w.x << 16), __builtin_bit_cast(float, w.x & 0xffff0000u), __builtin_bit_cast(float, w.y << 16), __builtin_bit_cast(float, w.y & 0xffff0000u)};
                        r1 = (f32x4){__builtin_bit_cast(float, w.z << 16), __builtin_bit_cast(float, w.z & 0xffff0000u), __builtin_bit_cast(float, w.w << 16), __builtin_bit_cast(float, w.w & 0xffff0000u)}; }
                    else { r0 = *(const f32x4*)((const float*)R + off + bj * HALF); r1 = *(const f32x4*)((const float*)R + off + bj * HALF + 4); }
                    const f32x4 v0 = r0 + acc[ai][bj][m][0], v1 = r1 + acc[ai][bj][m][1];
                    if constexpr (OB) { u32x4 w; w.x = cvt_pk_bf16(v0[0], v0[1]); w.y = cvt_pk_bf16(v0[2], v0[3]); w.z = cvt_pk_bf16(v1[0], v1[1]); w.w = cvt_pk_bf16(v1[2], v1[3]);
                        *(u32x4*)((bf16_t*)O + off + bj * HALF) = w;
                        if constexpr (PSUM) {
#pragma unroll
                            for (int i = 0; i < 4; ++i) { const unsigned ww = (i == 0) ? w.x : (i == 1 ? w.y : (i == 2 ? w.z : w.w));
                                const float lo = __builtin_bit_cast(float, ww << 16), hi = __builtin_bit_cast(float, ww & 0xffff0000u); ssq += lo * lo + hi * hi; } } }
                    else { *(f32x4*)((float*)O + off + bj * HALF) = v0; *(f32x4*)((float*)O + off + bj * HALF + 4) = v1; }
                }
                if constexpr (PSUM) { ssq += __shfl_xor(ssq, 16); ssq += __shfl_xor(ssq, 32);
                    if (fq == 0) PS[(size_t)(row0 + ai * HALF + m * 16) * 16 + u.pn * 4 + wc] = ssq; } }
    }
};
struct EpiConvGate {
    static constexpr bool PERM = true, AFTER_DRAIN = false;
    bf16_t* Y; const float* wconv; float* CVH; float* BND;
    __device__ __forceinline__ void operator()(const f32x4 (&acc)[2][2][4][2], const Unit& u, int wr, int wc, int fr, int fq) const {
        const int ch0 = 64 * u.pn + 16 * wc + 4 * fq;
        const f32x4 w0 = *(const f32x4*)(wconv + ch0), w1 = *(const f32x4*)(wconv + 1024 + ch0), w2 = *(const f32x4*)(wconv + 2048 + ch0);
#pragma unroll
        for (int ai = 0; ai < 2; ++ai) {
            f32x4 p15 = (f32x4){0.f, 0.f, 0.f, 0.f}, p14 = (f32x4){0.f, 0.f, 0.f, 0.f};
#pragma unroll
            for (int m = 0; m < 4; ++m) {
                const int row = u.pm * BM + ai * HALF + wr * 64 + m * 16 + fr;
                const f32x4 b = acc[ai][0][m][0], c = acc[ai][0][m][1], v = acc[ai][1][m][0], z = acc[ai][1][m][1];
                const f32x4 cv = c * v;
                f32x4 y, n15, n14;
#pragma unroll
                for (int e = 0; e < 4; ++e) {
                    const float up1 = __shfl_up(cv[e], 1, 16), up2 = __shfl_up(cv[e], 2, 16);
                    const float cm1 = (fr >= 1) ? up1 : p15[e];
                    const float cm2 = (fr >= 2) ? up2 : ((fr == 1) ? p15[e] : p14[e]);
                    const float zz = z[e];
                    y[e] = b[e] * (w0[e] * cm2 + w1[e] * cm1 + w2[e] * cv[e]) * (zz / (1.f + __expf(-zz)));
                    n15[e] = __shfl(cv[e], 15, 16); n14[e] = __shfl(cv[e], 14, 16);
                }
                p15 = n15; p14 = n14;
                if (m > 0 || fr >= 2) {
                    unsigned long long o = (unsigned long long)cvt_pk_bf16(y[0], y[1]) | ((unsigned long long)cvt_pk_bf16(y[2], y[3]) << 32);
                    *(unsigned long long*)(Y + (size_t)row * 1024 + ch0) = o;
                } else {
                    float* bp = BND + ((size_t)(row >> 6) * 2 + fr) * 3 * 1024 + ch0;
                    *(f32x4*)bp = b; *(f32x4*)(bp + 1024) = z; *(f32x4*)(bp + 2048) = cv;
                }
                if (m == 3 && fr >= 14) *(f32x4*)(CVH + ((size_t)(row >> 6) * 2 + (fr - 14)) * 1024 + ch0) = cv;
            }
        }
    }
};
struct EpiStoreScaled {
    static constexpr bool PERM = true, AFTER_DRAIN = false;
    bf16_t* O; int ldc; const float* PS;
    __device__ __forceinline__ void operator()(const f32x4 (&acc)[2][2][4][2], const Unit& u, int wr, int wc, int fr, int fq) const {
        const int row0 = u.pm * BM + wr * 64 + fr; const int col0 = u.pn * BM + wc * 32 + 8 * fq;
#pragma unroll
        for (int ai = 0; ai < 2; ++ai)
#pragma unroll
            for (int m = 0; m < 4; ++m) { const int row = row0 + ai * HALF + m * 16; bf16_t* rowp = O + (size_t)row * ldc + col0;
                const f32x4* pp = (const f32x4*)(PS + (size_t)row * 16);
                const f32x4 s4 = (pp[0] + pp[1]) + (pp[2] + pp[3]);
                const float r = rsqrtf(((s4[0] + s4[1]) + (s4[2] + s4[3])) * (1.f / 1024.f) + 1e-6f);
#pragma unroll
                for (int bj = 0; bj < 2; ++bj) { const f32x4 v0 = acc[ai][bj][m][0] * r, v1 = acc[ai][bj][m][1] * r;
                    u32x4 w; w.x = cvt_pk_bf16(v0[0], v0[1]); w.y = cvt_pk_bf16(v0[2], v0[3]); w.z = cvt_pk_bf16(v1[0], v1[1]); w.w = cvt_pk_bf16(v1[2], v1[3]);
                    *(u32x4*)(rowp + bj * HALF) = w; } }
    }
};
template <class Epi, class Sched, bool ALIGN_EPI = false, bool SP2 = false>
__device__ __forceinline__ void gemm_phase(PG8_LAS unsigned char* lds, const Gemm g, const Sched& S, const Epi& E) {
    int tid_l = threadIdx.x; asm volatile("" : "+v"(tid_l));
    const int tid = tid_l, wid = __builtin_amdgcn_readfirstlane(tid >> 6), lane = tid & 63, wr = wid >> 2, wc = wid & 3, fr = lane & 15, fq = lane >> 4;
    const int K = g.K, nt = K / BK;
    unsigned voffA[2], voffB[2];
#pragma unroll
    for (int i = 0; i < 2; ++i) { int R, C; stage_rc(tid * 16 + i * 8192, R, C); const int Rb = Epi::PERM ? ((R & ~31) + perm32(R & 31)) : R;
        voffA[i] = (unsigned)(R * K + C) * 2u; voffB[i] = (unsigned)(Rb * K + C) * 2u; }
    const size_t kstep = (size_t)(BK * 2);
    const size_t hstep = (size_t)HALF * K * 2;
    const size_t tstep = 2 * hstep;
    const unsigned ldsw = (unsigned)wid * 1024u;
    const int aoff = lds_byte(wr * 64 + fr, fq * 8), boff = lds_byte(wc * 32 + fr, fq * 8);
#define PG8_SA(b, h) (((b) * 2 + (h)) * HTB)
#define PG8_SB(b, h) ((4 + (b) * 2 + (h)) * HTB)
#define PG8_STAGE(bufoff, gbase, voff) do { _Pragma("unroll") for (int _i = 0; _i < 2; ++_i) \
        __builtin_amdgcn_global_load_lds((const unsigned*)((const char*)(gbase) + (voff)[_i]), (PG8_LAS unsigned*)(lds + (bufoff) + ldsw + _i * 8192), 16, 0, 0); } while (0)
#define PG8_LDA(dst, b, h) do { _Pragma("unroll") for (int m = 0; m < 4; ++m) _Pragma("unroll") for (int k = 0; k < 2; ++k) dst[m][k] = *(const PG8_LAS bf16x8*)(lds + PG8_SA(b, h) + aoff + m * 2048 + k * 1024); } while (0)
#define PG8_LDB(dst, b, h) do { _Pragma("unroll") for (int n = 0; n < 2; ++n) _Pragma("unroll") for (int k = 0; k < 2; ++k) dst[n][k] = *(const PG8_LAS bf16x8*)(lds + PG8_SB(b, h) + boff + n * 2048 + k * 1024); } while (0)
#define PG8_MMA(ai, bj, At, Bt) do { __builtin_amdgcn_s_setprio(1); _Pragma("unroll") for (int m = 0; m < 4; ++m) _Pragma("unroll") for (int n = 0; n < 2; ++n) _Pragma("unroll") for (int k = 0; k < 2; ++k) \
        acc[ai][bj][m][n] = __builtin_amdgcn_mfma_f32_16x16x32_bf16(Bt[n][k], At[m][k], acc[ai][bj][m][n], 0, 0, 0); __builtin_amdgcn_s_setprio(0); } while (0)
#define PG8_WAIT_V(n) asm volatile("s_waitcnt vmcnt(" #n ")" ::: "memory")
#define PG8_WAIT_L(n) asm volatile("s_waitcnt lgkmcnt(" #n ")" ::: "memory")
#define PG8_BAR __builtin_amdgcn_s_barrier()
#define PG8_SCHED __builtin_amdgcn_sched_barrier(0)
    Unit cur, nxt; int ui = 0;
    if (!S.next(0, cur)) return;
    f32x4 acc[2][2][4][2];
#pragma unroll
    for (int a = 0; a < 2; ++a)
#pragma unroll
        for (int b = 0; b < 2; ++b)
#pragma unroll
            for (int m = 0; m < 4; ++m)
#pragma unroll
                for (int n = 0; n < 2; ++n) acc[a][b][m][n] = (f32x4){0.f, 0.f, 0.f, 0.f};
    bf16x8 At[4][2], B0[2][2], B1[2][2];
    const char* cA = (const char*)g.A + (size_t)cur.pm * tstep; const char* cB = (const char*)g.Bt + (size_t)cur.pn * tstep;
    S.a_ready(cur);
    if constexpr (SP2) {
        PG8_STAGE(PG8_SB(0, 0), cB, voffB); PG8_STAGE(PG8_SB(0, 1), cB + hstep, voffB); PG8_STAGE(PG8_SA(0, 0), cA, voffA); PG8_STAGE(PG8_SA(0, 1), cA + hstep, voffA);
        if (wr == 1) PG8_BAR;
        PG8_WAIT_V(2); PG8_BAR;
        PG8_STAGE(PG8_SB(1, 0), cB + kstep, voffB); PG8_STAGE(PG8_SA(1, 0), cA + kstep, voffA); PG8_STAGE(PG8_SB(1, 1), cB + hstep + kstep, voffB);
        PG8_WAIT_V(6); PG8_BAR;
    } else {
        PG8_STAGE(PG8_SB(0, 0), cB, voffB); PG8_STAGE(PG8_SA(0, 0), cA, voffA); PG8_STAGE(PG8_SB(0, 1), cB + hstep, voffB); PG8_STAGE(PG8_SA(0, 1), cA + hstep, voffA);
        if (wr == 1) PG8_BAR;
        PG8_WAIT_V(4); PG8_BAR;
        PG8_STAGE(PG8_SB(1, 0), cB + kstep, voffB); PG8_STAGE(PG8_SA(1, 0), cA + kstep, voffA); PG8_STAGE(PG8_SB(1, 1), cB + hstep + kstep, voffB);
        PG8_WAIT_V(6); PG8_BAR;
    }
    for (;;) {
        const bool has_next = S.next(ui + 1, nxt);
        const char* nA = has_next ? (const char*)g.A + (size_t)nxt.pm * tstep : cA; const char* nB = has_next ? (const char*)g.Bt + (size_t)nxt.pn * tstep : cB;
        for (int t = 0; t < nt; t += 2) {
            const bool last = (t == nt - 2);
            const char* a1 = cA + (size_t)(t + 1) * kstep;
            const char* a2 = last ? nA : cA + (size_t)(t + 2) * kstep; const char* b2 = last ? nB : cB + (size_t)(t + 2) * kstep;
            const char* a3 = a2 + kstep; const char* b3 = b2 + kstep;
            if (last && has_next) S.a_ready(nxt);
            if constexpr (SP2) {
            PG8_LDB(B0, 0, 0); PG8_LDB(B1, 0, 1); PG8_SCHED; PG8_LDA(At, 0, 0); PG8_STAGE(PG8_SA(1, 1), a1 + hstep, voffA);
            PG8_WAIT_V(8); PG8_WAIT_L(0); PG8_BAR; PG8_MMA(0, 0, At, B0); PG8_MMA(0, 1, At, B1); PG8_BAR; PG8_SCHED;
            PG8_LDA(At, 0, 1); PG8_STAGE(PG8_SB(0, 0), b2, voffB); PG8_STAGE(PG8_SB(0, 1), b2 + hstep, voffB); PG8_STAGE(PG8_SA(0, 0), a2, voffA);
            PG8_WAIT_V(8); PG8_WAIT_L(0); PG8_BAR; PG8_MMA(1, 0, At, B0); PG8_MMA(1, 1, At, B1); PG8_BAR; PG8_SCHED;
            PG8_LDB(B0, 1, 0); PG8_LDB(B1, 1, 1); PG8_SCHED; PG8_LDA(At, 1, 0); PG8_STAGE(PG8_SA(0, 1), a2 + hstep, voffA);
            PG8_WAIT_V(8); PG8_WAIT_L(0); PG8_BAR; PG8_MMA(0, 0, At, B0); PG8_MMA(0, 1, At, B1); PG8_BAR; PG8_SCHED;
            PG8_LDA(At, 1, 1); PG8_STAGE(PG8_SB(1, 0), b3, voffB); PG8_STAGE(PG8_SB(1, 1), b3 + hstep, voffB); PG8_STAGE(PG8_SA(1, 0), a3, voffA);
            PG8_WAIT_V(8); PG8_WAIT_L(0); PG8_BAR; PG8_MMA(1, 0, At, B0); PG8_MMA(1, 1, At, B1); PG8_BAR; PG8_SCHED;
            } else {
            PG8_LDB(B0, 0, 0); PG8_SCHED; PG8_LDA(At, 0, 0); PG8_STAGE(PG8_SA(1, 1), a1 + hstep, voffA);
            PG8_WAIT_L(8); PG8_BAR; PG8_WAIT_L(0); PG8_MMA(0, 0, At, B0); PG8_BAR; PG8_SCHED;
            PG8_LDB(B1, 0, 1); PG8_STAGE(PG8_SB(0, 0), b2, voffB);
            PG8_BAR; PG8_WAIT_L(0); PG8_MMA(0, 1, At, B1); PG8_BAR;
            PG8_LDA(At, 0, 1); PG8_STAGE(PG8_SA(0, 0), a2, voffA);
            PG8_BAR; PG8_WAIT_L(0); PG8_MMA(1, 0, At, B0); PG8_BAR; PG8_SCHED;
            PG8_STAGE(PG8_SB(0, 1), b2 + hstep, voffB);
            PG8_WAIT_V(6); PG8_BAR; PG8_MMA(1, 1, At, B1); PG8_BAR;
            PG8_LDB(B0, 1, 0); PG8_SCHED; PG8_LDA(At, 1, 0); PG8_STAGE(PG8_SA(0, 1), a2 + hstep, voffA);
            PG8_WAIT_L(8); PG8_BAR; PG8_WAIT_L(0); PG8_MMA(0, 0, At, B0); PG8_BAR; PG8_SCHED;
            PG8_LDB(B1, 1, 1); PG8_STAGE(PG8_SB(1, 0), b3, voffB);
            PG8_BAR; PG8_WAIT_L(0); PG8_MMA(0, 1, At, B1); PG8_BAR;
            PG8_LDA(At, 1, 1); PG8_STAGE(PG8_SA(1, 0), a3, voffA);
            PG8_BAR; PG8_WAIT_L(0); PG8_MMA(1, 0, At, B0); PG8_BAR; PG8_SCHED;
            PG8_STAGE(PG8_SB(1, 1), b3 + hstep, voffB);
            PG8_WAIT_V(6); PG8_BAR; PG8_MMA(1, 1, At, B1); PG8_BAR;
            }
        }
        if constexpr (ALIGN_EPI) { if (wr == 0) PG8_BAR; }
        if constexpr (!Epi::AFTER_DRAIN) { E(acc, cur, wr, wc, fr, fq); S.done(cur); }
        if (!has_next) break;
#pragma unroll
        for (int a = 0; a < 2; ++a)
#pragma unroll
            for (int b = 0; b < 2; ++b)
#pragma unroll
                for (int m = 0; m < 4; ++m)
#pragma unroll
                    for (int n = 0; n < 2; ++n) acc[a][b][m][n] = (f32x4){0.f, 0.f, 0.f, 0.f};
        cur = nxt; cA = nA; cB = nB; ++ui;
        if constexpr (ALIGN_EPI) { if (wr == 1) PG8_BAR; }
    }
    PG8_WAIT_V(0);
    if constexpr (!ALIGN_EPI) { if (wr == 0) PG8_BAR; }
    PG8_BAR;
    if constexpr (Epi::AFTER_DRAIN) { E.fused(acc, cur, wr, wc, fr, fq, lds, wid, lane); S.done(cur); }
#undef PG8_SA
#undef PG8_SB
#undef PG8_STAGE
#undef PG8_LDA
#undef PG8_LDB
#undef PG8_MMA
#undef PG8_WAIT_V
#undef PG8_WAIT_L
#undef PG8_BAR
#undef PG8_SCHED
}
}
#define XB_TMO      128
#define XB_XCNT(j)  (256  + 64 * (j))
#define XB_XSUB(j)  (1280 + 64 * (j))
#define XB_XGEN(j)  (2304 + 64 * (j))
#define XB_TOP      3328
#define XB_TOPGEN   3392
#define XCD_BAR_WORDS 3456
#define XB_SPIN_CAP (1u << 18)

__device__ __forceinline__ unsigned xb_ld(unsigned* p)              { return __hip_atomic_load(p, __ATOMIC_RELAXED, __HIP_MEMORY_SCOPE_AGENT); }
__device__ __forceinline__ unsigned xb_add(unsigned* p, unsigned v) { return __hip_atomic_fetch_add(p, v, __ATOMIC_RELAXED, __HIP_MEMORY_SCOPE_AGENT); }
__device__ __forceinline__ unsigned xb_xcc_id() { return (unsigned)__builtin_amdgcn_s_getreg((3 << 11) | 20) & 0xFu; }
#define XB_SPIN(cond, bar) do { unsigned _sp = 0; while (cond) { __builtin_amdgcn_s_sleep(1); \
    if ((++_sp & 255u) == 0u) { if (xb_ld(&(bar)[XB_TMO])) break; if (_sp > XB_SPIN_CAP) { atomicAdd(&(bar)[XB_TMO], 1u); break; } } } } while (0)

struct XcdBarrier {
    unsigned* bar; unsigned x;
    volatile LAS unsigned* st;
};

__device__ __forceinline__ XcdBarrier xcd_barrier_post(unsigned* bar, volatile LAS unsigned* st) {
    XcdBarrier b; b.bar = bar; b.x = xb_xcc_id(); b.st = st;
    if (threadIdx.x == 0) (void)xb_add(&bar[XB_XCNT(b.x)], 1u);
    return b;
}
__device__ __forceinline__ void xcd_barrier_complete(unsigned* bar, unsigned x, unsigned& nloc, unsigned& nx) {
    const unsigned G = gridDim.x * gridDim.y * gridDim.z;
    unsigned sum, cnt, mine, sp = 0u;
    for (;;) {
        sum = 0u; cnt = 0u; mine = 0u;
#pragma unroll
        for (unsigned j = 0; j < 16; ++j) { const unsigned c = xb_ld(&bar[XB_XCNT(j)]); sum += c; cnt += (c > 0u) ? 1u : 0u; mine = (j == x) ? c : mine; }
        if (sum == G) break;
        __builtin_amdgcn_s_sleep(1);
        if ((++sp & 255u) == 0u) { if (xb_ld(&bar[XB_TMO])) break; if (sp > XB_SPIN_CAP) { atomicAdd(&bar[XB_TMO], 1u); break; } }
    }
    nloc = mine > 0u ? mine : 1u; nx = cnt > 0u ? cnt : 1u;
}

__device__ __forceinline__ void xcd_barrier(const XcdBarrier& b) {
    asm volatile("s_waitcnt vmcnt(0)" ::: "memory");
    __syncthreads();
    if (threadIdx.x == 0) {
        unsigned* bar = b.bar;
        __builtin_amdgcn_s_waitcnt(0);
        unsigned nloc = b.st[0], nx = b.st[1];
        if (nloc == 0u) { xcd_barrier_complete(bar, b.x, nloc, nx); b.st[0] = nloc; b.st[1] = nx; }
        const unsigned old = xb_add(&bar[XB_XSUB(b.x)], 1u);
        const unsigned gen = old / nloc;
        if (old + 1u == (gen + 1u) * nloc) {
            __builtin_amdgcn_fence(__ATOMIC_RELEASE, "agent");
            asm volatile("s_waitcnt vmcnt(0)" ::: "memory");
            const unsigned og = xb_add(&bar[XB_TOP], 1u);
            const unsigned tg = og / nx;
            if (og + 1u == (tg + 1u) * nx) xb_add(&bar[XB_TOPGEN], 1u);
            else XB_SPIN(xb_ld(&bar[XB_TOPGEN]) == tg, bar);
            __builtin_amdgcn_fence(__ATOMIC_ACQUIRE, "agent");
            xb_add(&bar[XB_XGEN(b.x)], 1u);
            asm volatile("s_waitcnt vmcnt(0)" ::: "memory");
        } else {
            XB_SPIN(xb_ld(&bar[XB_XGEN(b.x)]) == gen, bar);
            __builtin_amdgcn_fence(__ATOMIC_ACQUIRE, "agent");
            asm volatile("s_waitcnt vmcnt(0)" ::: "memory");
        }
    }
    __syncthreads();
}

template <bool CONVPERM = false>
DI void p0_transpose_item(const float* W, int K, int ldw, int ncols, bf16* WT, LAS float* scr, int item, int lane, const float* rowscale = nullptr) {
    const int nblk = ncols / 32, kb = item / nblk, nb = item % nblk, k0 = 64 * kb, n0 = 32 * nb;
#pragma unroll 8
    for (int i = 0; i < 32; ++i) { const int kk = 2 * i + (lane >> 5); float wv = W[(size_t)(k0 + kk) * ldw + n0 + (lane & 31)]; if (rowscale != nullptr) wv *= rowscale[k0 + kk];
        scr[kk * 33 + (lane & 31)] = wv; }
    asm volatile("s_waitcnt lgkmcnt(0)" ::: "memory");
    const int c = lane & 7;
#pragma unroll
    for (int j = 0; j < 4; ++j) { const int n = (lane >> 3) + 8 * j; const LAS float* s = scr + (8 * c) * 33 + n;
        v4u o; o.x = pk2(s[0 * 33], s[1 * 33]); o.y = pk2(s[2 * 33], s[3 * 33]); o.z = pk2(s[4 * 33], s[5 * 33]); o.w = pk2(s[6 * 33], s[7 * 33]);
        int orow = n0 + n;
        if constexpr (CONVPERM) { const int sct = orow >> 10, ch = orow & 1023;
            orow = 256 * (ch >> 6) + 128 * (sct >> 1) + 32 * ((ch >> 4) & 3) + 8 * ((ch >> 2) & 3) + 4 * (sct & 1) + (ch & 3); }
        *(v4u*)(WT + (size_t)orow * K + k0 + 8 * c) = o; }
    asm volatile("s_waitcnt lgkmcnt(0)" ::: "memory");
}

struct Ptrs {
    const float* in[19]; float* out; unsigned char* ws; int ph_lo, ph_hi;
};

DI void p0_prologue(const Ptrs& P, LAS unsigned char* lds, int gw, int NGW, int wave, int lane) {
    LAS float* scr = (LAS float*)(lds + wave * 16384);
    unsigned char* ws = P.ws;
    constexpr int I_IN = 16 * 128, I_OUT = 16 * 32, I_SWA = 16 * 80;
    constexpr int NIT = 3 * I_IN + I_SWA + 4 * I_OUT;
    for (int it = gw; it < NIT; it += NGW) {
        int r = it;
        if (r < I_IN) { p0_transpose_item<true>(P.in[4], 1024, 4096, 4096, (bf16*)(ws + WS_W0I), scr, r, lane); continue; } r -= I_IN;
        if (r < I_IN) { p0_transpose_item(P.in[7], 1024, 4104, 4096, (bf16*)(ws + WS_W1I), scr, r, lane); continue; } r -= I_IN;
        if (r < I_IN) { p0_transpose_item(P.in[10], 1024, 4112, 4096, (bf16*)(ws + WS_W2I), scr, r, lane); continue; } r -= I_IN;
        if (r < I_SWA) { p0_transpose_item(P.in[16], 1024, 2560, 2560, (bf16*)(ws + WS_W3I), scr, r, lane, P.in[2] + 3072); continue; } r -= I_SWA;
        if (r < I_OUT) { p0_transpose_item(P.in[6], 1024, 1024, 1024, (bf16*)(ws + WS_W0O), scr, r, lane); continue; } r -= I_OUT;
        if (r < I_OUT) { p0_transpose_item(P.in[9], 1024, 1024, 1024, (bf16*)(ws + WS_W1O), scr, r, lane); continue; } r -= I_OUT;
        if (r < I_OUT) { p0_transpose_item(P.in[15], 1024, 1024, 1024, (bf16*)(ws + WS_W2O), scr, r, lane); continue; } r -= I_OUT;
        p0_transpose_item(P.in[18], 1024, 1024, 1024, (bf16*)(ws + WS_W3O), scr, r, lane);
    }
}

template <int MODE, bool XBF = false>
DI void norm_phase(const float* X, const float* nw, bf16* H, float* OUTF, const float* W, int ldw, float* oa, float* ob, const float* p0, const float* p1, const float* p2,
                   const int* pos, LAS unsigned char* lds, int gw, int NGW, int tid, int lane) {
    constexpr int NT = (MODE == 1) ? 8 : (MODE == 2 ? 16 : 0);
    LAS f32x4* thin = (LAS f32x4*)lds;
    if constexpr (NT > 0) {
        for (int i = tid; i < 1024 * (NT / 4); i += NTHR) { const int k = i / (NT / 4), c4 = i % (NT / 4);
            const f32x4 v = *(const f32x4*)(W + (size_t)k * ldw + 4096 + 4 * c4);
            const int j = k >> 8, l = (k & 255) >> 2, e = k & 3;
            thin[c4 * 1024 + (j * 4 + e) * 64 + l] = v; }
        __syncthreads();
    }
    constexpr int NR = (NT == 16) ? 2 : 4;
    f32x4 nwv[4];
#pragma unroll
    for (int j = 0; j < 4; ++j) nwv[j] = *((const f32x4*)nw + lane + 64 * j);
    for (int row0 = gw * NR; row0 < TT; row0 += NGW * NR) {
        f32x4 vv[NR][4];
#pragma unroll
        for (int rr = 0; rr < NR; ++rr) {
            if constexpr (XBF) { const v2u* xr = (const v2u*)((const bf16*)X + (size_t)(row0 + rr) * DM) + lane;
#pragma unroll
                for (int j = 0; j < 4; ++j) { const v2u u = xr[64 * j]; vv[rr][j] = (f32x4){bflo(u.x), bfhi(u.x), bflo(u.y), bfhi(u.y)}; } }
            else { const f32x4* xr = (const f32x4*)(X + (size_t)(row0 + rr) * DM) + lane;
#pragma unroll
                for (int j = 0; j < 4; ++j) vv[rr][j] = xr[64 * j]; } }
#pragma unroll
        for (int rr = 0; rr < NR; ++rr) {
        const int row = row0 + rr;
        f32x4 v[4]; float s = 0.f;
#pragma unroll
        for (int j = 0; j < 4; ++j) { v[j] = vv[rr][j]; s += (v[j].x * v[j].x + v[j].y * v[j].y) + (v[j].z * v[j].z + v[j].w * v[j].w); }
        const float r = rsqrtf(wave_sum(s) * (1.f / DM) + EPS);
#pragma unroll
        for (int j = 0; j < 4; ++j) { v[j] = v[j] * r * nwv[j]; vv[rr][j] = v[j]; }
        if constexpr (MODE == 4) {
            f32x4* o = (f32x4*)(OUTF + (size_t)row * DM) + lane;
#pragma unroll
            for (int j = 0; j < 4; ++j) o[64 * j] = v[j];
        } else {
            unsigned long long* o8 = (unsigned long long*)(H + (size_t)row * DM) + lane;
#pragma unroll
            for (int j = 0; j < 4; ++j) o8[64 * j] = (unsigned long long)pk2(v[j].x, v[j].y) | ((unsigned long long)pk2(v[j].z, v[j].w) << 32);
        }
        if constexpr (MODE == 3) {
            if (lane < 32) { const float inv = powf(10000.f, -(float)lane * (1.f / 32.f)); const float ang = (float)pos[row] * inv; float sn, cs; sincosf(ang, &sn, &cs);
                oa[(size_t)row * 64 + lane] = cs; oa[(size_t)row * 64 + 32 + lane] = sn; }
        }
        }
        if constexpr (NT > 0) {
            constexpr int RG = (NT == 16) ? 1 : NR;
#pragma unroll
            for (int r0 = 0; r0 < NR; r0 += RG) {
            f32x4 a[RG][NT / 4];
#pragma unroll
            for (int rr = 0; rr < RG; ++rr)
#pragma unroll
                for (int c = 0; c < NT / 4; ++c) a[rr][c] = (f32x4){0.f, 0.f, 0.f, 0.f};
#pragma unroll
            for (int j = 0; j < 4; ++j)
#pragma unroll
                for (int e = 0; e < 4; ++e) {
#pragma unroll
                    for (int c = 0; c < NT / 4; ++c) { const f32x4 w = thin[c * 1024 + (j * 4 + e) * 64 + lane];
#pragma unroll
                        for (int rr = 0; rr < RG; ++rr) a[rr][c] += w * vv[r0 + rr][j][e]; }
                    __builtin_amdgcn_sched_barrier(0); }
#pragma unroll
            for (int rr = 0; rr < RG; ++rr) {
                const int row = row0 + r0 + rr;
                float t8[NT / 2];
#pragma unroll
                for (int i = 0; i < NT / 2; ++i) { const float x0 = a[rr][(2 * i) >> 2][(2 * i) & 3], x1 = a[rr][(2 * i + 1) >> 2][(2 * i + 1) & 3];
                    const bool bb = lane & 1; const float mine = bb ? x1 : x0, send = bb ? x0 : x1; t8[i] = mine + __shfl_xor(send, 1); }
                float t4[NT / 4];
#pragma unroll
                for (int i = 0; i < NT / 4; ++i) { const bool bb = lane & 2; const float mine = bb ? t8[2 * i + 1] : t8[2 * i], send = bb ? t8[2 * i] : t8[2 * i + 1]; t4[i] = mine + __shfl_xor(send, 2); }
                float t2[NT / 8];
#pragma unroll
                for (int i = 0; i < NT / 8; ++i) { const bool bb = lane & 4; const float mine = bb ? t4[2 * i + 1] : t4[2 * i], send = bb ? t4[2 * i] : t4[2 * i + 1]; t2[i] = mine + __shfl_xor(send, 4); }
                float tc;
                if constexpr (NT == 16) { const bool bb = lane & 8; const float mine = bb ? t2[1] : t2[0], send = bb ? t2[0] : t2[1]; tc = mine + __shfl_xor(send, 8); }
                else { tc = t2[0]; tc += __shfl_xor(tc, 8); }
                tc += __shfl_xor(tc, 16); tc += __shfl_xor(tc, 32);
                if constexpr (MODE == 1) {
                    if (lane < 8) { const float xx = tc + p0[lane]; oa[(size_t)row * 8 + lane] = fminf(xx, 0.f) - log1pf(__expf(-fabsf(xx))); }
                } else {
                    const float ma = __shfl(tc, (lane + 8) & 63);
                    if (lane < 8) { oa[(size_t)row * 8 + lane] = 1.f / (1.f + __expf(-tc));
                        ob[(size_t)row * 8 + lane] = -__expf(p0[lane]) * softplus_f(ma + p1[lane]); }
                }
            }
            }
        }
    }
    if constexpr (NT > 0) __syncthreads();
}

DI void convgate_phase(const bf16* PROJ, const float* wconv, bf16* Y, int gtid, int NG) {
    for (int it = gtid; it < (TT / 32) * 128; it += NG) {
        const int oct = it & 127, chunk = it >> 7, r0 = chunk * 32, c0 = oct * 8;
        float w0[8], w1[8], w2[8];
#pragma unroll
        for (int e = 0; e < 8; ++e) { w0[e] = wconv[c0 + e]; w1[e] = wconv[1024 + c0 + e]; w2[e] = wconv[2048 + c0 + e]; }
        float p2[8], p1[8];
#pragma unroll
        for (int e = 0; e < 8; ++e) { p2[e] = 0.f; p1[e] = 0.f; }
        if ((r0 & (SEQ - 1)) != 0) {
#pragma unroll
            for (int d = 2; d >= 1; --d) { const bf16* rp = PROJ + (size_t)(r0 - d) * 4096 + c0;
                const v4u cc = *(const v4u*)(rp + 1024), vv = *(const v4u*)(rp + 2048);
#pragma unroll
                for (int e = 0; e < 4; ++e) { const float a = bflo(cc[e]) * bflo(vv[e]), b = bfhi(cc[e]) * bfhi(vv[e]);
                    if (d == 2) { p2[2 * e] = a; p2[2 * e + 1] = b; } else { p1[2 * e] = a; p1[2 * e + 1] = b; } } }
        }
#pragma unroll 4
        for (int r = 0; r < 32; ++r) {
            const bf16* rp = PROJ + (size_t)(r0 + r) * 4096 + c0;
            const v4u bb = *(const v4u*)(rp), cc = *(const v4u*)(rp + 1024), vv = *(const v4u*)(rp + 2048), zz = *(const v4u*)(rp + 3072);
            float y[8];
#pragma unroll
            for (int e = 0; e < 4; ++e) {
                const float cv0 = bflo(cc[e]) * bflo(vv[e]), cv1 = bfhi(cc[e]) * bfhi(vv[e]);
                const float o0 = w0[2 * e] * p2[2 * e] + w1[2 * e] * p1[2 * e] + w2[2 * e] * cv0;
                const float o1 = w0[2 * e + 1] * p2[2 * e + 1] + w1[2 * e + 1] * p1[2 * e + 1] + w2[2 * e + 1] * cv1;
                p2[2 * e] = p1[2 * e]; p1[2 * e] = cv0; p2[2 * e + 1] = p1[2 * e + 1]; p1[2 * e + 1] = cv1;
                y[2 * e] = bflo(bb[e]) * o0 * silu_f(bflo(zz[e])); y[2 * e + 1] = bfhi(bb[e]) * o1 * silu_f(bfhi(zz[e]));
            }
            v4u o; o.x = pk2(y[0], y[1]); o.y = pk2(y[2], y[3]); o.z = pk2(y[4], y[5]); o.w = pk2(y[6], y[7]);
            *(v4u*)(Y + (size_t)(r0 + r) * 1024 + c0) = o;
        }
    }
}

DI void convfix_phase(const float* CVH, const float* BND, const float* wconv, bf16* Y, int gtid, int NG) {
    for (int it = gtid; it < 512 * 2 * 256; it += NG) {
        const int c4 = it & 255, r = (it >> 8) & 1, g = it >> 9, ch0 = 4 * c4;
        const float* bp = BND + ((size_t)g * 2 + r) * 3 * 1024 + ch0;
        const f32x4 b = *(const f32x4*)bp, z = *(const f32x4*)(bp + 1024), cv = *(const f32x4*)(bp + 2048);
        f32x4 cm1 = (f32x4){0.f, 0.f, 0.f, 0.f}, cm2 = (f32x4){0.f, 0.f, 0.f, 0.f};
        const bool first = (g & 255) == 0;
        if (r == 0) { if (!first) { cm1 = *(const f32x4*)(CVH + ((size_t)(g - 1) * 2 + 1) * 1024 + ch0); cm2 = *(const f32x4*)(CVH + ((size_t)(g - 1) * 2) * 1024 + ch0); } }
        else { cm1 = *(const f32x4*)(BND + ((size_t)g * 2) * 3 * 1024 + 2048 + ch0); if (!first) cm2 = *(const f32x4*)(CVH + ((size_t)(g - 1) * 2 + 1) * 1024 + ch0); }
        const f32x4 w0 = *(const f32x4*)(wconv + ch0), w1 = *(const f32x4*)(wconv + 1024 + ch0), w2 = *(const f32x4*)(wconv + 2048 + ch0);
        float y[4];
#pragma unroll
        for (int e = 0; e < 4; ++e) y[e] = b[e] * (w0[e] * cm2[e] + w1[e] * cm1[e] + w2[e] * cv[e]) * silu_f(z[e]);
        v2u o; o.x = pk2(y[0], y[1]); o.y = pk2(y[2], y[3]);
        *(v2u*)(Y + ((size_t)g * 64 + r) * 1024 + ch0) = o;
    }
}
DI int crow32(int i, int hi) { return (i & 3) + 8 * (i >> 2) + 4 * hi; }
DI int perm16(int p) { return (p & 3) | ((p & 4) << 1) | ((p & 8) >> 1); }
#define MFMA32(a, b, c) __builtin_amdgcn_mfma_f32_32x32x16_bf16((a), (b), (c), 0, 0, 0)
#define MFMA16(a, b, c) __builtin_amdgcn_mfma_f32_16x16x32_bf16((a), (b), (c), 0, 0, 0)

DI void fox_cumsum(const float* LOGF, float* CUM, int bh, LAS unsigned char* lds, int tid) {
    LAS double* tot = (LAS double*)lds;
    const int b = bh >> 3, h = bh & 7;
    const float* src = LOGF + ((size_t)b * SEQ + 32 * tid) * 8 + h;
    float v[32]; double s = 0.0;
#pragma unroll
    for (int i = 0; i < 32; ++i) { v[i] = src[i * 8]; s += (double)v[i]; }
    double inc = s;
    const int ln = tid & 63, wv = tid >> 6;
#pragma unroll
    for (int o = 1; o < 64; o <<= 1) { const double t = __shfl_up(inc, o); if (ln >= o) inc += t; }
    if (ln == 63) tot[wv] = inc;
    __syncthreads();
    double pre = inc - s;
    for (int i = 0; i < wv; ++i) pre += tot[i];
    float* dst = CUM + (size_t)bh * SEQ + 32 * tid;
#pragma unroll
    for (int i = 0; i < 32; ++i) { pre += (double)v[i]; dst[i] = (float)pre; }
    __syncthreads();
}

DI void fox_norms_phase(const bf16* PROJ, float* NRMT, int gw, int NGW, int lane) {
    for (int it = gw; it < 16 * 256; it += NGW) {
        const int bh = it >> 8, tl = it & 255, b = bh >> 3, h = bh & 7;
        const size_t r0 = (size_t)b * SEQ + 64 * tl;
        float mk = 0.f;
#pragma unroll
        for (int rr = 0; rr < 8; ++rr) {
            const int row = 8 * rr + (lane >> 3), seg = lane & 7; const bf16* qp = PROJ + (r0 + row) * 4096 + h * 128 + 16 * seg;
            const v4u b0 = *(const v4u*)(qp + 1024), b1 = *(const v4u*)(qp + 1032);
            float sk = 0.f;
#pragma unroll
            for (int e = 0; e < 4; ++e) sk += bflo(b0[e]) * bflo(b0[e]) + bfhi(b0[e]) * bfhi(b0[e]) + bflo(b1[e]) * bflo(b1[e]) + bfhi(b1[e]) * bfhi(b1[e]);
#pragma unroll
            for (int o = 1; o < 8; o <<= 1) sk += __shfl_xor(sk, o);
            mk = fmaxf(mk, sk);
        }
#pragma unroll
        for (int o = 8; o < 64; o <<= 1) mk = fmaxf(mk, __shfl_xor(mk, o));
        if (lane == 0) NRMT[(size_t)it * 2 + 1] = mk;
    }
}

constexpr int FX_KB = 64 * 272, FX_VB = 64 * 320;
typedef short v4i16_t __attribute__((ext_vector_type(4)));
DI v4i16_t fx_vtr(const LAS unsigned char* p) { return __builtin_amdgcn_ds_read_tr16_b64_v4i16((LAS v4i16_t*)p); }
DI void fox_attn_phase(const bf16* PROJ, const float* CUM, bf16* Y, const float* NRMT, unsigned* QCTR, LAS unsigned char* lds, int bid, int G, int tid, int wave, int lane) {
    LAS unsigned char* Kb = lds; LAS unsigned char* Vb = lds + 2 * FX_KB; LAS float* Bs = (LAS float*)(lds + 2 * FX_KB + 2 * FX_VB);
    const int r = lane & 31, hi = lane >> 5;
    const float SQD = 11.313708498984761f;
    const float c2 = 0.08838834764831845f * 1.4426950408889634f;
    LAS unsigned* Qs = (LAS unsigned*)(lds + 2 * FX_KB + 2 * FX_VB + 512);
    LAS float* Mq = (LAS float*)(lds + 2 * FX_KB + 2 * FX_VB + 704);
    LAS float* Ms = (LAS float*)(lds + 2 * FX_KB + 2 * FX_VB + 576);
    for (;;) {
        if (tid == 0) Qs[0] = atomicAdd(QCTR, 1u);
        __syncthreads();
        const int e = (int)Qs[0];
        __syncthreads();
        if (e >= 1024) break;
        {
            const int bh = e & 15, qb = 63 - (e >> 4), b = bh >> 3, h = bh & 7;
            const int q0 = qb * 256, ntiles = 4 * (qb + 1);
            const float cref = CUM[(size_t)bh * SEQ + q0];
            const int qmin = q0 + 32 * wave;
            bf16x8 Qf[8];
            { const bf16* qp = PROJ + ((size_t)b * SEQ + qmin + r) * 4096 + h * 128 + 8 * hi;
#pragma unroll
              for (int ks = 0; ks < 8; ++ks) Qf[ks] = *(const bf16x8*)(qp + 16 * ks); }
            { float qn = 0.f;
#pragma unroll
              for (int ks = 0; ks < 8; ++ks) { const v4u w = __builtin_bit_cast(v4u, Qf[ks]);
#pragma unroll
                  for (int e = 0; e < 4; ++e) qn += bflo(w[e]) * bflo(w[e]) + bfhi(w[e]) * bfhi(w[e]); }
              qn += __shfl_xor(qn, 32);
#pragma unroll
              for (int o = 1; o < 32; o <<= 1) qn = fmaxf(qn, __shfl_xor(qn, o));
              if (lane == 0) Mq[wave] = qn; }
            __syncthreads();
            int jstart; float Bq;
            { float mq = Mq[0], mk = 0.f;
#pragma unroll
              for (int w = 1; w < 8; ++w) mq = fmaxf(mq, Mq[w]);
#pragma unroll
              for (int u = 0; u < 4; ++u) mk = fmaxf(mk, NRMT[((size_t)bh * 256 + lane + 64 * u) * 2 + 1]);
#pragma unroll
              for (int o = 1; o < 64; o <<= 1) mk = fmaxf(mk, __shfl_xor(mk, o));
              Bq = sqrtf(mq * mk);
              const float B2 = 2.f * Bq * 0.08838834764831845f;
              const float thr = -(30.f + B2);
              const int jc = (lane * (4 * qb)) >> 6;
              const bool live = (qb == 0) ? true : ((cref - CUM[(size_t)bh * SEQ + 64 * jc + 63]) > thr);
              const unsigned long long m = __ballot(live);
              const int fl = (m == 0ull) ? 64 : (__ffsll((long long)m) - 1);
              const int pl = fl > 0 ? fl - 1 : 0;
              jstart = (qb == 0) ? 0 : ((pl * (4 * qb)) >> 6);
              jstart = __builtin_amdgcn_readfirstlane(jstart); }
            f32x16 O[4];
#pragma unroll
            for (int dt = 0; dt < 4; ++dt)
#pragma unroll
                for (int i = 0; i < 16; ++i) O[dt][i] = 0.f;
            float m_old = -INFINITY, lsum = 0.f;
            const bf16* kg[2]; const bf16* vg[2]; int klds[2], vlds[2];
#pragma unroll
            for (int u = 0; u < 2; ++u) { const int p = tid + 512 * u;
                kg[u] = PROJ + ((size_t)b * SEQ + (p >> 4)) * 4096 + 1024 + h * 128 + 8 * (p & 15); klds[u] = (p >> 4) * 272 + (p & 15) * 16;
                vg[u] = PROJ + ((size_t)b * SEQ + (p >> 4)) * 4096 + 2048 + h * 128 + 8 * (p & 15); vlds[u] = (p >> 4) * 320 + (p & 15) * 16; }
            v4u kr[2], vr[2]; float br = 0.f;
            const int jlast = ntiles - 1;
#pragma unroll
            for (int u = 0; u < 2; ++u) { kr[u] = *(const v4u*)(kg[u] + (size_t)jlast * 64 * 4096); vr[u] = *(const v4u*)(vg[u] + (size_t)jlast * 64 * 4096); }
            if (tid < 64) br = (cref - CUM[(size_t)bh * SEQ + jlast * 64 + tid]) * SQD;
#pragma unroll
            for (int u = 0; u < 2; ++u) { *(LAS v4u*)(Kb + (jlast & 1) * FX_KB + klds[u]) = kr[u]; *(LAS v4u*)(Vb + (jlast & 1) * FX_VB + vlds[u]) = vr[u]; }
            if (tid < 64) Bs[(jlast & 1) * 64 + tid] = br;
            __syncthreads();
            for (int j = jlast; j >= jstart; --j) {
                const int cur = j & 1, nxt = cur ^ 1;
                if (j > jstart) {
#pragma unroll
                    for (int u = 0; u < 2; ++u) { kr[u] = *(const v4u*)(kg[u] + (size_t)(j - 1) * 64 * 4096); vr[u] = *(const v4u*)(vg[u] + (size_t)(j - 1) * 64 * 4096); }
                    if (tid < 64) br = (cref - CUM[(size_t)bh * SEQ + (j - 1) * 64 + tid]) * SQD;
                }
                if (64 * j <= qmin + 31) {
                    LAS unsigned char* Kc = Kb + cur * FX_KB; LAS unsigned char* Vc = Vb + cur * FX_VB; LAS float* Bc = Bs + cur * 64;
                    f32x16 S[2];
#pragma unroll
                    for (int sub = 0; sub < 2; ++sub) {
#pragma unroll
                        for (int g = 0; g < 4; ++g) { const f32x4 bv = *(const LAS f32x4*)(Bc + 32 * sub + 8 * g + 4 * hi);
                            S[sub][4 * g] = bv.x; S[sub][4 * g + 1] = bv.y; S[sub][4 * g + 2] = bv.z; S[sub][4 * g + 3] = bv.w; }
#pragma unroll
                        for (int ks = 0; ks < 8; ++ks) { const bf16x8 a = *(const LAS bf16x8*)(Kc + (32 * sub + r) * 272 + (16 * ks + 8 * hi) * 2);
                            S[sub] = MFMA32(a, Qf[ks], S[sub]); }
                    }
                    if (64 * j + 63 > qmin) {
                        const int qi = qmin + r;
#pragma unroll
                        for (int sub = 0; sub < 2; ++sub)
#pragma unroll
                            for (int i = 0; i < 16; ++i) { const int key = 64 * j + 32 * sub + crow32(i, hi); if (key > qi) S[sub][i] = -INFINITY; }
                    }
                    float mx = S[0][0];
#pragma unroll
                    for (int i = 1; i < 16; ++i) mx = fmaxf(mx, S[0][i]);
#pragma unroll
                    for (int i = 0; i < 16; ++i) mx = fmaxf(mx, S[1][i]);
                    mx = fmaxf(mx, __shfl_xor(mx, 32));
                    const float m_new = fmaxf(m_old, mx);
                    const float alpha = __builtin_amdgcn_exp2f((m_old - m_new) * c2);
                    const float nm = -m_new * c2;
                    m_old = m_new;
                    float ps = 0.f;
#pragma unroll
                    for (int sub = 0; sub < 2; ++sub)
#pragma unroll
                        for (int i = 0; i < 16; ++i) { const float p = __builtin_amdgcn_exp2f(fmaf(S[sub][i], c2, nm)); S[sub][i] = p; ps += p; }
                    lsum = lsum * alpha + ps;
                    if (!__all(alpha == 1.f)) {
#pragma unroll
                        for (int dt = 0; dt < 4; ++dt)
#pragma unroll
                            for (int i = 0; i < 16; ++i) O[dt][i] *= alpha;
                    }
                    __builtin_amdgcn_sched_barrier(0);
                    bf16x8 Pf[4];
#pragma unroll
                    for (int kk = 0; kk < 4; ++kk) { const int sub = kk >> 1, s = kk & 1; v4u w;
                        w.x = pk2(S[sub][8 * s], S[sub][8 * s + 1]); w.y = pk2(S[sub][8 * s + 2], S[sub][8 * s + 3]);
                        w.z = pk2(S[sub][8 * s + 4], S[sub][8 * s + 5]); w.w = pk2(S[sub][8 * s + 6], S[sub][8 * s + 7]);
                        Pf[kk] = __builtin_bit_cast(bf16x8, w); }
#pragma unroll
                    for (int dt = 0; dt < 4; ++dt) { __builtin_amdgcn_sched_barrier(0);
#pragma unroll
                        for (int kk = 0; kk < 4; ++kk) {
                            const LAS unsigned char* vp = Vc + (16 * kk + 4 * hi + ((lane & 15) >> 2)) * 320 + 64 * dt + 32 * ((lane >> 4) & 1) + 8 * (lane & 3);
                            const v4i16_t lo = fx_vtr(vp), hi4 = fx_vtr(vp + 8 * 320);
                            const bf16x8 a = __builtin_shufflevector(lo, hi4, 0, 1, 2, 3, 4, 5, 6, 7);
                            O[dt] = MFMA32(a, Pf[kk], O[dt]); } }
                }
                { float mm = m_old;
#pragma unroll
                  for (int o = 1; o < 32; o <<= 1) mm = fminf(mm, __shfl_xor(mm, o));
                  if (lane == 0) Ms[cur * 8 + wave] = mm; }
                if (j > jstart) {
#pragma unroll
                    for (int u = 0; u < 2; ++u) { *(LAS v4u*)(Kb + nxt * FX_KB + klds[u]) = kr[u]; *(LAS v4u*)(Vb + nxt * FX_VB + vlds[u]) = vr[u]; }
                    if (tid < 64) Bs[nxt * 64 + tid] = br;
                }
                __syncthreads();
                if (j > jstart) { float mn = Ms[cur * 8];
#pragma unroll
                    for (int w = 1; w < 8; ++w) mn = fminf(mn, Ms[cur * 8 + w]);
                    if ((Bq + Bs[nxt * 64 + 63] - mn) * 0.08838834764831845f <= -30.f) break; }
            }
            const float lt = lsum + __shfl_xor(lsum, 32);
            const float inv = 1.f / lt;
            const size_t trow = (size_t)b * SEQ + qmin + r;
#pragma unroll
            for (int dt = 0; dt < 4; ++dt)
#pragma unroll
                for (int g = 0; g < 4; ++g) { const int d = 32 * dt + 8 * g + 4 * hi;
                    const v2u z = *(const v2u*)(PROJ + trow * 4096 + 3072 + h * 128 + d);
                    const float y0 = O[dt][4 * g] * inv * silu_f(bflo(z.x)), y1 = O[dt][4 * g + 1] * inv * silu_f(bfhi(z.x));
                    const float y2 = O[dt][4 * g + 2] * inv * silu_f(bflo(z.y)), y3 = O[dt][4 * g + 3] * inv * silu_f(bfhi(z.y));
                    v2u o; o.x = pk2(y0, y1); o.y = pk2(y2, y3);
                    *(v2u*)(Y + trow * 1024 + h * 128 + d) = o; }
        }
    }
}
DI int kperm(int s, int q, int jj) { return 32 * s + 16 * (jj >> 2) + 4 * q + (jj & 3); }
DI bf16x8 pack_acc2(const f32x4& X, const f32x4& Y) { v4u w; w.x = pk2(X[0], X[1]); w.y = pk2(X[2], X[3]); w.z = pk2(Y[0], Y[1]); w.w = pk2(Y[2], Y[3]); return __builtin_bit_cast(bf16x8, w); }

DI void st16_wt(void* p, v4u v) {
    __hip_atomic_store((unsigned long long*)p, (unsigned long long)v.x | ((unsigned long long)v.y << 32), __ATOMIC_RELAXED, __HIP_MEMORY_SCOPE_AGENT);
    __hip_atomic_store((unsigned long long*)p + 1, (unsigned long long)v.z | ((unsigned long long)v.w << 32), __ATOMIC_RELAXED, __HIP_MEMORY_SCOPE_AGENT);
}
template <bool DRY>
DI void gdn_prep_phase(bf16* PROJ, bf16* DRYBUF, const bf16* HALO, const float* wconv, const float* BETA, const float* GG, unsigned char* EX, float* GL, unsigned* FLAG,
                       LAS unsigned char* lds, int bid, int G, int FIRST, int tid, int wave, int lane) {
    LAS bf16* QB = (LAS bf16*)lds; LAS bf16* KB = (LAS bf16*)(lds + 17408); LAS bf16* VBt = (LAS bf16*)(lds + 34816);
    LAS float* Lm = (LAS float*)(lds + 52224); LAS float* Tm = (LAS float*)(lds + 68864); LAS float* QKm = (LAS float*)(lds + 85504);
    LAS float* gcS = (LAS float*)(lds + 102144); LAS float* btS = (LAS float*)(lds + 102400); LAS float* Mt = (LAS float*)(lds + 102656);
    LAS float* Wc = (LAS float*)(lds + 119296);
    int hcur = -1;
    for (int e0 = bid - FIRST; e0 < 4096; e0 += G - FIRST) {
        const int bh = e0 & 15, n = e0 >> 4, it = bh * 256 + n, b = bh >> 3, h = bh & 7;
        const size_t t0 = (size_t)b * SEQ + 64 * n;
        if (tid < 64) { float gv = GG[(t0 + tid) * 8 + h]; btS[tid] = BETA[(t0 + tid) * 8 + h];
#pragma unroll
            for (int o = 1; o < 64; o <<= 1) { const float tv = __shfl_up(gv, o); if (lane >= o) gv += tv; }
            gcS[tid] = gv; }
        for (int e = tid; e < 6 * 256; e += NTHR) { const int bq = e >> 8, r = (e >> 4) & 15, c = e & 15;
            const int bi = (bq < 3) ? 0 : (bq < 5 ? 1 : 2), bj = (bq < 3) ? bq + 1 : (bq < 5 ? bq - 1 : 3);
            Tm[(16 * bi + r) * 65 + 16 * bj + c] = 0.f; }
        if (h != hcur) {
            __syncthreads();
            for (int i2 = tid; i2 < 4 * 3 * 128; i2 += NTHR) { const int kk = i2 / 384, rem = i2 - kk * 384; Wc[i2] = wconv[kk * 3072 + (rem >> 7) * 1024 + h * 128 + (rem & 127)]; }
            hcur = h;
            __syncthreads();
        }
#pragma unroll 1
        for (int rnd = 0; rnd < 2; ++rnd) {
        v4u PV[3][4];
#pragma unroll
        for (int s3 = 0; s3 < 3; ++s3) {
            const int idx = wave * 6 + rnd * 3 + s3, mat = idx >> 4, rg = idx & 15;
            const int row = 4 * rg + (lane >> 4), oct = lane & 15, colg = mat * 1024 + h * 128 + 8 * oct;
#pragma unroll
            for (int kk = 0; kk < 4; ++kk) {
                const int rr = row - 3 + kk;
                v4u v = (v4u){0u, 0u, 0u, 0u};
                if (rr >= 0) v = *(const v4u*)(PROJ + (t0 + rr) * 4096 + colg);
                else if (n > 0) v = *(const v4u*)(HALO + ((size_t)(b * 256 + n - 1) * 3 + (rr + 3)) * 3072 + colg);
                PV[s3][kk] = v; }
        }
#pragma unroll
        for (int s3 = 0; s3 < 3; ++s3) {
            const int idx = wave * 6 + rnd * 3 + s3, mat = idx >> 4, rg = idx & 15;
            const int row = 4 * rg + (lane >> 4), oct = lane & 15;
            float a[8];
#pragma unroll
            for (int e = 0; e < 8; ++e) a[e] = 0.f;
#pragma unroll
            for (int kk = 0; kk < 4; ++kk) {
                const v4u v = PV[s3][kk];
                const f32x4 w0 = *(const LAS f32x4*)(Wc + (kk * 3 + mat) * 128 + 8 * oct), w1 = *(const LAS f32x4*)(Wc + (kk * 3 + mat) * 128 + 8 * oct + 4);
                a[0] += w0.x * bflo(v.x); a[1] += w0.y * bfhi(v.x); a[2] += w0.z * bflo(v.y); a[3] += w0.w * bfhi(v.y);
                a[4] += w1.x * bflo(v.z); a[5] += w1.y * bfhi(v.z); a[6] += w1.z * bflo(v.w); a[7] += w1.w * bfhi(v.w);
            }
            float ss = 0.f;
#pragma unroll
            for (int e = 0; e < 8; ++e) { a[e] = silu_f(a[e]); ss += a[e] * a[e]; }
            ss += __shfl_xor(ss, 1); ss += __shfl_xor(ss, 2); ss += __shfl_xor(ss, 4); ss += __shfl_xor(ss, 8);
            float rs = 1.f;
            if (mat == 0) rs = rsqrtf(ss + EPS) * 0.08838834764831845f; else if (mat == 1) rs = rsqrtf(ss + EPS);
            v4u o; o.x = pk2(a[0] * rs, a[1] * rs); o.y = pk2(a[2] * rs, a[3] * rs); o.z = pk2(a[4] * rs, a[5] * rs); o.w = pk2(a[6] * rs, a[7] * rs);
            LAS bf16* dst = (mat == 0 ? QB : (mat == 1 ? KB : VBt)) + row * 136 + 8 * oct;
            *(LAS v4u*)dst = o;
        }
        }
        __syncthreads();
        { const int isq = wave >> 2, m = wave & 3, r16 = lane & 15, q = lane >> 4;
          LAS bf16* As = isq ? QB : KB;
          bf16x8 af[4];
#pragma unroll
          for (int s = 0; s < 4; ++s) af[s] = *(const LAS bf16x8*)(As + (16 * m + r16) * 136 + 32 * s + 8 * q);
#pragma unroll
          for (int nt = 0; nt < 4; ++nt) { f32x4 acc = (f32x4){0.f, 0.f, 0.f, 0.f};
#pragma unroll
              for (int s = 0; s < 4; ++s) { const bf16x8 bfr = *(const LAS bf16x8*)(KB + (16 * nt + r16) * 136 + 32 * s + 8 * q); acc = MFMA16(af[s], bfr, acc); }
#pragma unroll
              for (int jj = 0; jj < 4; ++jj) { const int i = 16 * m + 4 * q + jj, j = 16 * nt + r16;
                  const float dec = __expf(fminf(gcS[i] - gcS[j], 0.f));
                  if (!isq) Lm[i * 65 + j] = (i > j) ? acc[jj] * btS[i] * dec : 0.f;
                  else QKm[i * 65 + j] = (i >= j) ? acc[jj] * dec : 0.f; } }
        }
        __syncthreads();
        const float gl = gcS[63];
        if (wave == 0) {
            const int blk = lane >> 4, col = lane & 15; const LAS float* Lb = Lm + (16 * blk) * 65 + 16 * blk;
            float t[16];
#pragma unroll
            for (int r = 0; r < 16; ++r) { float a = (r == col) ? 1.f : 0.f;
#pragma unroll
                for (int x = 0; x < r; ++x) a -= Lb[r * 65 + x] * t[x];
                t[r] = a; }
#pragma unroll
            for (int r = 0; r < 16; ++r) Tm[(16 * blk + r) * 65 + 16 * blk + col] = t[r];
        } else {
#pragma unroll 1
            for (int p0 = tid - 64; p0 < 4608; p0 += 448) {
                const int sect = p0 >> 10, p = p0 & 1023, l = p & 63, f = p >> 6, q = l >> 4, r16 = l & 15;
                v4u o;
                bf16* dst;
                if (sect == 0) {
                    const int m = f >> 2, s = f & 3, i = 16 * m + r16, c0 = 32 * s + 4 * q;
                    LAS bf16* src = QB + i * 136 + c0;
                    const v2u x0 = *(const LAS v2u*)src, x1 = *(const LAS v2u*)(src + 16);
                    const float sc = __expf(gcS[i]);
                    o.x = pk2(bflo(x0.x) * sc, bfhi(x0.x) * sc); o.y = pk2(bflo(x0.y) * sc, bfhi(x0.y) * sc);
                    o.z = pk2(bflo(x1.x) * sc, bfhi(x1.x) * sc); o.w = pk2(bflo(x1.y) * sc, bfhi(x1.y) * sc);
                    dst = PROJ + (t0 + (p >> 4)) * 4096 + h * 128 + (p & 15) * 8;
                } else if (sect == 1) {
                    o = *(const LAS v4u*)(KB + (p >> 4) * 136 + (p & 15) * 8);
                    dst = PROJ + (t0 + (p >> 4)) * 4096 + 1024 + h * 128 + (p & 15) * 8;
                } else if (sect == 2) {
                    const int w = p >> 7, ll = (p & 127) >> 1, half = p & 1; float y[8];
#pragma unroll
                    for (int jj = 0; jj < 8; ++jj) { const int m = half * 2 + (jj >> 2), rowi = 16 * m + 4 * (ll >> 4) + (jj & 3);
                        y[jj] = bf2f(VBt[rowi * 136 + 16 * w + (ll & 15)]) * btS[rowi]; }
                    o.x = pk2(y[0], y[1]); o.y = pk2(y[2], y[3]); o.z = pk2(y[4], y[5]); o.w = pk2(y[6], y[7]);
                    dst = PROJ + (t0 + (p >> 4)) * 4096 + 2048 + h * 128 + (p & 15) * 8;
                } else if (sect == 3) {
                    if (p >= 32) continue;
                    float y[4];
#pragma unroll
                    for (int jj = 0; jj < 4; ++jj) { const int i = 4 * (p & 15) + jj; y[jj] = (p < 16) ? -btS[i] * __expf(gcS[i]) : __expf(gl - gcS[i]); }
                    o.x = __builtin_bit_cast(unsigned, y[0]); o.y = __builtin_bit_cast(unsigned, y[1]); o.z = __builtin_bit_cast(unsigned, y[2]); o.w = __builtin_bit_cast(unsigned, y[3]);
                    dst = (bf16*)(EX + (size_t)it * 32768 + p * 16);
                } else {
                    const int m = f >> 1, s = f & 1, i = 16 * m + r16; float y[8];
#pragma unroll
                    for (int jj = 0; jj < 8; ++jj) y[jj] = QKm[i * 65 + kperm(s, q, jj)];
                    o.x = pk2(y[0], y[1]); o.y = pk2(y[2], y[3]); o.z = pk2(y[4], y[5]); o.w = pk2(y[6], y[7]);
                    dst = (bf16*)(EX + (size_t)it * 32768 + 24576 + p * 16);
                }
                if (DRY) { dst = DRYBUF + (size_t)(it & 255) * 40960 + p0 * 8; *(v4u*)dst = o; } else st16_wt(dst, o);
            }
        }
        __syncthreads();
#pragma unroll 1
        for (int d = 1; d <= 3; ++d) {
            const int nel = (4 - d) * 256;
            for (int e = tid; e < nel; e += NTHR) { const int bj = e >> 8, r = (e >> 4) & 15, c = e & 15, bi = bj + d;
                const LAS float* Lr = Lm + (16 * bi + r) * 65; const LAS float* Tc = Tm + 16 * bj + c; float a = 0.f;
#pragma unroll 16
                for (int y = 16 * bj; y < 16 * bi; ++y) a += Lr[y] * Tc[y * 65];
                Mt[(16 * bi + r) * 65 + 16 * bj + c] = a; }
            __syncthreads();
            for (int e = tid; e < nel; e += NTHR) { const int bj = e >> 8, r = (e >> 4) & 15, c = e & 15, bi = bj + d;
                const LAS float* Dr = Tm + (16 * bi + r) * 65 + 16 * bi; const LAS float* Mc = Mt + (16 * bi) * 65 + 16 * bj + c; float a = 0.f;
#pragma unroll
                for (int x = 0; x < 16; ++x) a += Dr[x] * Mc[x * 65];
                Tm[(16 * bi + r) * 65 + 16 * bj + c] = -a; }
            __syncthreads();
        }
        { const int p = tid, l = p & 63, f = p >> 6, q = l >> 4, r16 = l & 15, m = f >> 1, s = f & 1, i = 16 * m + r16; float y[8];
#pragma unroll
          for (int jj = 0; jj < 8; ++jj) y[jj] = Tm[i * 65 + kperm(s, q, jj)];
          v4u o; o.x = pk2(y[0], y[1]); o.y = pk2(y[2], y[3]); o.z = pk2(y[4], y[5]); o.w = pk2(y[6], y[7]);
          if (DRY) *(v4u*)(DRYBUF + (size_t)(it & 255) * 40960 + 36864 + p * 8) = o; else st16_wt(EX + (size_t)it * 32768 + 16384 + p * 16, o);
          if (tid == 0 && !DRY) __hip_atomic_store(GL + it, __expf(gl), __ATOMIC_RELAXED, __HIP_MEMORY_SCOPE_AGENT); }
        asm volatile("s_waitcnt vmcnt(0)" ::: "memory");
        __syncthreads();
        if (tid == 0 && !DRY) __hip_atomic_store(FLAG + it, 1u, __ATOMIC_RELAXED, __HIP_MEMORY_SCOPE_AGENT);
    }
}

constexpr int GS_BUF = 57344;
constexpr int GS_QA = 18432, GS_SC = 34816, GS_TA = 36864, GS_QK = 45056, GS_VB = 53248;
DI void gdn_scan_phase(const bf16* PROJ, const unsigned char* EX, const float* GL, const unsigned* FLAG, bf16* ORAW, LAS unsigned char* lds, int bid, int tid, int wave, int lane) {
    if (bid >= 64) return;
    const int bh = bid >> 2, sub = bid & 3, b = bh >> 3, h = bh & 7, q = lane >> 4, r16 = lane & 15;
    LAS unsigned char* OB = lds + 2 * GS_BUF;
    LAS float* GLs = (LAS float*)(lds + 2 * GS_BUF + 8192);
    if (wave >= 2) {
        const int g = (wave - 2) >> 1, i = tid & 127, rowi = i >> 4, pc = i & 15;
        v4u R0[9], R1[9], R2[9]; float G0, G1, G2;
#define GS_LD(R_, G_, n_) do { G_ = GL[bh * 256 + (n_)]; const size_t t0_ = (size_t)b * SEQ + 64 * (n_); const unsigned char* ex_ = EX + (size_t)(bh * 256 + (n_)) * 32768; \
        _Pragma("unroll") for (int u = 0; u < 9; ++u) { const int c = g + 3 * u; const int k = c < 17 ? c : c + 7; \
            const unsigned char* base_; size_t stride_; \
            if (k < 8) { base_ = (const unsigned char*)(PROJ + (t0_ + 8 * k) * 4096 + 1024 + h * 128); stride_ = 8192; } \
            else if (k < 16) { base_ = (const unsigned char*)(PROJ + (t0_ + 8 * (k - 8)) * 4096 + h * 128); stride_ = 8192; } \
            else if (k < 32) { base_ = ex_ + (size_t)(k - 16) * 2048; stride_ = 256; } \
            else { base_ = (const unsigned char*)(PROJ + (t0_ + 8 * (2 * sub + (k - 32))) * 4096 + 2048 + h * 128); stride_ = 8192; } \
            R_[u] = *(const v4u*)(base_ + (size_t)rowi * stride_ + pc * 16); } } while (0)
#define GS_ST(R_, G_, n_, buf_) do { if (g == 0 && i == 0) GLs[(n_)] = G_; _Pragma("unroll") for (int u = 0; u < 9; ++u) { const int c = g + 3 * u; const int k = c < 17 ? c : c + 7; \
            int d_; if (k < 8) d_ = (8 * k + rowi) * 288 + pc * 16; else if (k < 16) d_ = GS_QA + (k - 8) * 2048 + i * 16; else if (k == 16) d_ = GS_SC + i * 16; \
            else if (k < 28) d_ = GS_TA + (k - 24) * 2048 + i * 16; else if (k < 32) d_ = GS_QK + (k - 28) * 2048 + i * 16; else d_ = GS_VB + (k - 32) * 2048 + i * 16; \
            *(LAS v4u*)((buf_) + d_) = R_[u]; } } while (0)
#define GS_OUT(n_) do { if (g == 2) { const size_t t0_ = (size_t)b * SEQ + 64 * (n_); \
        _Pragma("unroll") for (int u = 0; u < 2; ++u) { const int p = i + 128 * u, row = p >> 2, c = p & 3; \
            const v4u v = *(const LAS v4u*)(OB + ((n_) & 1) * 4096 + row * 64 + c * 16); \
            *(v4u*)(ORAW + (t0_ + row) * 1024 + h * 128 + 32 * sub + 8 * c) = v; } } } while (0)
        __syncthreads();
        GS_LD(R0, G0, 0); GS_LD(R1, G1, 1); GS_LD(R2, G2, 2);
        GS_ST(R0, G0, 0, lds);
        __syncthreads();
#define GS_STEP(n_, Rst_, Gst_, Rld_, Gld_) do { if ((n_) < 256) { if ((n_) + 3 < 256) GS_LD(Rld_, Gld_, (n_) + 3); if ((n_) >= 1) GS_OUT((n_) - 1); \
            if ((n_) + 1 < 256) GS_ST(Rst_, Gst_, (n_) + 1, lds + (((n_) + 1) & 1) * GS_BUF); __syncthreads(); } } while (0)
#pragma unroll 1
        for (int n = 0; n < 258; n += 3) {
            GS_STEP(n, R1, G1, R0, G0);
            GS_STEP(n + 1, R2, G2, R1, G1);
            GS_STEP(n + 2, R0, G0, R2, G2);
        }
        GS_OUT(255);
#undef GS_LD
#undef GS_ST
#undef GS_OUT
#undef GS_STEP
        return;
    }
    f32x4 S[8];
#pragma unroll
    for (int i = 0; i < 8; ++i) S[i] = (f32x4){0.f, 0.f, 0.f, 0.f};
    const unsigned* fl = FLAG + bh * 256;
#define GS_POLL(c_) do { unsigned sp_ = 0; while (__builtin_amdgcn_readfirstlane(__hip_atomic_load(fl + (c_), __ATOMIC_RELAXED, __HIP_MEMORY_SCOPE_AGENT)) == 0u) { __builtin_amdgcn_s_sleep(2); if (++sp_ > (1u << 22)) break; } } while (0)
    if (wave == 0) { GS_POLL(0); GS_POLL(1); GS_POLL(2); GS_POLL(3); __builtin_amdgcn_fence(__ATOMIC_ACQUIRE, "agent"); asm volatile("s_waitcnt vmcnt(0)" ::: "memory"); }
    __syncthreads();
    __syncthreads();
#pragma unroll 1
    for (int n = 0; n < 256; ++n) {
        LAS unsigned char* buf = lds + (n & 1) * GS_BUF;
        const float egl = GLs[n];
        unsigned fnext = 1u;
        if (wave == 0 && n + 4 < 256) fnext = __hip_atomic_load(fl + n + 4, __ATOMIC_RELAXED, __HIP_MEMORY_SCOPE_AGENT);
        f32x4 rhs[4];
        { const v4u vb0 = *(const LAS v4u*)(buf + GS_VB + wave * 2048 + lane * 32), vb1 = *(const LAS v4u*)(buf + GS_VB + wave * 2048 + lane * 32 + 16);
          rhs[0] = (f32x4){bflo(vb0.x), bfhi(vb0.x), bflo(vb0.y), bfhi(vb0.y)}; rhs[1] = (f32x4){bflo(vb0.z), bfhi(vb0.z), bflo(vb0.w), bfhi(vb0.w)};
          rhs[2] = (f32x4){bflo(vb1.x), bfhi(vb1.x), bflo(vb1.y), bfhi(vb1.y)}; rhs[3] = (f32x4){bflo(vb1.z), bfhi(vb1.z), bflo(vb1.w), bfhi(vb1.w)}; }
        bf16x8 Sb[4];
#pragma unroll
        for (int s = 0; s < 4; ++s) Sb[s] = pack_acc2(S[2 * s], S[2 * s + 1]);
        f32x4 tk[4];
#pragma unroll
        for (int m = 0; m < 4; ++m) tk[m] = (f32x4){0.f, 0.f, 0.f, 0.f};
#pragma unroll
        for (int s = 0; s < 4; ++s)
#pragma unroll
            for (int m = 0; m < 4; ++m) { const LAS unsigned char* kp = buf + (16 * m + r16) * 288 + (32 * s + 4 * q) * 2;
                const v2u lo = *(const LAS v2u*)kp, hi2 = *(const LAS v2u*)(kp + 32);
                v4u w; w.x = lo.x; w.y = lo.y; w.z = hi2.x; w.w = hi2.y;
                tk[m] = MFMA16(__builtin_bit_cast(bf16x8, w), Sb[s], tk[m]); }
#pragma unroll
        for (int m = 0; m < 4; ++m) { const f32x4 sc1 = *(const LAS f32x4*)(buf + GS_SC + (16 * m + 4 * q) * 4); rhs[m] = rhs[m] + sc1 * tk[m]; }
        __builtin_amdgcn_sched_barrier(0);
        bf16x8 Rb[2];
#pragma unroll
        for (int s = 0; s < 2; ++s) Rb[s] = pack_acc2(rhs[2 * s], rhs[2 * s + 1]);
        f32x4 vn[4];
#pragma unroll
        for (int m = 0; m < 4; ++m) vn[m] = (f32x4){0.f, 0.f, 0.f, 0.f};
#pragma unroll
        for (int s = 0; s < 2; ++s)
#pragma unroll
            for (int m = 0; m < 4; ++m) { const bf16x8 a = *(const LAS bf16x8*)(buf + GS_TA + (m * 2 + s) * 1024 + lane * 16); vn[m] = MFMA16(a, Rb[s], vn[m]); }
        __builtin_amdgcn_sched_barrier(0);
        bf16x8 Vb[2];
#pragma unroll
        for (int s = 0; s < 2; ++s) Vb[s] = pack_acc2(vn[2 * s], vn[2 * s + 1]);
        bf16x8 Vs[2];
        { f32x4 vsc[4];
#pragma unroll
          for (int m = 0; m < 4; ++m) { const f32x4 sc2 = *(const LAS f32x4*)(buf + GS_SC + 256 + (16 * m + 4 * q) * 4); vsc[m] = vn[m] * sc2; }
#pragma unroll
          for (int s = 0; s < 2; ++s) Vs[s] = pack_acc2(vsc[2 * s], vsc[2 * s + 1]); }
#pragma unroll
        for (int m8 = 0; m8 < 8; ++m8) S[m8] = S[m8] * egl;
#pragma unroll
        for (int s = 0; s < 2; ++s)
#pragma unroll
            for (int m8 = 0; m8 < 8; ++m8) {
                const LAS unsigned char* tp = buf + (32 * s + 4 * q + ((lane & 15) >> 2)) * 288 + 32 * m8 + 8 * (lane & 3);
                const v4i16_t lo = fx_vtr(tp), hi4 = fx_vtr(tp + 16 * 288);
                S[m8] = MFMA16(__builtin_shufflevector(lo, hi4, 0, 1, 2, 3, 4, 5, 6, 7), Vs[s], S[m8]); }
        __builtin_amdgcn_sched_barrier(0);
        f32x4 o[4];
#pragma unroll
        for (int m = 0; m < 4; ++m) o[m] = (f32x4){0.f, 0.f, 0.f, 0.f};
#pragma unroll
        for (int s = 0; s < 4; ++s)
#pragma unroll
            for (int m = 0; m < 4; ++m) { const bf16x8 a = *(const LAS bf16x8*)(buf + GS_QA + (m * 4 + s) * 1024 + lane * 16); o[m] = MFMA16(a, Sb[s], o[m]); }
#pragma unroll
        for (int s = 0; s < 2; ++s)
#pragma unroll
            for (int m = 0; m < 4; ++m) { const bf16x8 a = *(const LAS bf16x8*)(buf + GS_QK + (m * 2 + s) * 1024 + lane * 16); o[m] = MFMA16(a, Vb[s], o[m]); }
        __builtin_amdgcn_sched_barrier(0);
        { LAS bf16* ob = (LAS bf16*)(OB + (n & 1) * 4096);
#pragma unroll
          for (int m = 0; m < 4; ++m)
#pragma unroll
              for (int j = 0; j < 4; ++j) ob[(16 * m + 4 * q + j) * 32 + 16 * wave + r16] = (bf16)f2bf(o[m][j]); }
        if (wave == 0 && n + 4 < 256) { if (__builtin_amdgcn_readfirstlane(fnext) == 0u) GS_POLL(n + 4);
            __builtin_amdgcn_fence(__ATOMIC_ACQUIRE, "agent"); asm volatile("s_waitcnt vmcnt(0)" ::: "memory"); }
        __syncthreads();
    }
#undef GS_POLL
}

DI void gdn_onorm_phase(bf16* OY, const bf16* PROJ, const float* wn, float* ROPE, const int* pos, int gw, int NGW, int lane) {
    constexpr int NR = 4;
    for (int row = gw; row < TT; row += NGW) {
        if (lane < 32) { const float inv = powf(10000.f, -(float)lane * (1.f / 32.f)); const float ang = (float)pos[row] * inv; float sn, cs; sincosf(ang, &sn, &cs);
            ROPE[(size_t)row * 64 + lane] = cs; ROPE[(size_t)row * 64 + 32 + lane] = sn; } }
    float wv[16];
#pragma unroll
    for (int e = 0; e < 16; ++e) wv[e] = wn[16 * (lane & 7) + e];
    for (int row0 = gw * NR; row0 < TT; row0 += NGW * NR) {
        v4u o0[NR], o1[NR], z0[NR], z1[NR];
#pragma unroll
        for (int rr = 0; rr < NR; ++rr) { const bf16* op = OY + (size_t)(row0 + rr) * 1024 + 16 * lane; const bf16* zp = PROJ + (size_t)(row0 + rr) * 4096 + 3072 + 16 * lane;
            o0[rr] = *(const v4u*)op; o1[rr] = *(const v4u*)(op + 8); z0[rr] = *(const v4u*)zp; z1[rr] = *(const v4u*)(zp + 8); }
#pragma unroll
        for (int rr = 0; rr < NR; ++rr) {
            bf16* op = OY + (size_t)(row0 + rr) * 1024 + 16 * lane;
            float ov[16], zv[16];
#pragma unroll
            for (int e = 0; e < 4; ++e) { ov[2 * e] = bflo(o0[rr][e]); ov[2 * e + 1] = bfhi(o0[rr][e]); ov[8 + 2 * e] = bflo(o1[rr][e]); ov[8 + 2 * e + 1] = bfhi(o1[rr][e]);
                zv[2 * e] = bflo(z0[rr][e]); zv[2 * e + 1] = bfhi(z0[rr][e]); zv[8 + 2 * e] = bflo(z1[rr][e]); zv[8 + 2 * e + 1] = bfhi(z1[rr][e]); }
            float ss = 0.f;
#pragma unroll
            for (int e = 0; e < 16; ++e) ss += ov[e] * ov[e];
            ss += __shfl_xor(ss, 1); ss += __shfl_xor(ss, 2); ss += __shfl_xor(ss, 4);
            const float rs = rsqrtf(ss * (1.f / 128.f) + EPS);
            float y[16];
#pragma unroll
            for (int e = 0; e < 16; ++e) y[e] = ov[e] * rs * wv[e] * silu_f(zv[e]);
            v4u a, c; a.x = pk2(y[0], y[1]); a.y = pk2(y[2], y[3]); a.z = pk2(y[4], y[5]); a.w = pk2(y[6], y[7]);
            c.x = pk2(y[8], y[9]); c.y = pk2(y[10], y[11]); c.z = pk2(y[12], y[13]); c.w = pk2(y[14], y[15]);
            *(v4u*)op = a; *(v4u*)(op + 8) = c;
        }
    }
}
DI void swa_phase(const bf16* PROJ, const float* ROPE, const float* sinks, bf16* Y, LAS unsigned char* lds, int bid, int G, int tid, int wave, int lane) {
    LAS bf16* Ks = (LAS bf16*)lds;
    LAS bf16* Vs = (LAS bf16*)(lds + 36864);
    const int r = lane & 31, hi = lane >> 5;
    const float LOG2E = 1.4426950408889634f, c2 = 0.125f * LOG2E;
    for (int it = bid; it < 1024; it += G) {
        const int hk = it & 3, nb = (it >> 2) & 127, b = it >> 9;
        const long tb0 = (long)b * SEQ + (long)(nb - 1) * 128;
#pragma unroll
        for (int u = 0; u < 2; ++u) { const int p = tid + 512 * u, kk = p >> 2, o = p & 3;
            v4u w1 = (v4u){0u, 0u, 0u, 0u}, w2 = (v4u){0u, 0u, 0u, 0u};
            if (nb > 0 || kk >= 128) {
                const size_t t = (size_t)(tb0 + kk);
                const bf16* kp = PROJ + t * 2560 + 1024 + hk * 64 + 8 * o;
                const v4u a = *(const v4u*)kp, c = *(const v4u*)(kp + 32);
                const f32x4 cs0 = *(const f32x4*)(ROPE + t * 64 + 8 * o), cs1 = *(const f32x4*)(ROPE + t * 64 + 8 * o + 4);
                const f32x4 sn0 = *(const f32x4*)(ROPE + t * 64 + 32 + 8 * o), sn1 = *(const f32x4*)(ROPE + t * 64 + 32 + 8 * o + 4);
                float x1[8], x2[8], cs[8], sn[8];
#pragma unroll
                for (int e = 0; e < 4; ++e) { x1[2 * e] = bflo(a[e]); x1[2 * e + 1] = bfhi(a[e]); x2[2 * e] = bflo(c[e]); x2[2 * e + 1] = bfhi(c[e]);
                    cs[e] = cs0[e]; cs[4 + e] = cs1[e]; sn[e] = sn0[e]; sn[4 + e] = sn1[e]; }
                float y1[8], y2[8];
#pragma unroll
                for (int e = 0; e < 8; ++e) { y1[e] = x1[e] * cs[e] - x2[e] * sn[e]; y2[e] = x2[e] * cs[e] + x1[e] * sn[e]; }
                w1.x = pk2(y1[0], y1[1]); w1.y = pk2(y1[2], y1[3]); w1.z = pk2(y1[4], y1[5]); w1.w = pk2(y1[6], y1[7]);
                w2.x = pk2(y2[0], y2[1]); w2.y = pk2(y2[2], y2[3]); w2.z = pk2(y2[4], y2[5]); w2.w = pk2(y2[6], y2[7]);
            }
            *(LAS v4u*)(Ks + kk * 72 + 8 * o) = w1; *(LAS v4u*)(Ks + kk * 72 + 32 + 8 * o) = w2; }
#pragma unroll
        for (int u = 0; u < 4; ++u) { const int p = tid + 512 * u, kk = p >> 3, o8 = p & 7;
            v4u v = (v4u){0u, 0u, 0u, 0u};
            if (nb > 0 || kk >= 128) v = *(const v4u*)(PROJ + (size_t)(tb0 + kk) * 2560 + 1280 + hk * 64 + 8 * o8);
            const int pos = (kk & ~15) + perm16(kk & 15);
            LAS bf16* d = Vs + (8 * o8) * 264 + pos;
            d[0] = (bf16)(v.x & 0xffffu); d[264] = (bf16)(v.x >> 16); d[2 * 264] = (bf16)(v.y & 0xffffu); d[3 * 264] = (bf16)(v.y >> 16);
            d[4 * 264] = (bf16)(v.z & 0xffffu); d[5 * 264] = (bf16)(v.z >> 16); d[6 * 264] = (bf16)(v.w & 0xffffu); d[7 * 264] = (bf16)(v.w >> 16); }
        __syncthreads();
        const int g = wave >> 1, qh = wave & 1, head = hk * 4 + g;
        const float sink2 = sinks[head] * LOG2E;
        for (int sb = 0; sb < 2; ++sb) {
            const int qs = 64 * qh + 32 * sb, qi = qs + r, tbase = qs >> 5;
            const size_t t = (size_t)b * SEQ + (size_t)nb * 128 + qi;
            bf16x8 Qf[4];
            { const bf16* qp = PROJ + t * 2560 + head * 64 + 8 * hi;
              v4u qa[4];
#pragma unroll
              for (int ks = 0; ks < 4; ++ks) qa[ks] = *(const v4u*)(qp + 16 * ks);
#pragma unroll
              for (int k2 = 0; k2 < 2; ++k2) {
                  const f32x4 cs0 = *(const f32x4*)(ROPE + t * 64 + 16 * k2 + 8 * hi), cs1 = *(const f32x4*)(ROPE + t * 64 + 16 * k2 + 8 * hi + 4);
                  const f32x4 sn0 = *(const f32x4*)(ROPE + t * 64 + 32 + 16 * k2 + 8 * hi), sn1 = *(const f32x4*)(ROPE + t * 64 + 32 + 16 * k2 + 8 * hi + 4);
                  float y1[8], y2[8];
#pragma unroll
                  for (int e = 0; e < 4; ++e) {
                      const float a0 = bflo(qa[k2][e]), a1 = bfhi(qa[k2][e]), c0 = bflo(qa[k2 + 2][e]), c1 = bfhi(qa[k2 + 2][e]);
                      const float cA = (e < 2) ? cs0[2 * e] : cs1[2 * e - 4], cB = (e < 2) ? cs0[2 * e + 1] : cs1[2 * e - 3];
                      const float sA = (e < 2) ? sn0[2 * e] : sn1[2 * e - 4], sB = (e < 2) ? sn0[2 * e + 1] : sn1[2 * e - 3];
                      y1[2 * e] = a0 * cA - c0 * sA; y2[2 * e] = c0 * cA + a0 * sA;
                      y1[2 * e + 1] = a1 * cB - c1 * sB; y2[2 * e + 1] = c1 * cB + a1 * sB; }
                  v4u w1, w2;
                  w1.x = pk2(y1[0], y1[1]); w1.y = pk2(y1[2], y1[3]); w1.z = pk2(y1[4], y1[5]); w1.w = pk2(y1[6], y1[7]);
                  w2.x = pk2(y2[0], y2[1]); w2.y = pk2(y2[2], y2[3]); w2.z = pk2(y2[4], y2[5]); w2.w = pk2(y2[6], y2[7]);
                  Qf[k2] = __builtin_bit_cast(bf16x8, w1); Qf[k2 + 2] = __builtin_bit_cast(bf16x8, w2); } }
            f32x16 S[5];
            float mx = sink2;
#pragma unroll
            for (int tk = 0; tk < 5; ++tk) {
#pragma unroll
                for (int i = 0; i < 16; ++i) S[tk][i] = 0.f;
                const int kt = tbase + tk;
#pragma unroll
                for (int ks = 0; ks < 4; ++ks) { const bf16x8 a = *(const LAS bf16x8*)(Ks + (32 * kt + r) * 72 + 16 * ks + 8 * hi); S[tk] = MFMA32(a, Qf[ks], S[tk]); }
#pragma unroll
                for (int i = 0; i < 16; ++i) { const int kk = 32 * kt + crow32(i, hi);
                    const bool ok = (kk > qi) && (kk <= qi + 128) && (nb > 0 || kk >= 128);
                    const float xv = ok ? S[tk][i] * c2 : -INFINITY; S[tk][i] = xv; mx = fmaxf(mx, xv); }
            }
            mx = fmaxf(mx, __shfl_xor(mx, 32));
            float ps = 0.f;
#pragma unroll
            for (int tk = 0; tk < 5; ++tk)
#pragma unroll
                for (int i = 0; i < 16; ++i) { const float p = __builtin_amdgcn_exp2f(S[tk][i] - mx); S[tk][i] = p; ps += p; }
            const float tot = ps + __shfl_xor(ps, 32) + __builtin_amdgcn_exp2f(sink2 - mx);
            const float inv = 1.f / tot;
            f32x16 O[2];
#pragma unroll
            for (int dt = 0; dt < 2; ++dt)
#pragma unroll
                for (int i = 0; i < 16; ++i) O[dt][i] = 0.f;
#pragma unroll
            for (int tk = 0; tk < 5; ++tk)
#pragma unroll
                for (int s = 0; s < 2; ++s) { v4u w;
                    w.x = pk2(S[tk][8 * s], S[tk][8 * s + 1]); w.y = pk2(S[tk][8 * s + 2], S[tk][8 * s + 3]);
                    w.z = pk2(S[tk][8 * s + 4], S[tk][8 * s + 5]); w.w = pk2(S[tk][8 * s + 6], S[tk][8 * s + 7]);
                    const bf16x8 pf = __builtin_bit_cast(bf16x8, w);
                    const int kt = tbase + tk;
#pragma unroll
                    for (int dt = 0; dt < 2; ++dt) { const bf16x8 a = *(const LAS bf16x8*)(Vs + (32 * dt + r) * 264 + 32 * kt + 16 * s + 8 * hi); O[dt] = MFMA32(a, pf, O[dt]); } }
#pragma unroll
            for (int dt = 0; dt < 2; ++dt)
#pragma unroll
                for (int g4 = 0; g4 < 4; ++g4) { const int d = 32 * dt + 8 * g4 + 4 * hi;
                    const v2u z = *(const v2u*)(PROJ + t * 2560 + 1536 + head * 64 + d);
                    const float y0 = O[dt][4 * g4] * inv * silu_f(bflo(z.x)), y1 = O[dt][4 * g4 + 1] * inv * silu_f(bfhi(z.x));
                    const float y2 = O[dt][4 * g4 + 2] * inv * silu_f(bflo(z.y)), y3 = O[dt][4 * g4 + 3] * inv * silu_f(bfhi(z.y));
                    v2u o; o.x = pk2(y0, y1); o.y = pk2(y2, y3);
                    *(v2u*)(Y + t * 1024 + head * 64 + d) = o; }
        }
        __syncthreads();
    }
}
#ifndef LAYER_MASK
#define LAYER_MASK 15
#endif
__global__ void __launch_bounds__(NTHR, 2) mega_fwd(Ptrs P) {
    extern __shared__ __attribute__((aligned(16))) unsigned char lds_raw[];
    LAS unsigned char* lds = (LAS unsigned char*)lds_raw;
    cg::grid_group grid = cg::this_grid();
    int tid_o = threadIdx.x; int tid = tid_o, lane = tid & 63; const int wave = __builtin_amdgcn_readfirstlane(tid >> 6);
    const int G = gridDim.x, bid = blockIdx.x;
    const int gw = bid * NWAVES + wave, NGW = G * NWAVES, NG = G * NTHR; int gtid = bid * NTHR + tid;
    unsigned char* ws = P.ws;
    const float* x_in = P.in[0]; const int* positions = (const int*)P.in[1];
    const float* norm_w = P.in[2]; const float* fnorm_w = P.in[3];
    float* X = P.out;
    bf16* XB = (bf16*)P.out;
    bf16* XB3 = (bf16*)(ws + WS_EX + 64 * MiB);
    bf16* HY = (bf16*)(ws + WS_HY); bf16* PROJ = (bf16*)(ws + WS_PROJ);
#define RELAUNDER() do { asm volatile("" : "+v"(tid_o)); tid = tid_o; lane = tid & 63; gtid = bid * NTHR + tid; } while (0)
#define GSYNC() do { xcd_barrier(xbar); RELAUNDER(); } while (0)

    unsigned* CTL = (unsigned*)(ws + WS_GL + 65536);
    if (bid == 0 && tid < 128) CTL[tid] = 0u;
    unsigned* FLAGS = (unsigned*)(ws + WS_GL + 131072);
    for (int i = gtid; i < 4096; i += NG) FLAGS[i] = 0u;
    unsigned* XBW = (unsigned*)(ws + WS_GL + 262144);
    volatile LAS unsigned* xst = (volatile LAS unsigned*)(lds + LDS_BYTES - 16);
    if (bid == 0) for (int i = tid; i < XCD_BAR_WORDS; i += NTHR) XBW[i] = 0u;
    if (tid < 2) xst[tid] = 0u;
    p0_prologue(P, lds, gw, NGW, wave, lane);
#ifdef DBL_P0
    p0_prologue(P, lds, gw, NGW, wave, lane);
#endif
    norm_phase<0>(x_in, norm_w, HY, nullptr, nullptr, 0, nullptr, nullptr, nullptr, nullptr, nullptr, nullptr, lds, gw, NGW, tid, lane);
    grid.sync();
    RELAUNDER();
    const XcdBarrier xbar = xcd_barrier_post(XBW, xst);
    if (LAYER_MASK & 1) {
        bf16* Y0 = (bf16*)(ws + WS_EX); float* CVH = (float*)(ws + WS_PROJ); float* BND = (float*)(ws + WS_PROJ + 8 * MiB);
        { pg8::Gemm g{HY, (const bf16*)(ws + WS_W0I), TT, 4096, 1024}; pg8::StaticOrder S; S.init(TT, 4096, G, bid);
          pg8::EpiConvGate E{Y0, P.in[5], CVH, BND};
          pg8::gemm_phase<pg8::EpiConvGate, pg8::StaticOrder, true, true>(lds, g, S, E); }
        GSYNC();
        convfix_phase(CVH, BND, P.in[5], Y0, gtid, NG);
        GSYNC();
        { pg8::Gemm g{Y0, (const bf16*)(ws + WS_W0O), TT, 1024, 1024}; pg8::StaticOrder S; S.init(TT, 1024, G, bid);
          pg8::EpiRes<false, true> E{x_in, XB, nullptr};
          pg8::gemm_phase<pg8::EpiRes<false, true>, pg8::StaticOrder, true, true>(lds, g, S, E);
        }
    } else {
        for (size_t i = gtid; i < (size_t)TT * DM / 4; i += NG) { const f32x4 v = ((const f32x4*)x_in)[i]; v2u o; o.x = pk2(v.x, v.y); o.y = pk2(v.z, v.w); ((v2u*)XB)[i] = o; }
    }
    GSYNC();
    if (LAYER_MASK & 2) {
        float* LOGF = (float*)(ws + WS_LOGF); float* CUM = (float*)(ws + WS_CUM); bf16* VT = (bf16*)(ws + WS_EX);
        norm_phase<1, true>((const float*)XB, norm_w + 1024, HY, nullptr, P.in[7], 4104, LOGF, nullptr, P.in[8], nullptr, nullptr, nullptr, lds, gw, NGW, tid, lane);
        GSYNC();
        if (bid < 16) fox_cumsum(LOGF, CUM, bid, lds, tid);
        { pg8::Gemm g{HY, (const bf16*)(ws + WS_W1I), TT, 4096, 1024}; pg8::StaticOrder S; S.init(TT, 4096, G, bid);
          pg8::EpiStore E{PROJ, 4096, nullptr};
          pg8::gemm_phase<pg8::EpiStore, pg8::StaticOrder, true, true>(lds, g, S, E); }
        GSYNC();
        fox_norms_phase(PROJ, (float*)(CTL + 1024), gw, NGW, lane);
#ifdef DBL_VTRANS
        fox_norms_phase(PROJ, (float*)(CTL + 1024), gw, NGW, lane);
#endif
        GSYNC();
        fox_attn_phase(PROJ, CUM, HY, (const float*)(CTL + 1024), CTL + 64, lds, bid, G, tid, wave, lane);
#ifdef DBL_FOX
        fox_attn_phase(PROJ, CUM, HY, (const float*)(CTL + 1024), CTL + 65, lds, bid, G, tid, wave, lane);
#endif
        GSYNC();
        { pg8::Gemm g{HY, (const bf16*)(ws + WS_W1O), TT, 1024, 1024}; pg8::StaticOrder S; S.init(TT, 1024, G, bid);
          pg8::EpiRes<true, true> E{XB, XB, nullptr};
          pg8::gemm_phase<pg8::EpiRes<true, true>, pg8::StaticOrder, true, true>(lds, g, S, E); }
        GSYNC();
    }
    if (LAYER_MASK & 4) {
        float* BETA = (float*)(ws + WS_LOGF); float* GG = (float*)(ws + WS_CUM); float* GL = (float*)(ws + WS_GL); bf16* HALO = (bf16*)(ws + WS_HALO);
        norm_phase<2, true>((const float*)XB, norm_w + 2048, HY, nullptr, P.in[10], 4112, BETA, GG, P.in[12], P.in[13], nullptr, nullptr, lds, gw, NGW, tid, lane);
#ifdef DBL_NORM2
        norm_phase<2, true>((const float*)XB, norm_w + 2048, HY, nullptr, P.in[10], 4112, BETA, GG, P.in[12], P.in[13], nullptr, nullptr, lds, gw, NGW, tid, lane);
#endif
        GSYNC();
        { pg8::Gemm g{HY, (const bf16*)(ws + WS_W2I), TT, 4096, 1024}; pg8::StaticOrder S; S.init(TT, 4096, G, bid);
          pg8::EpiStore E{PROJ, 4096, HALO};
          pg8::gemm_phase<pg8::EpiStore, pg8::StaticOrder, true, true>(lds, g, S, E); }
        GSYNC();
        if (bid >= 64) gdn_prep_phase<false>(PROJ, HY, HALO, P.in[11], BETA, GG, ws + WS_EX, GL, FLAGS, lds, bid, G, 64, tid, wave, lane);
        else gdn_scan_phase(PROJ, ws + WS_EX, GL, FLAGS, HY, lds, bid, tid, wave, lane);
        GSYNC();
        gdn_onorm_phase(HY, PROJ, P.in[14], (float*)(ws + WS_EX), positions, gw, NGW, lane);
        GSYNC();
        { pg8::Gemm g{HY, (const bf16*)(ws + WS_W2O), TT, 1024, 1024}; pg8::StaticOrder S; S.init(TT, 1024, G, bid);
          pg8::EpiRes<true, true, true> E{XB, XB3, (float*)(ws + WS_LOGF)};
          pg8::gemm_phase<pg8::EpiRes<true, true, true>, pg8::StaticOrder, true, true>(lds, g, S, E); }
        GSYNC();
    }
    if (LAYER_MASK & 8) {
        float* ROPE = (float*)(ws + WS_EX);
        { pg8::Gemm g{XB3, (const bf16*)(ws + WS_W3I), TT, 2560, 1024}; pg8::StaticOrder S; S.init(TT, 2560, G, bid);
          pg8::EpiStoreScaled E{PROJ, 2560, (const float*)(ws + WS_LOGF)};
          pg8::gemm_phase<pg8::EpiStoreScaled, pg8::StaticOrder, true, true>(lds, g, S, E); }
        GSYNC();
        swa_phase(PROJ, ROPE, P.in[17], HY, lds, bid, G, tid, wave, lane);
#ifdef DBL_SWA
        swa_phase(PROJ, ROPE, P.in[17], HY, lds, bid, G, tid, wave, lane);
#endif
        GSYNC();
        { pg8::Gemm g{HY, (const bf16*)(ws + WS_W3O), TT, 1024, 1024}; pg8::StaticOrder S; S.init(TT, 1024, G, bid);
          pg8::EpiRes<true, false> E{XB3, X, nullptr};
          pg8::gemm_phase<pg8::EpiRes<true, false>, pg8::StaticOrder, true, true>(lds, g, S, E); }
        GSYNC();
    }
#ifdef DBL_SYNC
    for (int i = 0; i < 10; ++i) GSYNC();
#endif
#ifdef DBL_FINAL
    norm_phase<0>(X, fnorm_w, HY, nullptr, nullptr, 0, nullptr, nullptr, nullptr, nullptr, nullptr, nullptr, lds, gw, NGW, tid, lane);
#endif
    norm_phase<4>(X, fnorm_w, nullptr, X, nullptr, 0, nullptr, nullptr, nullptr, nullptr, nullptr, nullptr, lds, gw, NGW, tid, lane);
}

extern "C" void kernel_launch(void* const* d_in, const int* in_sizes, int n_in, void* d_out, int out_size, void* d_ws, size_t ws_size, hipStream_t stream) {
    static int grid = 0;
    if (grid == 0) {
        int dev = 0, cus = 0, per_cu = 0;
        hipGetDevice(&dev);
        hipDeviceGetAttribute(&cus, hipDeviceAttributeMultiprocessorCount, dev);
        if (hipFuncSetAttribute((const void*)mega_fwd, hipFuncAttributeMaxDynamicSharedMemorySize, LDS_BYTES) != hipSuccess) fprintf(stderr, "kernel_launch: hipFuncSetAttribute failed\n");
        if (hipOccupancyMaxActiveBlocksPerMultiprocessor(&per_cu, (const void*)mega_fwd, NTHR, LDS_BYTES) != hipSuccess || per_cu < 1) { fprintf(stderr, "kernel_launch: occupancy query says %d\n", per_cu); per_cu = 1; }
        (void)hipGetLastError();
        grid = cus;
        if (ws_size < WS_END) fprintf(stderr, "kernel_launch: workspace %zu < %zu\n", ws_size, (size_t)WS_END);
    }
    Ptrs p{};
    for (int i = 0; i < 19; ++i) p.in[i] = (const float*)d_in[i];
    p.out = (float*)d_out; p.ws = (unsigned char*)d_ws; p.ph_lo = 0; p.ph_hi = 0;
    void* args[] = {&p};
    hipError_t e = hipLaunchCooperativeKernel((const void*)mega_fwd, dim3(grid), dim3(NTHR), args, LDS_BYTES, stream);
    if (e != hipSuccess) fprintf(stderr, "cooperative launch failed: %s (grid %d)\n", hipGetErrorString(e), grid);
}
```

```cpp
#include <hip/hip_runtime.h>
#include <hip/hip_cooperative_groups.h>
#include <cstdio>
#include <cstdint>
namespace cg = cooperative_groups;

#define DI __device__ __forceinline__
#define LAS __attribute__((address_space(3)))
#define GAS __attribute__((address_space(1)))
typedef unsigned short bf16;
typedef unsigned v4u __attribute__((ext_vector_type(4)));
typedef unsigned v2u __attribute__((ext_vector_type(2)));
typedef float f32x4 __attribute__((ext_vector_type(4)));
typedef float f32x16 __attribute__((ext_vector_type(16)));
typedef short bf16x8 __attribute__((ext_vector_type(8)));

constexpr int NBATCH = 2, SEQ = 16384, TT = NBATCH * SEQ, DM = 1024;
constexpr float EPS = 1e-6f;
constexpr int NWAVES = 8, NTHR = 512;
constexpr size_t MiB = 1u << 20;
constexpr size_t WS_W0I = 0, WS_W0O = 8 * MiB, WS_W1I = 10 * MiB, WS_W1O = 18 * MiB, WS_W2I = 20 * MiB, WS_W2O = 28 * MiB, WS_W3I = 30 * MiB, WS_W3O = 35 * MiB;
constexpr size_t WS_LOGF = 38 * MiB;
constexpr size_t WS_CUM = 39 * MiB;
constexpr size_t WS_GL = 40 * MiB;
constexpr size_t WS_HALO = 48 * MiB;
constexpr size_t WS_HY = 64 * MiB;
constexpr size_t WS_PROJ = 128 * MiB;
constexpr size_t WS_EX = 384 * MiB;
constexpr size_t WS_END = 512 * MiB;
constexpr int LDS_BYTES = 155648;

DI unsigned f2bf(float f) { unsigned u = __builtin_bit_cast(unsigned, f); return (u + 0x7fffu + ((u >> 16) & 1u)) >> 16; }
typedef float f32x2_t __attribute__((ext_vector_type(2)));
typedef __bf16 bf16x2_t __attribute__((ext_vector_type(2)));
DI unsigned pk2(float lo, float hi) { f32x2_t v = {lo, hi}; bf16x2_t b = __builtin_convertvector(v, bf16x2_t); return __builtin_bit_cast(unsigned, b); }
DI float bflo(unsigned u) { return __builtin_bit_cast(float, u << 16); }
DI float bfhi(unsigned u) { return __builtin_bit_cast(float, u & 0xffff0000u); }
DI float bf2f(bf16 b) { return __builtin_bit_cast(float, (unsigned)b << 16); }
DI float wave_sum(float v) {
#pragma unroll
    for (int o = 1; o < 64; o <<= 1) v += __shfl_xor(v, o);
    return v;
}
DI float silu_f(float x) { return x / (1.f + __expf(-x)); }
DI float softplus_f(float x) { return fmaxf(x, 0.f) + log1pf(__expf(-fabsf(x))); }
namespace pg8 {
#define PG8_LAS __attribute__((address_space(3)))
typedef unsigned short bf16_t;
typedef short bf16x8 __attribute__((ext_vector_type(8)));
typedef float f32x4 __attribute__((ext_vector_type(4)));
typedef unsigned u32x4 __attribute__((ext_vector_type(4)));
constexpr int BM = 256, BK = 64, HALF = 128, HTB = HALF * BK * 2  , STAGE_BYTES = 8 * HTB, NXCD = 8, WGM = 8;

__host__ __device__ __forceinline__ int lds_byte(int r, int c) { const int st = (r >> 4) * 2 + (c >> 5), rr = r & 15, cc = c & 31, ob = rr * 64 + cc * 2; return st * 1024 + (ob ^ (((ob >> 9) & 1) << 5)); }
__host__ __device__ __forceinline__ void stage_rc(int b, int& R, int& C) { const int st = b / 1024, sb = b % 1024, swz = sb ^ (((sb >> 9) & 1) << 5); R = (st >> 1) * 16 + swz / 64; C = (st & 1) * 32 + (swz % 64) / 2; }
__host__ __device__ __forceinline__ int perm32(int rho) { const int n = rho >> 4, i = rho & 15; return 8 * (i >> 2) + 4 * n + (i & 3); }

struct Unit { int pm, pn; };
struct Gemm { const bf16_t* A; const bf16_t* Bt; int M, N, K; };

struct StaticOrder {
    int nM, nN, nwg, G, c;
    __host__ __device__ void init(int M, int N, int G_, int c_) { nM = M / BM; nN = N / BM; nwg = nM * nN; G = G_; c = c_; }
    __host__ __device__ bool next(int i, Unit& u) const {
        const long L = (long)i * G + c; if (L >= nwg) return false;
        int wgid = (int)L; { const int q = nwg / NXCD, r = nwg % NXCD, xcd = wgid % NXCD, off = wgid / NXCD; wgid = (xcd < r ? xcd * (q + 1) : r * (q + 1) + (xcd - r) * q) + off; }
        const int nig = WGM * nN, gid = wgid / nig, fm = gid * WGM, gsz = (nM - fm) < WGM ? (nM - fm) : WGM;
        u.pm = fm + ((wgid % nig) % gsz); u.pn = (wgid % nig) / gsz; return true;
    }
    __device__ __forceinline__ void a_ready(const Unit&) const {}
    __device__ __forceinline__ void done(const Unit&) const {}
};

__device__ __forceinline__ unsigned cvt_pk_bf16(float lo, float hi) { unsigned r; asm volatile("v_cvt_pk_bf16_f32 %0, %1, %2" : "=v"(r) : "v"(lo), "v"(hi)); return r; }
struct EpiStore {
    static constexpr bool PERM = true, AFTER_DRAIN = false;
    bf16_t* O; int ldc; bf16_t* HALO;
    __device__ __forceinline__ void operator()(const f32x4 (&acc)[2][2][4][2], const Unit& u, int wr, int wc, int fr, int fq) const {
        const int row0 = u.pm * BM + wr * 64 + fr; const int col0 = u.pn * BM + wc * 32 + 8 * fq;
#pragma unroll
        for (int ai = 0; ai < 2; ++ai)
#pragma unroll
            for (int m = 0; m < 4; ++m) { const int row = row0 + ai * HALF + m * 16; bf16_t* rowp = O + (size_t)row * ldc + col0;
#pragma unroll
                for (int bj = 0; bj < 2; ++bj) { const f32x4 v0 = acc[ai][bj][m][0], v1 = acc[ai][bj][m][1];
                    u32x4 w; w.x = cvt_pk_bf16(v0[0], v0[1]); w.y = cvt_pk_bf16(v0[2], v0[3]); w.z = cvt_pk_bf16(v1[0], v1[1]); w.w = cvt_pk_bf16(v1[2], v1[3]);
                    *(u32x4*)(rowp + bj * HALF) = w;
                    if (HALO != nullptr && m == 3 && fr >= 13 && (col0 + bj * HALF) < 3072)
                        *(u32x4*)(HALO + ((size_t)(row >> 6) * 3 + (fr - 13)) * 3072 + col0 + bj * HALF) = w;
                } }
    }
};
template <bool RB, bool OB, bool PSUM = false>
struct EpiRes {
    static constexpr bool PERM = true, AFTER_DRAIN = false;
    const void* R; void* O; float* PS;
    __device__ __forceinline__ void operator()(const f32x4 (&acc)[2][2][4][2], const Unit& u, int wr, int wc, int fr, int fq) const {
        const int row0 = u.pm * BM + wr * 64 + fr; const int col0 = u.pn * BM + wc * 32 + 8 * fq;
#pragma unroll
        for (int ai = 0; ai < 2; ++ai)
#pragma unroll
            for (int m = 0; m < 4; ++m) { const size_t off = (size_t)(row0 + ai * HALF + m * 16) * 1024 + col0; float ssq = 0.f;
#pragma unroll
                for (int bj = 0; bj < 2; ++bj) {
                    f32x4 r0, r1;
                    if constexpr (RB) { const u32x4 w = *(const u32x4*)((const bf16_t*)R + off + bj * HALF);
                        r0 = (f32x4){__builtin_bit_cast(float, w.x << 16), __builtin_bit_cast(float, w.x & 0xffff0000u), __builtin_bit_cast(float, w.y << 16), __builtin_bit_cast(float, w.y & 0xffff0000u)};
                        r1 = (f32x4){__builtin_bit_cast(float, w.z << 16), __builtin_bit_cast(float, w.z & 0xffff0000u), __builtin_bit_cast(float, w.w << 16), __builtin_bit_cast(float, w.w & 0xffff0000u)}; }
                    else { r0 = *(const f32x4*)((const float*)R + off + bj * HALF); r1 = *(const f32x4*)((const float*)R + off + bj * HALF + 4); }
                    const f32x4 v0 = r0 + acc[ai][bj][m][0], v1 = r1 + acc[ai][bj][m][1];
                    if constexpr (OB) { u32x4 w; w.x = cvt_pk_bf16(v0[0], v0[1]); w.y = cvt_pk_bf16(v0[2], v0[3]); w.z = cvt_pk_bf16(v1[0], v1[1]); w.w = cvt_pk_bf16(v1[2], v1[3]);
                        *(u32x4*)((bf16_t*)O + off + bj * HALF) = w;
                        if constexpr (PSUM) {
#pragma unroll
                            for (int i = 0; i < 4; ++i) { const unsigned ww = (i == 0) ? w.x : (i == 1 ? w.y : (i == 2 ? w.z : w.w));
                                const float lo = __builtin_bit_cast(float, ww << 16), hi = __builtin_bit_cast(float, ww & 0xffff0000u); ssq += lo * lo + hi * hi; } } }
                    else { *(f32x4*)((float*)O + off + bj * HALF) = v0; *(f32x4*)((float*)O + off + bj * HALF + 4) = v1; }
                }
                if constexpr (PSUM) { ssq += __shfl_xor(ssq, 16); ssq += __shfl_xor(ssq, 32);
                    if (fq == 0) PS[(size_t)(row0 + ai * HALF + m * 16) * 16 + u.pn * 4 + wc] = ssq; } }
    }
};
struct EpiConvGate {
    static constexpr bool PERM = true, AFTER_DRAIN = false;
    bf16_t* Y; const float* wconv; float* CVH; float* BND;
    __device__ __forceinline__ void operator()(const f32x4 (&acc)[2][2][4][2], const Unit& u, int wr, int wc, int fr, int fq) const {
        const int ch0 = 64 * u.pn + 16 * wc + 4 * fq;
        const f32x4 w0 = *(const f32x4*)(wconv + ch0), w1 = *(const f32x4*)(wconv + 1024 + ch0), w2 = *(const f32x4*)(wconv + 2048 + ch0);
#pragma unroll
        for (int ai = 0; ai < 2; ++ai) {
            f32x4 p15 = (f32x4){0.f, 0.f, 0.f, 0.f}, p14 = (f32x4){0.f, 0.f, 0.f, 0.f};
#pragma unroll
            for (int m = 0; m < 4; ++m) {
                const int row = u.pm * BM + ai * HALF + wr * 64 + m * 16 + fr;
                const f32x4 b = acc[ai][0][m][0], c = acc[ai][0][m][1], v = acc[ai][1][m][0], z = acc[ai][1][m][1];
                const f32x4 cv = c * v;
                f32x4 y, n15, n14;
#pragma unroll
                for (int e = 0; e < 4; ++e) {
                    const float up1 = __shfl_up(cv[e], 1, 16), up2 = __shfl_up(cv[e], 2, 16);
                    const float cm1 = (fr >= 1) ? up1 : p15[e];
                    const float cm2 = (fr >= 2) ? up2 : ((fr == 1) ? p15[e] : p14[e]);
                    const float zz = z[e];
                    y[e] = b[e] * (w0[e] * cm2 + w1[e] * cm1 + w2[e] * cv[e]) * (zz / (1.f + __expf(-zz)));
                    n15[e] = __shfl(cv[e], 15, 16); n14[e] = __shfl(cv[e], 14, 16);
                }
                p15 = n15; p14 = n14;
                if (m > 0 || fr >= 2) {
                    unsigned long long o = (unsigned long long)cvt_pk_bf16(y[0], y[1]) | ((unsigned long long)cvt_pk_bf16(y[2], y[3]) << 32);
                    *(unsigned long long*)(Y + (size_t)row * 1024 + ch0) = o;
                } else {
                    float* bp = BND + ((size_t)(row >> 6) * 2 + fr) * 3 * 1024 + ch0;
                    *(f32x4*)bp = b; *(f32x4*)(bp + 1024) = z; *(f32x4*)(bp + 2048) = cv;
                }
                if (m == 3 && fr >= 14) *(f32x4*)(CVH + ((size_t)(row >> 6) * 2 + (fr - 14)) * 1024 + ch0) = cv;
            }
        }
    }
};
struct EpiStoreScaled {
    static constexpr bool PERM = true, AFTER_DRAIN = false;
    bf16_t* O; int ldc; const float* PS;
    __device__ __forceinline__ void operator()(const f32x4 (&acc)[2][2][4][2], const Unit& u, int wr, int wc, int fr, int fq) const {
        const int row0 = u.pm * BM + wr * 64 + fr; const int col0 = u.pn * BM + wc * 32 + 8 * fq;
#pragma unroll
        for (int ai = 0; ai < 2; ++ai)
#pragma unroll
            for (int m = 0; m < 4; ++m) { const int row = row0 + ai * HALF + m * 16; bf16_t* rowp = O + (size_t)row * ldc + col0;
                const f32x4* pp = (const f32x4*)(PS + (size_t)row * 16);
                const f32x4 s4 = (pp[0] + pp[1]) + (pp[2] + pp[3]);
                const float r = rsqrtf(((s4[0] + s4[1]) + (s4[2] + s4[3])) * (1.f / 1024.f) + 1e-6f);
#pragma unroll
                for (int bj = 0; bj < 2; ++bj) { const f32x4 v0 = acc[ai][bj][m][0] * r, v1 = acc[ai][bj][m][1] * r;
                    u32x4 w; w.x = cvt_pk_bf16(v0[0], v0[1]); w.y = cvt_pk_bf16(v0[2], v0[3]); w.z = cvt_pk_bf16(v1[0], v1[1]); w.w = cvt_pk_bf16(v1[2], v1[3]);
                    *(u32x4*)(rowp + bj * HALF) = w; } }
    }
};
template <class Epi, class Sched, bool ALIGN_EPI = false, bool SP2 = false>
__device__ __forceinline__ void gemm_phase(PG8_LAS unsigned char* lds, const Gemm g, const Sched& S, const Epi& E) {
    int tid_l = threadIdx.x; asm volatile("" : "+v"(tid_l));
    const int tid = tid_l, wid = __builtin_amdgcn_readfirstlane(tid >> 6), lane = tid & 63, wr = wid >> 2, wc = wid & 3, fr = lane & 15, fq = lane >> 4;
    const int K = g.K, nt = K / BK;
    unsigned voffA[2], voffB[2];
#pragma unroll
    for (int i = 0; i < 2; ++i) { int R, C; stage_rc(tid * 16 + i * 8192, R, C); const int Rb = Epi::PERM ? ((R & ~31) + perm32(R & 31)) : R;
        voffA[i] = (unsigned)(R * K + C) * 2u; voffB[i] = (unsigned)(Rb * K + C) * 2u; }
    const size_t kstep = (size_t)(BK * 2);
    const size_t hstep = (size_t)HALF * K * 2;
    const size_t tstep = 2 * hstep;
    const unsigned ldsw = (unsigned)wid * 1024u;
    const int aoff = lds_byte(wr * 64 + fr, fq * 8), boff = lds_byte(wc * 32 + fr, fq * 8);
#define PG8_SA(b, h) (((b) * 2 + (h)) * HTB)
#define PG8_SB(b, h) ((4 + (b) * 2 + (h)) * HTB)
#define PG8_STAGE(bufoff, gbase, voff) do { _Pragma("unroll") for (int _i = 0; _i < 2; ++_i) \
        __builtin_amdgcn_global_load_lds((const unsigned*)((const char*)(gbase) + (voff)[_i]), (PG8_LAS unsigned*)(lds + (bufoff) + ldsw + _i * 8192), 16, 0, 0); } while (0)
#define PG8_LDA(dst, b, h) do { _Pragma("unroll") for (int m = 0; m < 4; ++m) _Pragma("unroll") for (int k = 0; k < 2; ++k) dst[m][k] = *(const PG8_LAS bf16x8*)(lds + PG8_SA(b, h) + aoff + m * 2048 + k * 1024); } while (0)
#define PG8_LDB(dst, b, h) do { _Pragma("unroll") for (int n = 0; n < 2; ++n) _Pragma("unroll") for (int k = 0; k < 2; ++k) dst[n][k] = *(const PG8_LAS bf16x8*)(lds + PG8_SB(b, h) + boff + n * 2048 + k * 1024); } while (0)
#define PG8_MMA(ai, bj, At, Bt) do { __builtin_amdgcn_s_setprio(1); _Pragma("unroll") for (int m = 0; m < 4; ++m) _Pragma("unroll") for (int n = 0; n < 2; ++n) _Pragma("unroll") for (int k = 0; k < 2; ++k) \
        acc[ai][bj][m][n] = __builtin_amdgcn_mfma_f32_16x16x32_bf16(Bt[n][k], At[m][k], acc[ai][bj][m][n], 0, 0, 0); __builtin_amdgcn_s_setprio(0); } while (0)
#define PG8_WAIT_V(n) asm volatile("s_waitcnt vmcnt(" #n ")" ::: "memory")
#define PG8_WAIT_L(n) asm volatile("s_waitcnt lgkmcnt(" #n ")" ::: "memory")
#define PG8_BAR __builtin_amdgcn_s_barrier()
#define PG8_SCHED __builtin_amdgcn_sched_barrier(0)
    Unit cur, nxt; int ui = 0;
    if (!S.next(0, cur)) return;
    f32x4 acc[2][2][4][2];
#pragma unroll
    for (int a = 0; a < 2; ++a)
#pragma unroll
        for (int b = 0; b < 2; ++b)
#pragma unroll
            for (int m = 0; m < 4; ++m)
#pragma unroll
                for (int n = 0; n < 2; ++n) acc[a][b][m][n] = (f32x4){0.f, 0.f, 0.f, 0.f};
    bf16x8 At[4][2], B0[2][2], B1[2][2];
    const char* cA = (const char*)g.A + (size_t)cur.pm * tstep; const char* cB = (const char*)g.Bt + (size_t)cur.pn * tstep;
    S.a_ready(cur);
    if constexpr (SP2) {
        PG8_STAGE(PG8_SB(0, 0), cB, voffB); PG8_STAGE(PG8_SB(0, 1), cB + hstep, voffB); PG8_STAGE(PG8_SA(0, 0), cA, voffA); PG8_STAGE(PG8_SA(0, 1), cA + hstep, voffA);
        if (wr == 1) PG8_BAR;
        PG8_WAIT_V(2); PG8_BAR;
        PG8_STAGE(PG8_SB(1, 0), cB + kstep, voffB); PG8_STAGE(PG8_SA(1, 0), cA + kstep, voffA); PG8_STAGE(PG8_SB(1, 1), cB + hstep + kstep, voffB);
        PG8_WAIT_V(6); PG8_BAR;
    } else {
        PG8_STAGE(PG8_SB(0, 0), cB, voffB); PG8_STAGE(PG8_SA(0, 0), cA, voffA); PG8_STAGE(PG8_SB(0, 1), cB + hstep, voffB); PG8_STAGE(PG8_SA(0, 1), cA + hstep, voffA);
        if (wr == 1) PG8_BAR;
        PG8_WAIT_V(4); PG8_BAR;
        PG8_STAGE(PG8_SB(1, 0), cB + kstep, voffB); PG8_STAGE(PG8_SA(1, 0), cA + kstep, voffA); PG8_STAGE(PG8_SB(1, 1), cB + hstep + kstep, voffB);
        PG8_WAIT_V(6); PG8_BAR;
    }
    for (;;) {
        const bool has_next = S.next(ui + 1, nxt);
        const char* nA = has_next ? (const char*)g.A + (size_t)nxt.pm * tstep : cA; const char* nB = has_next ? (const char*)g.Bt + (size_t)nxt.pn * tstep : cB;
        for (int t = 0; t < nt; t += 2) {
            const bool last = (t == nt - 2);
            const char* a1 = cA + (size_t)(t + 1) * kstep;
            const char* a2 = last ? nA : cA + (size_t)(t + 2) * kstep; const char* b2 = last ? nB : cB + (size_t)(t + 2) * kstep;
            const char* a3 = a2 + kstep; const char* b3 = b2 + kstep;
            if (last && has_next) S.a_ready(nxt);
            if constexpr (SP2) {
            PG8_LDB(B0, 0, 0); PG8_LDB(B1, 0, 1); PG8_SCHED; PG8_LDA(At, 0, 0); PG8_STAGE(PG8_SA(1, 1), a1 + hstep, voffA);
            PG8_WAIT_V(8); PG8_WAIT_L(0); PG8_BAR; PG8_MMA(0, 0, At, B0); PG8_MMA(0, 1, At, B1); PG8_BAR; PG8_SCHED;
            PG8_LDA(At, 0, 1); PG8_STAGE(PG8_SB(0, 0), b2, voffB); PG8_STAGE(PG8_SB(0, 1), b2 + hstep, voffB); PG8_STAGE(PG8_SA(0, 0), a2, voffA);
            PG8_WAIT_V(8); PG8_WAIT_L(0); PG8_BAR; PG8_MMA(1, 0, At, B0); PG8_MMA(1, 1, At, B1); PG8_BAR; PG8_SCHED;
            PG8_LDB(B0, 1, 0); PG8_LDB(B1, 1, 1); PG8_SCHED; PG8_LDA(At, 1, 0); PG8_STAGE(PG8_SA(0, 1), a2 + hstep, voffA);
            PG8_WAIT_V(8); PG8_WAIT_L(0); PG8_BAR; PG8_MMA(0, 0, At, B0); PG8_MMA(0, 1, At, B1); PG8_BAR; PG8_SCHED;
            PG8_LDA(At, 1, 1); PG8_STAGE(PG8_SB(1, 0), b3, voffB); PG8_STAGE(PG8_SB(1, 1), b3 + hstep, voffB); PG8_STAGE(PG8_SA(1, 0), a3, voffA);
            PG8_WAIT_V(8); PG8_WAIT_L(0); PG8_BAR; PG8_MMA(1, 0, At, B0); PG8_MMA(1, 1, At, B1); PG8_BAR; PG8_SCHED;
            } else {
            PG8_LDB(B0, 0, 0); PG8_SCHED; PG8_LDA(At, 0, 0); PG8_STAGE(PG8_SA(1, 1), a1 + hstep, voffA);
            PG8_WAIT_L(8); PG8_BAR; PG8_WAIT_L(0); PG8_MMA(0, 0, At, B0); PG8_BAR; PG8_SCHED;
            PG8_LDB(B1, 0, 1); PG8_STAGE(PG8_SB(0, 0), b2, voffB);
            PG8_BAR; PG8_WAIT_L(0); PG8_MMA(0, 1, At, B1); PG8_BAR;
            PG8_LDA(At, 0, 1); PG8_STAGE(PG8_SA(0, 0), a2, voffA);
            PG8_BAR; PG8_WAIT_L(0); PG8_MMA(1, 0, At, B0); PG8_BAR; PG8_SCHED;
            PG8_STAGE(PG8_SB(0, 1), b2 + hstep, voffB);
            PG8_WAIT_V(6); PG8_BAR; PG8_MMA(1, 1, At, B1); PG8_BAR;
            PG8_LDB(B0, 1, 0); PG8_SCHED; PG8_LDA(At, 1, 0); PG8_STAGE(PG8_SA(0, 1), a2 + hstep, voffA);
            PG8_WAIT_L(8); PG8_BAR; PG8_WAIT_L(0); PG8_MMA(0, 0, At, B0); PG8_BAR; PG8_SCHED;
            PG8_LDB(B1, 1, 1); PG8_STAGE(PG8_SB(1, 0), b3, voffB);
            PG8_BAR; PG8_WAIT_L(0); PG8_MMA(0, 1, At, B1); PG8_BAR;
            PG8_LDA(At, 1, 1); PG8_STAGE(PG8_SA(1, 0), a3, voffA);
            PG8_BAR; PG8_WAIT_L(0); PG8_MMA(1, 0, At, B0); PG8_BAR; PG8_SCHED;
            PG8_STAGE(PG8_SB(1, 1), b3 + hstep, voffB);
            PG8_WAIT_V(6); PG8_BAR; PG8_MMA(1, 1, At, B1); PG8_BAR;
            }
        }
        if constexpr (ALIGN_EPI) { if (wr == 0) PG8_BAR; }
        if constexpr (!Epi::AFTER_DRAIN) { E(acc, cur, wr, wc, fr, fq); S.done(cur); }
        if (!has_next) break;
#pragma unroll
        for (int a = 0; a < 2; ++a)
#pragma unroll
            for (int b = 0; b < 2; ++b)
#pragma unroll
                for (int m = 0; m < 4; ++m)
#pragma unroll
                    for (int n = 0; n < 2; ++n) acc[a][b][m][n] = (f32x4){0.f, 0.f, 0.f, 0.f};
        cur = nxt; cA = nA; cB = nB; ++ui;
        if constexpr (ALIGN_EPI) { if (wr == 1) PG8_BAR; }
    }
    PG8_WAIT_V(0);
    if constexpr (!ALIGN_EPI) { if (wr == 0) PG8_BAR; }
    PG8_BAR;
    if constexpr (Epi::AFTER_DRAIN) { E.fused(acc, cur, wr, wc, fr, fq, lds, wid, lane); S.done(cur); }
#undef PG8_SA
#undef PG8_SB
#undef PG8_STAGE
#undef PG8_LDA
#undef PG8_LDB
#undef PG8_MMA
#undef PG8_WAIT_V
#undef PG8_WAIT_L
#undef PG8_BAR
#undef PG8_SCHED
}
}
#define XB_TMO      128
#define XB_XCNT(j)  (256  + 64 * (j))
#define XB_XSUB(j)  (1280 + 64 * (j))
#define XB_XGEN(j)  (2304 + 64 * (j))
#define XB_TOP      3328
#define XB_TOPGEN   3392
#define XCD_BAR_WORDS 3456
#define XB_SPIN_CAP (1u << 18)

__device__ __forceinline__ unsigned xb_ld(unsigned* p)              { return __hip_atomic_load(p, __ATOMIC_RELAXED, __HIP_MEMORY_SCOPE_AGENT); }
__device__ __forceinline__ unsigned xb_add(unsigned* p, unsigned v) { return __hip_atomic_fetch_add(p, v, __ATOMIC_RELAXED, __HIP_MEMORY_SCOPE_AGENT); }
__device__ __forceinline__ unsigned xb_xcc_id() { return (unsigned)__builtin_amdgcn_s_getreg((3 << 11) | 20) & 0xFu; }
#define XB_SPIN(cond, bar) do { unsigned _sp = 0; while (cond) { __builtin_amdgcn_s_sleep(1); \
    if ((++_sp & 255u) == 0u) { if (xb_ld(&(bar)[XB_TMO])) break; if (_sp > XB_SPIN_CAP) { atomicAdd(&(bar)[XB_TMO], 1u); break; } } } } while (0)

struct XcdBarrier {
    unsigned* bar; unsigned x;
    volatile LAS unsigned* st;
};

__device__ __forceinline__ XcdBarrier xcd_barrier_post(unsigned* bar, volatile LAS unsigned* st) {
    XcdBarrier b; b.bar = bar; b.x = xb_xcc_id(); b.st = st;
    if (threadIdx.x == 0) (void)xb_add(&bar[XB_XCNT(b.x)], 1u);
    return b;
}
__device__ __forceinline__ void xcd_barrier_complete(unsigned* bar, unsigned x, unsigned& nloc, unsigned& nx) {
    const unsigned G = gridDim.x * gridDim.y * gridDim.z;
    unsigned sum, cnt, mine, sp = 0u;
    for (;;) {
        sum = 0u; cnt = 0u; mine = 0u;
#pragma unroll
        for (unsigned j = 0; j < 16; ++j) { const unsigned c = xb_ld(&bar[XB_XCNT(j)]); sum += c; cnt += (c > 0u) ? 1u : 0u; mine = (j == x) ? c : mine; }
        if (sum == G) break;
        __builtin_amdgcn_s_sleep(1);
        if ((++sp & 255u) == 0u) { if (xb_ld(&bar[XB_TMO])) break; if (sp > XB_SPIN_CAP) { atomicAdd(&bar[XB_TMO], 1u); break; } }
    }
    nloc = mine > 0u ? mine : 1u; nx = cnt > 0u ? cnt : 1u;
}

__device__ __forceinline__ void xcd_barrier(const XcdBarrier& b) {
    asm volatile("s_waitcnt vmcnt(0)" ::: "memory");
    __syncthreads();
    if (threadIdx.x == 0) {
        unsigned* bar = b.bar;
        __builtin_amdgcn_s_waitcnt(0);
        unsigned nloc = b.st[0], nx = b.st[1];
        if (nloc == 0u) { xcd_barrier_complete(bar, b.x, nloc, nx); b.st[0] = nloc; b.st[1] = nx; }
        const unsigned old = xb_add(&bar[XB_XSUB(b.x)], 1u);
        const unsigned gen = old / nloc;
        if (old + 1u == (gen + 1u) * nloc) {
            __builtin_amdgcn_fence(__ATOMIC_RELEASE, "agent");
            asm volatile("s_waitcnt vmcnt(0)" ::: "memory");
            const unsigned og = xb_add(&bar[XB_TOP], 1u);
            const unsigned tg = og / nx;
            if (og + 1u == (tg + 1u) * nx) xb_add(&bar[XB_TOPGEN], 1u);
            else XB_SPIN(xb_ld(&bar[XB_TOPGEN]) == tg, bar);
            __builtin_amdgcn_fence(__ATOMIC_ACQUIRE, "agent");
            xb_add(&bar[XB_XGEN(b.x)], 1u);
            asm volatile("s_waitcnt vmcnt(0)" ::: "memory");
        } else {
            XB_SPIN(xb_ld(&bar[XB_XGEN(b.x)]) == gen, bar);
            __builtin_amdgcn_fence(__ATOMIC_ACQUIRE, "agent");
            asm volatile("s_waitcnt vmcnt(0)" ::: "memory");
        }
    }
    __syncthreads();
}

template <bool CONVPERM = false>
DI void p0_transpose_item(const float* W, int K, int ldw, int ncols, bf16* WT, LAS float* scr, int item, int lane, const float* rowscale = nullptr) {
    const int nblk = ncols / 32, kb = item / nblk, nb = item % nblk, k0 = 64 * kb, n0 = 32 * nb;
#pragma unroll 8
    for (int i = 0; i < 32; ++i) { const int kk = 2 * i + (lane >> 5); float wv = W[(size_t)(k0 + kk) * ldw + n0 + (lane & 31)]; if (rowscale != nullptr) wv *= rowscale[k0 + kk];
        scr[kk * 33 + (lane & 31)] = wv; }
    asm volatile("s_waitcnt lgkmcnt(0)" ::: "memory");
    const int c = lane & 7;
#pragma unroll
    for (int j = 0; j < 4; ++j) { const int n = (lane >> 3) + 8 * j; const LAS float* s = scr + (8 * c) * 33 + n;
        v4u o; o.x = pk2(s[0 * 33], s[1 * 33]); o.y = pk2(s[2 * 33], s[3 * 33]); o.z = pk2(s[4 * 33], s[5 * 33]); o.w = pk2(s[6 * 33], s[7 * 33]);
        int orow = n0 + n;
        if constexpr (CONVPERM) { const int sct = orow >> 10, ch = orow & 1023;
            orow = 256 * (ch >> 6) + 128 * (sct >> 1) + 32 * ((ch >> 4) & 3) + 8 * ((ch >> 2) & 3) + 4 * (sct & 1) + (ch & 3); }
        *(v4u*)(WT + (size_t)orow * K + k0 + 8 * c) = o; }
    asm volatile("s_waitcnt lgkmcnt(0)" ::: "memory");
}

struct Ptrs {
    const float* in[19]; float* out; unsigned char* ws; int ph_lo, ph_hi;
};

DI void p0_prologue(const Ptrs& P, LAS unsigned char* lds, int gw, int NGW, int wave, int lane) {
    LAS float* scr = (LAS float*)(lds + wave * 16384);
    unsigned char* ws = P.ws;
    constexpr int I_IN = 16 * 128, I_OUT = 16 * 32, I_SWA = 16 * 80;
    constexpr int NIT = 3 * I_IN + I_SWA + 4 * I_OUT;
    for (int it = gw; it < NIT; it += NGW) {
        int r = it;
        if (r < I_IN) { p0_transpose_item<true>(P.in[4], 1024, 4096, 4096, (bf16*)(ws + WS_W0I), scr, r, lane); continue; } r -= I_IN;
        if (r < I_IN) { p0_transpose_item(P.in[7], 1024, 4104, 4096, (bf16*)(ws + WS_W1I), scr, r, lane); continue; } r -= I_IN;
        if (r < I_IN) { p0_transpose_item(P.in[10], 1024, 4112, 4096, (bf16*)(ws + WS_W2I), scr, r, lane); continue; } r -= I_IN;
        if (r < I_SWA) { p0_transpose_item(P.in[16], 1024, 2560, 2560, (bf16*)(ws + WS_W3I), scr, r, lane, P.in[2] + 3072); continue; } r -= I_SWA;
        if (r < I_OUT) { p0_transpose_item(P.in[6], 1024, 1024, 1024, (bf16*)(ws + WS_W0O), scr, r, lane); continue; } r -= I_OUT;
        if (r < I_OUT) { p0_transpose_item(P.in[9], 1024, 1024, 1024, (bf16*)(ws + WS_W1O), scr, r, lane); continue; } r -= I_OUT;
        if (r < I_OUT) { p0_transpose_item(P.in[15], 1024, 1024, 1024, (bf16*)(ws + WS_W2O), scr, r, lane); continue; } r -= I_OUT;
        p0_transpose_item(P.in[18], 1024, 1024, 1024, (bf16*)(ws + WS_W3O), scr, r, lane);
    }
}

template <int MODE, bool XBF = false>
DI void norm_phase(const float* X, const float* nw, bf16* H, float* OUTF, const float* W, int ldw, float* oa, float* ob, const float* p0, const float* p1, const float* p2,
                   const int* pos, LAS unsigned char* lds, int gw, int NGW, int tid, int lane) {
    constexpr int NT = (MODE == 1) ? 8 : (MODE == 2 ? 16 : 0);
    LAS f32x4* thin = (LAS f32x4*)lds;
    if constexpr (NT > 0) {
        for (int i = tid; i < 1024 * (NT / 4); i += NTHR) { const int k = i / (NT / 4), c4 = i % (NT / 4);
            const f32x4 v = *(const f32x4*)(W + (size_t)k * ldw + 4096 + 4 * c4);
            const int j = k >> 8, l = (k & 255) >> 2, e = k & 3;
            thin[c4 * 1024 + (j * 4 + e) * 64 + l] = v; }
        __syncthreads();
    }
    constexpr int NR = (NT == 16) ? 2 : 4;
    f32x4 nwv[4];
#pragma unroll
    for (int j = 0; j < 4; ++j) nwv[j] = *((const f32x4*)nw + lane + 64 * j);
    for (int row0 = gw * NR; row0 < TT; row0 += NGW * NR) {
        f32x4 vv[NR][4];
#pragma unroll
        for (int rr = 0; rr < NR; ++rr) {
            if constexpr (XBF) { const v2u* xr = (const v2u*)((const bf16*)X + (size_t)(row0 + rr) * DM) + lane;
#pragma unroll
                for (int j = 0; j < 4; ++j) { const v2u u = xr[64 * j]; vv[rr][j] = (f32x4){bflo(u.x), bfhi(u.x), bflo(u.y), bfhi(u.y)}; } }
            else { const f32x4* xr = (const f32x4*)(X + (size_t)(row0 + rr) * DM) + lane;
#pragma unroll
                for (int j = 0; j < 4; ++j) vv[rr][j] = xr[64 * j]; } }
#pragma unroll
        for (int rr = 0; rr < NR; ++rr) {
        const int row = row0 + rr;
        f32x4 v[4]; float s = 0.f;
#pragma unroll
        for (int j = 0; j < 4; ++j) { v[j] = vv[rr][j]; s += (v[j].x * v[j].x + v[j].y * v[j].y) + (v[j].z * v[j].z + v[j].w * v[j].w); }
        const float r = rsqrtf(wave_sum(s) * (1.f / DM) + EPS);
#pragma unroll
        for (int j = 0; j < 4; ++j) { v[j] = v[j] * r * nwv[j]; vv[rr][j] = v[j]; }
        if constexpr (MODE == 4) {
            f32x4* o = (f32x4*)(OUTF + (size_t)row * DM) + lane;
#pragma unroll
            for (int j = 0; j < 4; ++j) o[64 * j] = v[j];
        } else {
            unsigned long long* o8 = (unsigned long long*)(H + (size_t)row * DM) + lane;
#pragma unroll
            for (int j = 0; j < 4; ++j) o8[64 * j] = (unsigned long long)pk2(v[j].x, v[j].y) | ((unsigned long long)pk2(v[j].z, v[j].w) << 32);
        }
        if constexpr (MODE == 3) {
            if (lane < 32) { const float inv = powf(10000.f, -(float)lane * (1.f / 32.f)); const float ang = (float)pos[row] * inv; float sn, cs; sincosf(ang, &sn, &cs);
                oa[(size_t)row * 64 + lane] = cs; oa[(size_t)row * 64 + 32 + lane] = sn; }
        }
        }
        if constexpr (NT > 0) {
            constexpr int RG = (NT == 16) ? 1 : NR;
#pragma unroll
            for (int r0 = 0; r0 < NR; r0 += RG) {
            f32x4 a[RG][NT / 4];
#pragma unroll
            for (int rr = 0; rr < RG; ++rr)
#pragma unroll
                for (int c = 0; c < NT / 4; ++c) a[rr][c] = (f32x4){0.f, 0.f, 0.f, 0.f};
#pragma unroll
            for (int j = 0; j < 4; ++j)
#pragma unroll
                for (int e = 0; e < 4; ++e) {
#pragma unroll
                    for (int c = 0; c < NT / 4; ++c) { const f32x4 w = thin[c * 1024 + (j * 4 + e) * 64 + lane];
#pragma unroll
                        for (int rr = 0; rr < RG; ++rr) a[rr][c] += w * vv[r0 + rr][j][e]; }
                    __builtin_amdgcn_sched_barrier(0); }
#pragma unroll
            for (int rr = 0; rr < RG; ++rr) {
                const int row = row0 + r0 + rr;
                float t8[NT / 2];
#pragma unroll
                for (int i = 0; i < NT / 2; ++i) { const float x0 = a[rr][(2 * i) >> 2][(2 * i) & 3], x1 = a[rr][(2 * i + 1) >> 2][(2 * i + 1) & 3];
                    const bool bb = lane & 1; const float mine = bb ? x1 : x0, send = bb ? x0 : x1; t8[i] = mine + __shfl_xor(send, 1); }
                float t4[NT / 4];
#pragma unroll
                for (int i = 0; i < NT / 4; ++i) { const bool bb = lane & 2; const float mine = bb ? t8[2 * i + 1] : t8[2 * i], send = bb ? t8[2 * i] : t8[2 * i + 1]; t4[i] = mine + __shfl_xor(send, 2); }
                float t2[NT / 8];
#pragma unroll
                for (int i = 0; i < NT / 8; ++i) { const bool bb = lane & 4; const float mine = bb ? t4[2 * i + 1] : t4[2 * i], send = bb ? t4[2 * i] : t4[2 * i + 1]; t2[i] = mine + __shfl_xor(send, 4); }
                float tc;
                if constexpr (NT == 16) { const bool bb = lane & 8; const float mine = bb ? t2[1] : t2[0], send = bb ? t2[0] : t2[1]; tc = mine + __shfl_xor(send, 8); }
                else { tc = t2[0]; tc += __shfl_xor(tc, 8); }
                tc += __shfl_xor(tc, 16); tc += __shfl_xor(tc, 32);
                if constexpr (MODE == 1) {
                    if (lane < 8) { const float xx = tc + p0[lane]; oa[(size_t)row * 8 + lane] = fminf(xx, 0.f) - log1pf(__expf(-fabsf(xx))); }
                } else {
                    const float ma = __shfl(tc, (lane + 8) & 63);
                    if (lane < 8) { oa[(size_t)row * 8 + lane] = 1.f / (1.f + __expf(-tc));
                        ob[(size_t)row * 8 + lane] = -__expf(p0[lane]) * softplus_f(ma + p1[lane]); }
                }
            }
            }
        }
    }
    if constexpr (NT > 0) __syncthreads();
}

DI void convgate_phase(const bf16* PROJ, const float* wconv, bf16* Y, int gtid, int NG) {
    for (int it = gtid; it < (TT / 32) * 128; it += NG) {
        const int oct = it & 127, chunk = it >> 7, r0 = chunk * 32, c0 = oct * 8;
        float w0[8], w1[8], w2[8];
#pragma unroll
        for (int e = 0; e < 8; ++e) { w0[e] = wconv[c0 + e]; w1[e] = wconv[1024 + c0 + e]; w2[e] = wconv[2048 + c0 + e]; }
        float p2[8], p1[8];
#pragma unroll
        for (int e = 0; e < 8; ++e) { p2[e] = 0.f; p1[e] = 0.f; }
        if ((r0 & (SEQ - 1)) != 0) {
#pragma unroll
            for (int d = 2; d >= 1; --d) { const bf16* rp = PROJ + (size_t)(r0 - d) * 4096 + c0;
                const v4u cc = *(const v4u*)(rp + 1024), vv = *(const v4u*)(rp + 2048);
#pragma unroll
                for (int e = 0; e < 4; ++e) { const float a = bflo(cc[e]) * bflo(vv[e]), b = bfhi(cc[e]) * bfhi(vv[e]);
                    if (d == 2) { p2[2 * e] = a; p2[2 * e + 1] = b; } else { p1[2 * e] = a; p1[2 * e + 1] = b; } } }
        }
#pragma unroll 4
        for (int r = 0; r < 32; ++r) {
            const bf16* rp = PROJ + (size_t)(r0 + r) * 4096 + c0;
            const v4u bb = *(const v4u*)(rp), cc = *(const v4u*)(rp + 1024), vv = *(const v4u*)(rp + 2048), zz = *(const v4u*)(rp + 3072);
            float y[8];
#pragma unroll
            for (int e = 0; e < 4; ++e) {
                const float cv0 = bflo(cc[e]) * bflo(vv[e]), cv1 = bfhi(cc[e]) * bfhi(vv[e]);
                const float o0 = w0[2 * e] * p2[2 * e] + w1[2 * e] * p1[2 * e] + w2[2 * e] * cv0;
                const float o1 = w0[2 * e + 1] * p2[2 * e + 1] + w1[2 * e + 1] * p1[2 * e + 1] + w2[2 * e + 1] * cv1;
                p2[2 * e] = p1[2 * e]; p1[2 * e] = cv0; p2[2 * e + 1] = p1[2 * e + 1]; p1[2 * e + 1] = cv1;
                y[2 * e] = bflo(bb[e]) * o0 * silu_f(bflo(zz[e])); y[2 * e + 1] = bfhi(bb[e]) * o1 * silu_f(bfhi(zz[e]));
            }
            v4u o; o.x = pk2(y[0], y[1]); o.y = pk2(y[2], y[3]); o.z = pk2(y[4], y[5]); o.w = pk2(y[6], y[7]);
            *(v4u*)(Y + (size_t)(r0 + r) * 1024 + c0) = o;
        }
    }
}

DI void convfix_phase(const float* CVH, const float* BND, const float* wconv, bf16* Y, int gtid, int NG) {
    for (int it = gtid; it < 512 * 2 * 256; it += NG) {
        const int c4 = it & 255, r = (it >> 8) & 1, g = it >> 9, ch0 = 4 * c4;
        const float* bp = BND + ((size_t)g * 2 + r) * 3 * 1024 + ch0;
        const f32x4 b = *(const f32x4*)bp, z = *(const f32x4*)(bp + 1024), cv = *(const f32x4*)(bp + 2048);
        f32x4 cm1 = (f32x4){0.f, 0.f, 0.f, 0.f}, cm2 = (f32x4){0.f, 0.f, 0.f, 0.f};
        const bool first = (g & 255) == 0;
        if (r == 0) { if (!first) { cm1 = *(const f32x4*)(CVH + ((size_t)(g - 1) * 2 + 1) * 1024 + ch0); cm2 = *(const f32x4*)(CVH + ((size_t)(g - 1) * 2) * 1024 + ch0); } }
        else { cm1 = *(const f32x4*)(BND + ((size_t)g * 2) * 3 * 1024 + 2048 + ch0); if (!first) cm2 = *(const f32x4*)(CVH + ((size_t)(g - 1) * 2 + 1) * 1024 + ch0); }
        const f32x4 w0 = *(const f32x4*)(wconv + ch0), w1 = *(const f32x4*)(wconv + 1024 + ch0), w2 = *(const f32x4*)(wconv + 2048 + ch0);
        float y[4];
#pragma unroll
        for (int e = 0; e < 4; ++e) y[e] = b[e] * (w0[e] * cm2[e] + w1[e] * cm1[e] + w2[e] * cv[e]) * silu_f(z[e]);
        v2u o; o.x = pk2(y[0], y[1]); o.y = pk2(y[2], y[3]);
        *(v2u*)(Y + ((size_t)g * 64 + r) * 1024 + ch0) = o;
    }
}
DI int crow32(int i, int hi) { return (i & 3) + 8 * (i >> 2) + 4 * hi; }
DI int perm16(int p) { return (p & 3) | ((p & 4) << 1) | ((p & 8) >> 1); }
#define MFMA32(a, b, c) __builtin_amdgcn_mfma_f32_32x32x16_bf16((a), (b), (c), 0, 0, 0)
#define MFMA16(a, b, c) __builtin_amdgcn_mfma_f32_16x16x32_bf16((a), (b), (c), 0, 0, 0)

DI void fox_cumsum(const float* LOGF, float* CUM, int bh, LAS unsigned char* lds, int tid) {
    LAS double* tot = (LAS double*)lds;
    const int b = bh >> 3, h = bh & 7;
    const float* src = LOGF + ((size_t)b * SEQ + 32 * tid) * 8 + h;
    float v[32]; double s = 0.0;
#pragma unroll
    for (int i = 0; i < 32; ++i) { v[i] = src[i * 8]; s += (double)v[i]; }
    double inc = s;
    const int ln = tid & 63, wv = tid >> 6;
#pragma unroll
    for (int o = 1; o < 64; o <<= 1) { const double t = __shfl_up(inc, o); if (ln >= o) inc += t; }
    if (ln == 63) tot[wv] = inc;
    __syncthreads();
    double pre = inc - s;
    for (int i = 0; i < wv; ++i) pre += tot[i];
    float* dst = CUM + (size_t)bh * SEQ + 32 * tid;
#pragma unroll
    for (int i = 0; i < 32; ++i) { pre += (double)v[i]; dst[i] = (float)pre; }
    __syncthreads();
}

DI void fox_norms_phase(const bf16* PROJ, float* NRMT, int gw, int NGW, int lane) {
    for (int it = gw; it < 16 * 256; it += NGW) {
        const int bh = it >> 8, tl = it & 255, b = bh >> 3, h = bh & 7;
        const size_t r0 = (size_t)b * SEQ + 64 * tl;
        float mk = 0.f;
#pragma unroll
        for (int rr = 0; rr < 8; ++rr) {
            const int row = 8 * rr + (lane >> 3), seg = lane & 7; const bf16* qp = PROJ + (r0 + row) * 4096 + h * 128 + 16 * seg;
            const v4u b0 = *(const v4u*)(qp + 1024), b1 = *(const v4u*)(qp + 1032);
            float sk = 0.f;
#pragma unroll
            for (int e = 0; e < 4; ++e) sk += bflo(b0[e]) * bflo(b0[e]) + bfhi(b0[e]) * bfhi(b0[e]) + bflo(b1[e]) * bflo(b1[e]) + bfhi(b1[e]) * bfhi(b1[e]);
#pragma unroll
            for (int o = 1; o < 8; o <<= 1) sk += __shfl_xor(sk, o);
            mk = fmaxf(mk, sk);
        }
#pragma unroll
        for (int o = 8; o < 64; o <<= 1) mk = fmaxf(mk, __shfl_xor(mk, o));
        if (lane == 0) NRMT[(size_t)it * 2 + 1] = mk;
    }
}

constexpr int FX_KB = 64 * 272, FX_VB = 64 * 320;
typedef short v4i16_t __attribute__((ext_vector_type(4)));
DI v4i16_t fx_vtr(const LAS unsigned char* p) { return __builtin_amdgcn_ds_read_tr16_b64_v4i16((LAS v4i16_t*)p); }
DI void fox_attn_phase(const bf16* PROJ, const float* CUM, bf16* Y, const float* NRMT, unsigned* QCTR, LAS unsigned char* lds, int bid, int G, int tid, int wave, int lane) {
    LAS unsigned char* Kb = lds; LAS unsigned char* Vb = lds + 2 * FX_KB; LAS float* Bs = (LAS float*)(lds + 2 * FX_KB + 2 * FX_VB);
    const int r = lane & 31, hi = lane >> 5;
    const float SQD = 11.313708498984761f;
    const float c2 = 0.08838834764831845f * 1.4426950408889634f;
    LAS unsigned* Qs = (LAS unsigned*)(lds + 2 * FX_KB + 2 * FX_VB + 512);
    LAS float* Mq = (LAS float*)(lds + 2 * FX_KB + 2 * FX_VB + 704);
    LAS float* Ms = (LAS float*)(lds + 2 * FX_KB + 2 * FX_VB + 576);
    for (;;) {
        if (tid == 0) Qs[0] = atomicAdd(QCTR, 1u);
        __syncthreads();
        const int e = (int)Qs[0];
        __syncthreads();
        if (e >= 1024) break;
        {
            const int bh = e & 15, qb = 63 - (e >> 4), b = bh >> 3, h = bh & 7;
            const int q0 = qb * 256, ntiles = 4 * (qb + 1);
            const float cref = CUM[(size_t)bh * SEQ + q0];
            const int qmin = q0 + 32 * wave;
            bf16x8 Qf[8];
            { const bf16* qp = PROJ + ((size_t)b * SEQ + qmin + r) * 4096 + h * 128 + 8 * hi;
#pragma unroll
              for (int ks = 0; ks < 8; ++ks) Qf[ks] = *(const bf16x8*)(qp + 16 * ks); }
            { float qn = 0.f;
#pragma unroll
              for (int ks = 0; ks < 8; ++ks) { const v4u w = __builtin_bit_cast(v4u, Qf[ks]);
#pragma unroll
                  for (int e = 0; e < 4; ++e) qn += bflo(w[e]) * bflo(w[e]) + bfhi(w[e]) * bfhi(w[e]); }
              qn += __shfl_xor(qn, 32);
#pragma unroll
              for (int o = 1; o < 32; o <<= 1) qn = fmaxf(qn, __shfl_xor(qn, o));
              if (lane == 0) Mq[wave] = qn; }
            __syncthreads();
            int jstart; float Bq;
            { float mq = Mq[0], mk = 0.f;
#pragma unroll
              for (int w = 1; w < 8; ++w) mq = fmaxf(mq, Mq[w]);
#pragma unroll
              for (int u = 0; u < 4; ++u) mk = fmaxf(mk, NRMT[((size_t)bh * 256 + lane + 64 * u) * 2 + 1]);
#pragma unroll
              for (int o = 1; o < 64; o <<= 1) mk = fmaxf(mk, __shfl_xor(mk, o));
              Bq = sqrtf(mq * mk);
              const float B2 = 2.f * Bq * 0.08838834764831845f;
              const float thr = -(30.f + B2);
              const int jc = (lane * (4 * qb)) >> 6;
              const bool live = (qb == 0) ? true : ((cref - CUM[(size_t)bh * SEQ + 64 * jc + 63]) > thr);
              const unsigned long long m = __ballot(live);
              const int fl = (m == 0ull) ? 64 : (__ffsll((long long)m) - 1);
              const int pl = fl > 0 ? fl - 1 : 0;
              jstart = (qb == 0) ? 0 : ((pl * (4 * qb)) >> 6);
              jstart = __builtin_amdgcn_readfirstlane(jstart); }
            f32x16 O[4];
#pragma unroll
            for (int dt = 0; dt < 4; ++dt)
#pragma unroll
                for (int i = 0; i < 16; ++i) O[dt][i] = 0.f;
            float m_old = -INFINITY, lsum = 0.f;
            const bf16* kg[2]; const bf16* vg[2]; int klds[2], vlds[2];
#pragma unroll
            for (int u = 0; u < 2; ++u) { const int p = tid + 512 * u;
                kg[u] = PROJ + ((size_t)b * SEQ + (p >> 4)) * 4096 + 1024 + h * 128 + 8 * (p & 15); klds[u] = (p >> 4) * 272 + (p & 15) * 16;
                vg[u] = PROJ + ((size_t)b * SEQ + (p >> 4)) * 4096 + 2048 + h * 128 + 8 * (p & 15); vlds[u] = (p >> 4) * 320 + (p & 15) * 16; }
            v4u kr[2], vr[2]; float br = 0.f;
            const int jlast = ntiles - 1;
#pragma unroll
            for (int u = 0; u < 2; ++u) { kr[u] = *(const v4u*)(kg[u] + (size_t)jlast * 64 * 4096); vr[u] = *(const v4u*)(vg[u] + (size_t)jlast * 64 * 4096); }
            if (tid < 64) br = (cref - CUM[(size_t)bh * SEQ + jlast * 64 + tid]) * SQD;
#pragma unroll
            for (int u = 0; u < 2; ++u) { *(LAS v4u*)(Kb + (jlast & 1) * FX_KB + klds[u]) = kr[u]; *(LAS v4u*)(Vb + (jlast & 1) * FX_VB + vlds[u]) = vr[u]; }
            if (tid < 64) Bs[(jlast & 1) * 64 + tid] = br;
            __syncthreads();
            for (int j = jlast; j >= jstart; --j) {
                const int cur = j & 1, nxt = cur ^ 1;
                if (j > jstart) {
#pragma unroll
                    for (int u = 0; u < 2; ++u) { kr[u] = *(const v4u*)(kg[u] + (size_t)(j - 1) * 64 * 4096); vr[u] = *(const v4u*)(vg[u] + (size_t)(j - 1) * 64 * 4096); }
                    if (tid < 64) br = (cref - CUM[(size_t)bh * SEQ + (j - 1) * 64 + tid]) * SQD;
                }
                if (64 * j <= qmin + 31) {
                    LAS unsigned char* Kc = Kb + cur * FX_KB; LAS unsigned char* Vc = Vb + cur * FX_VB; LAS float* Bc = Bs + cur * 64;
                    f32x16 S[2];
#pragma unroll
                    for (int sub = 0; sub < 2; ++sub) {
#pragma unroll
                        for (int g = 0; g < 4; ++g) { const f32x4 bv = *(const LAS f32x4*)(Bc + 32 * sub + 8 * g + 4 * hi);
                            S[sub][4 * g] = bv.x; S[sub][4 * g + 1] = bv.y; S[sub][4 * g + 2] = bv.z; S[sub][4 * g + 3] = bv.w; }
#pragma unroll
                        for (int ks = 0; ks < 8; ++ks) { const bf16x8 a = *(const LAS bf16x8*)(Kc + (32 * sub + r) * 272 + (16 * ks + 8 * hi) * 2);
                            S[sub] = MFMA32(a, Qf[ks], S[sub]); }
                    }
                    if (64 * j + 63 > qmin) {
                        const int qi = qmin + r;
#pragma unroll
                        for (int sub = 0; sub < 2; ++sub)
#pragma unroll
                            for (int i = 0; i < 16; ++i) { const int key = 64 * j + 32 * sub + crow32(i, hi); if (key > qi) S[sub][i] = -INFINITY; }
                    }
                    float mx = S[0][0];
#pragma unroll
                    for (int i = 1; i < 16; ++i) mx = fmaxf(mx, S[0][i]);
#pragma unroll
                    for (int i = 0; i < 16; ++i) mx = fmaxf(mx, S[1][i]);
                    mx = fmaxf(mx, __shfl_xor(mx, 32));
                    const float m_new = fmaxf(m_old, mx);
                    const float alpha = __builtin_amdgcn_exp2f((m_old - m_new) * c2);
                    const float nm = -m_new * c2;
                    m_old = m_new;
                    float ps = 0.f;
#pragma unroll
                    for (int sub = 0; sub < 2; ++sub)
#pragma unroll
                        for (int i = 0; i < 16; ++i) { const float p = __builtin_amdgcn_exp2f(fmaf(S[sub][i], c2, nm)); S[sub][i] = p; ps += p; }
                    lsum = lsum * alpha + ps;
                    if (!__all(alpha == 1.f)) {
#pragma unroll
                        for (int dt = 0; dt < 4; ++dt)
#pragma unroll
                            for (int i = 0; i < 16; ++i) O[dt][i] *= alpha;
                    }
                    __builtin_amdgcn_sched_barrier(0);
                    bf16x8 Pf[4];
#pragma unroll
                    for (int kk = 0; kk < 4; ++kk) { const int sub = kk >> 1, s = kk & 1; v4u w;
                        w.x = pk2(S[sub][8 * s], S[sub][8 * s + 1]); w.y = pk2(S[sub][8 * s + 2], S[sub][8 * s + 3]);
                        w.z = pk2(S[sub][8 * s + 4], S[sub][8 * s + 5]); w.w = pk2(S[sub][8 * s + 6], S[sub][8 * s + 7]);
                        Pf[kk] = __builtin_bit_cast(bf16x8, w); }
#pragma unroll
                    for (int dt = 0; dt < 4; ++dt) { __builtin_amdgcn_sched_barrier(0);
#pragma unroll
                        for (int kk = 0; kk < 4; ++kk) {
                            const LAS unsigned char* vp = Vc + (16 * kk + 4 * hi + ((lane & 15) >> 2)) * 320 + 64 * dt + 32 * ((lane >> 4) & 1) + 8 * (lane & 3);
                            const v4i16_t lo = fx_vtr(vp), hi4 = fx_vtr(vp + 8 * 320);
                            const bf16x8 a = __builtin_shufflevector(lo, hi4, 0, 1, 2, 3, 4, 5, 6, 7);
                            O[dt] = MFMA32(a, Pf[kk], O[dt]); } }
                }
                { float mm = m_old;
#pragma unroll
                  for (int o = 1; o < 32; o <<= 1) mm = fminf(mm, __shfl_xor(mm, o));
                  if (lane == 0) Ms[cur * 8 + wave] = mm; }
                if (j > jstart) {
#pragma unroll
                    for (int u = 0; u < 2; ++u) { *(LAS v4u*)(Kb + nxt * FX_KB + klds[u]) = kr[u]; *(LAS v4u*)(Vb + nxt * FX_VB + vlds[u]) = vr[u]; }
                    if (tid < 64) Bs[nxt * 64 + tid] = br;
                }
                __syncthreads();
                if (j > jstart) { float mn = Ms[cur * 8];
#pragma unroll
                    for (int w = 1; w < 8; ++w) mn = fminf(mn, Ms[cur * 8 + w]);
                    if ((Bq + Bs[nxt * 64 + 63] - mn) * 0.08838834764831845f <= -30.f) break; }
            }
            const float lt = lsum + __shfl_xor(lsum, 32);
            const float inv = 1.f / lt;
            const size_t trow = (size_t)b * SEQ + qmin + r;
#pragma unroll
            for (int dt = 0; dt < 4; ++dt)
#pragma unroll
                for (int g = 0; g < 4; ++g) { const int d = 32 * dt + 8 * g + 4 * hi;
                    const v2u z = *(const v2u*)(PROJ + trow * 4096 + 3072 + h * 128 + d);
                    const float y0 = O[dt][4 * g] * inv * silu_f(bflo(z.x)), y1 = O[dt][4 * g + 1] * inv * silu_f(bfhi(z.x));
                    const float y2 = O[dt][4 * g + 2] * inv * silu_f(bflo(z.y)), y3 = O[dt][4 * g + 3] * inv * silu_f(bfhi(z.y));
                    v2u o; o.x = pk2(y0, y1); o.y = pk2(y2, y3);
                    *(v2u*)(Y + trow * 1024 + h * 128 + d) = o; }
        }
    }
}
DI int kperm(int s, int q, int jj) { return 32 * s + 16 * (jj >> 2) + 4 * q + (jj & 3); }
DI bf16x8 pack_acc2(const f32x4& X, const f32x4& Y) { v4u w; w.x = pk2(X[0], X[1]); w.y = pk2(X[2], X[3]); w.z = pk2(Y[0], Y[1]); w.w = pk2(Y[2], Y[3]); return __builtin_bit_cast(bf16x8, w); }

DI void st16_wt(void* p, v4u v) {
    __hip_atomic_store((unsigned long long*)p, (unsigned long long)v.x | ((unsigned long long)v.y << 32), __ATOMIC_RELAXED, __HIP_MEMORY_SCOPE_AGENT);
    __hip_atomic_store((unsigned long long*)p + 1, (unsigned long long)v.z | ((unsigned long long)v.w << 32), __ATOMIC_RELAXED, __HIP_MEMORY_SCOPE_AGENT);
}
template <bool DRY>
DI void gdn_prep_phase(bf16* PROJ, bf16* DRYBUF, const bf16* HALO, const float* wconv, const float* BETA, const float* GG, unsigned char* EX, float* GL, unsigned* FLAG,
                       LAS unsigned char* lds, int bid, int G, int FIRST, int tid, int wave, int lane) {
    LAS bf16* QB = (LAS bf16*)lds; LAS bf16* KB = (LAS bf16*)(lds + 17408); LAS bf16* VBt = (LAS bf16*)(lds + 34816);
    LAS float* Lm = (LAS float*)(lds + 52224); LAS float* Tm = (LAS float*)(lds + 68864); LAS float* QKm = (LAS float*)(lds + 85504);
    LAS float* gcS = (LAS float*)(lds + 102144); LAS float* btS = (LAS float*)(lds + 102400); LAS float* Mt = (LAS float*)(lds + 102656);
    LAS float* Wc = (LAS float*)(lds + 119296);
    int hcur = -1;
    for (int e0 = bid - FIRST; e0 < 4096; e0 += G - FIRST) {
        const int bh = e0 & 15, n = e0 >> 4, it = bh * 256 + n, b = bh >> 3, h = bh & 7;
        const size_t t0 = (size_t)b * SEQ + 64 * n;
        if (tid < 64) { float gv = GG[(t0 + tid) * 8 + h]; btS[tid] = BETA[(t0 + tid) * 8 + h];
#pragma unroll
            for (int o = 1; o < 64; o <<= 1) { const float tv = __shfl_up(gv, o); if (lane >= o) gv += tv; }
            gcS[tid] = gv; }
        for (int e = tid; e < 6 * 256; e += NTHR) { const int bq = e >> 8, r = (e >> 4) & 15, c = e & 15;
            const int bi = (bq < 3) ? 0 : (bq < 5 ? 1 : 2), bj = (bq < 3) ? bq + 1 : (bq < 5 ? bq - 1 : 3);
            Tm[(16 * bi + r) * 65 + 16 * bj + c] = 0.f; }
        if (h != hcur) {
            __syncthreads();
            for (int i2 = tid; i2 < 4 * 3 * 128; i2 += NTHR) { const int kk = i2 / 384, rem = i2 - kk * 384; Wc[i2] = wconv[kk * 3072 + (rem >> 7) * 1024 + h * 128 + (rem & 127)]; }
            hcur = h;
            __syncthreads();
        }
#pragma unroll 1
        for (int rnd = 0; rnd < 2; ++rnd) {
        v4u PV[3][4];
#pragma unroll
        for (int s3 = 0; s3 < 3; ++s3) {
            const int idx = wave * 6 + rnd * 3 + s3, mat = idx >> 4, rg = idx & 15;
            const int row = 4 * rg + (lane >> 4), oct = lane & 15, colg = mat * 1024 + h * 128 + 8 * oct;
#pragma unroll
            for (int kk = 0; kk < 4; ++kk) {
                const int rr = row - 3 + kk;
                v4u v = (v4u){0u, 0u, 0u, 0u};
                if (rr >= 0) v = *(const v4u*)(PROJ + (t0 + rr) * 4096 + colg);
                else if (n > 0) v = *(const v4u*)(HALO + ((size_t)(b * 256 + n - 1) * 3 + (rr + 3)) * 3072 + colg);
                PV[s3][kk] = v; }
        }
#pragma unroll
        for (int s3 = 0; s3 < 3; ++s3) {
            const int idx = wave * 6 + rnd * 3 + s3, mat = idx >> 4, rg = idx & 15;
            const int row = 4 * rg + (lane >> 4), oct = lane & 15;
            float a[8];
#pragma unroll
            for (int e = 0; e < 8; ++e) a[e] = 0.f;
#pragma unroll
            for (int kk = 0; kk < 4; ++kk) {
                const v4u v = PV[s3][kk];
                const f32x4 w0 = *(const LAS f32x4*)(Wc + (kk * 3 + mat) * 128 + 8 * oct), w1 = *(const LAS f32x4*)(Wc + (kk * 3 + mat) * 128 + 8 * oct + 4);
                a[0] += w0.x * bflo(v.x); a[1] += w0.y * bfhi(v.x); a[2] += w0.z * bflo(v.y); a[3] += w0.w * bfhi(v.y);
                a[4] += w1.x * bflo(v.z); a[5] += w1.y * bfhi(v.z); a[6] += w1.z * bflo(v.w); a[7] += w1.w * bfhi(v.w);
            }
            float ss = 0.f;
#pragma unroll
            for (int e = 0; e < 8; ++e) { a[e] = silu_f(a[e]); ss += a[e] * a[e]; }
            ss += __shfl_xor(ss, 1); ss += __shfl_xor(ss, 2); ss += __shfl_xor(ss, 4); ss += __shfl_xor(ss, 8);
            float rs = 1.f;
            if (mat == 0) rs = rsqrtf(ss + EPS) * 0.08838834764831845f; else if (mat == 1) rs = rsqrtf(ss + EPS);
            v4u o; o.x = pk2(a[0] * rs, a[1] * rs); o.y = pk2(a[2] * rs, a[3] * rs); o.z = pk2(a[4] * rs, a[5] * rs); o.w = pk2(a[6] * rs, a[7] * rs);
            LAS bf16* dst = (mat == 0 ? QB : (mat == 1 ? KB : VBt)) + row * 136 + 8 * oct;
            *(LAS v4u*)dst = o;
        }
        }
        __syncthreads();
        { const int isq = wave >> 2, m = wave & 3, r16 = lane & 15, q = lane >> 4;
          LAS bf16* As = isq ? QB : KB;
          bf16x8 af[4];
#pragma unroll
          for (int s = 0; s < 4; ++s) af[s] = *(const LAS bf16x8*)(As + (16 * m + r16) * 136 + 32 * s + 8 * q);
#pragma unroll
          for (int nt = 0; nt < 4; ++nt) { f32x4 acc = (f32x4){0.f, 0.f, 0.f, 0.f};
#pragma unroll
              for (int s = 0; s < 4; ++s) { const bf16x8 bfr = *(const LAS bf16x8*)(KB + (16 * nt + r16) * 136 + 32 * s + 8 * q); acc = MFMA16(af[s], bfr, acc); }
#pragma unroll
              for (int jj = 0; jj < 4; ++jj) { const int i = 16 * m + 4 * q + jj, j = 16 * nt + r16;
                  const float dec = __expf(fminf(gcS[i] - gcS[j], 0.f));
                  if (!isq) Lm[i * 65 + j] = (i > j) ? acc[jj] * btS[i] * dec : 0.f;
                  else QKm[i * 65 + j] = (i >= j) ? acc[jj] * dec : 0.f; } }
        }
        __syncthreads();
        const float gl = gcS[63];
        if (wave == 0) {
            const int blk = lane >> 4, col = lane & 15; const LAS float* Lb = Lm + (16 * blk) * 65 + 16 * blk;
            float t[16];
#pragma unroll
            for (int r = 0; r < 16; ++r) { float a = (r == col) ? 1.f : 0.f;
#pragma unroll
                for (int x = 0; x < r; ++x) a -= Lb[r * 65 + x] * t[x];
                t[r] = a; }
#pragma unroll
            for (int r = 0; r < 16; ++r) Tm[(16 * blk + r) * 65 + 16 * blk + col] = t[r];
        } else {
#pragma unroll 1
            for (int p0 = tid - 64; p0 < 4608; p0 += 448) {
                const int sect = p0 >> 10, p = p0 & 1023, l = p & 63, f = p >> 6, q = l >> 4, r16 = l & 15;
                v4u o;
                bf16* dst;
                if (sect == 0) {
                    const int m = f >> 2, s = f & 3, i = 16 * m + r16, c0 = 32 * s + 4 * q;
                    LAS bf16* src = QB + i * 136 + c0;
                    const v2u x0 = *(const LAS v2u*)src, x1 = *(const LAS v2u*)(src + 16);
                    const float sc = __expf(gcS[i]);
                    o.x = pk2(bflo(x0.x) * sc, bfhi(x0.x) * sc); o.y = pk2(bflo(x0.y) * sc, bfhi(x0.y) * sc);
                    o.z = pk2(bflo(x1.x) * sc, bfhi(x1.x) * sc); o.w = pk2(bflo(x1.y) * sc, bfhi(x1.y) * sc);
                    dst = PROJ + (t0 + (p >> 4)) * 4096 + h * 128 + (p & 15) * 8;
                } else if (sect == 1) {
                    o = *(const LAS v4u*)(KB + (p >> 4) * 136 + (p & 15) * 8);
                    dst = PROJ + (t0 + (p >> 4)) * 4096 + 1024 + h * 128 + (p & 15) * 8;
                } else if (sect == 2) {
                    const int w = p >> 7, ll = (p & 127) >> 1, half = p & 1; float y[8];
#pragma unroll
                    for (int jj = 0; jj < 8; ++jj) { const int m = half * 2 + (jj >> 2), rowi = 16 * m + 4 * (ll >> 4) + (jj & 3);
                        y[jj] = bf2f(VBt[rowi * 136 + 16 * w + (ll & 15)]) * btS[rowi]; }
                    o.x = pk2(y[0], y[1]); o.y = pk2(y[2], y[3]); o.z = pk2(y[4], y[5]); o.w = pk2(y[6], y[7]);
                    dst = PROJ + (t0 + (p >> 4)) * 4096 + 2048 + h * 128 + (p & 15) * 8;
                } else if (sect == 3) {
                    if (p >= 32) continue;
                    float y[4];
#pragma unroll
                    for (int jj = 0; jj < 4; ++jj) { const int i = 4 * (p & 15) + jj; y[jj] = (p < 16) ? -btS[i] * __expf(gcS[i]) : __expf(gl - gcS[i]); }
                    o.x = __builtin_bit_cast(unsigned, y[0]); o.y = __builtin_bit_cast(unsigned, y[1]); o.z = __builtin_bit_cast(unsigned, y[2]); o.w = __builtin_bit_cast(unsigned, y[3]);
                    dst = (bf16*)(EX + (size_t)it * 32768 + p * 16);
                } else {
                    const int m = f >> 1, s = f & 1, i = 16 * m + r16; float y[8];
#pragma unroll
                    for (int jj = 0; jj < 8; ++jj) y[jj] = QKm[i * 65 + kperm(s, q, jj)];
                    o.x = pk2(y[0], y[1]); o.y = pk2(y[2], y[3]); o.z = pk2(y[4], y[5]); o.w = pk2(y[6], y[7]);
                    dst = (bf16*)(EX + (size_t)it * 32768 + 24576 + p * 16);
                }
                if (DRY) { dst = DRYBUF + (size_t)(it & 255) * 40960 + p0 * 8; *(v4u*)dst = o; } else st16_wt(dst, o);
            }
        }
        __syncthreads();
#pragma unroll
        for (int d = 1; d <= 3; ++d) {
            const int nel = (4 - d) * 256;
            for (int e = tid; e < nel; e += NTHR) { const int bj = e >> 8, r = (e >> 4) & 15, c = e & 15, bi = bj + d;
                const LAS float* Lr = Lm + (16 * bi + r) * 65; const LAS float* Tc = Tm + 16 * bj + c; float a = 0.f;
#pragma unroll
                for (int yy = 0; yy < 16 * d; ++yy) { const int y = 16 * bj + yy; a += Lr[y] * Tc[y * 65]; }
                Mt[(16 * bi + r) * 65 + 16 * bj + c] = a; }
            __syncthreads();
            for (int e = tid; e < nel; e += NTHR) { const int bj = e >> 8, r = (e >> 4) & 15, c = e & 15, bi = bj + d;
                const LAS float* Dr = Tm + (16 * bi + r) * 65 + 16 * bi; const LAS float* Mc = Mt + (16 * bi) * 65 + 16 * bj + c; float a = 0.f;
#pragma unroll
                for (int x = 0; x < 16; ++x) a += Dr[x] * Mc[x * 65];
                Tm[(16 * bi + r) * 65 + 16 * bj + c] = -a; }
            __syncthreads();
        }
        { const int p = tid, l = p & 63, f = p >> 6, q = l >> 4, r16 = l & 15, m = f >> 1, s = f & 1, i = 16 * m + r16; float y[8];
#pragma unroll
          for (int jj = 0; jj < 8; ++jj) y[jj] = Tm[i * 65 + kperm(s, q, jj)];
          v4u o; o.x = pk2(y[0], y[1]); o.y = pk2(y[2], y[3]); o.z = pk2(y[4], y[5]); o.w = pk2(y[6], y[7]);
          if (DRY) *(v4u*)(DRYBUF + (size_t)(it & 255) * 40960 + 36864 + p * 8) = o; else st16_wt(EX + (size_t)it * 32768 + 16384 + p * 16, o);
          if (tid == 0 && !DRY) __hip_atomic_store(GL + it, __expf(gl), __ATOMIC_RELAXED, __HIP_MEMORY_SCOPE_AGENT); }
        asm volatile("s_waitcnt vmcnt(0)" ::: "memory");
        __syncthreads();
        if (tid == 0 && !DRY) __hip_atomic_store(FLAG + it, 1u, __ATOMIC_RELAXED, __HIP_MEMORY_SCOPE_AGENT);
    }
}

constexpr int GS_BUF = 57344;
constexpr int GS_QA = 18432, GS_SC = 34816, GS_TA = 36864, GS_QK = 45056, GS_VB = 53248;
DI void gdn_scan_phase(const bf16* PROJ, const unsigned char* EX, const float* GL, const unsigned* FLAG, bf16* ORAW, LAS unsigned char* lds, int bid, int tid, int wave, int lane) {
    if (bid >= 64) return;
    const int bh = bid >> 2, sub = bid & 3, b = bh >> 3, h = bh & 7, q = lane >> 4, r16 = lane & 15;
    LAS unsigned char* OB = lds + 2 * GS_BUF;
    LAS float* GLs = (LAS float*)(lds + 2 * GS_BUF + 8192);
    if (wave >= 2) {
        const int g = (wave - 2) >> 1, i = tid & 127, rowi = i >> 4, pc = i & 15;
        v4u R0[9], R1[9], R2[9]; float G0, G1, G2;
#define GS_LD(R_, G_, n_) do { G_ = GL[bh * 256 + (n_)]; const size_t t0_ = (size_t)b * SEQ + 64 * (n_); const unsigned char* ex_ = EX + (size_t)(bh * 256 + (n_)) * 32768; \
        _Pragma("unroll") for (int u = 0; u < 9; ++u) { const int c = g + 3 * u; const int k = c < 17 ? c : c + 7; \
            const unsigned char* base_; size_t stride_; \
            if (k < 8) { base_ = (const unsigned char*)(PROJ + (t0_ + 8 * k) * 4096 + 1024 + h * 128); stride_ = 8192; } \
            else if (k < 16) { base_ = (const unsigned char*)(PROJ + (t0_ + 8 * (k - 8)) * 4096 + h * 128); stride_ = 8192; } \
            else if (k < 32) { base_ = ex_ + (size_t)(k - 16) * 2048; stride_ = 256; } \
            else { base_ = (const unsigned char*)(PROJ + (t0_ + 8 * (2 * sub + (k - 32))) * 4096 + 2048 + h * 128); stride_ = 8192; } \
            R_[u] = *(const v4u*)(base_ + (size_t)rowi * stride_ + pc * 16); } } while (0)
#define GS_ST(R_, G_, n_, buf_) do { if (g == 0 && i == 0) GLs[(n_)] = G_; _Pragma("unroll") for (int u = 0; u < 9; ++u) { const int c = g + 3 * u; const int k = c < 17 ? c : c + 7; \
            int d_; if (k < 8) d_ = (8 * k + rowi) * 288 + pc * 16; else if (k < 16) d_ = GS_QA + (k - 8) * 2048 + i * 16; else if (k == 16) d_ = GS_SC + i * 16; \
            else if (k < 28) d_ = GS_TA + (k - 24) * 2048 + i * 16; else if (k < 32) d_ = GS_QK + (k - 28) * 2048 + i * 16; else d_ = GS_VB + (k - 32) * 2048 + i * 16; \
            *(LAS v4u*)((buf_) + d_) = R_[u]; } } while (0)
#define GS_OUT(n_) do { if (g == 2) { const size_t t0_ = (size_t)b * SEQ + 64 * (n_); \
        _Pragma("unroll") for (int u = 0; u < 2; ++u) { const int p = i + 128 * u, row = p >> 2, c = p & 3; \
            const v4u v = *(const LAS v4u*)(OB + ((n_) & 1) * 4096 + row * 64 + c * 16); \
            *(v4u*)(ORAW + (t0_ + row) * 1024 + h * 128 + 32 * sub + 8 * c) = v; } } } while (0)
        __syncthreads();
        GS_LD(R0, G0, 0); GS_LD(R1, G1, 1); GS_LD(R2, G2, 2);
        GS_ST(R0, G0, 0, lds);
        __syncthreads();
#define GS_STEP(n_, Rst_, Gst_, Rld_, Gld_) do { if ((n_) < 256) { if ((n_) + 3 < 256) GS_LD(Rld_, Gld_, (n_) + 3); if ((n_) >= 1) GS_OUT((n_) - 1); \
            if ((n_) + 1 < 256) GS_ST(Rst_, Gst_, (n_) + 1, lds + (((n_) + 1) & 1) * GS_BUF); __syncthreads(); } } while (0)
#pragma unroll 1
        for (int n = 0; n < 258; n += 3) {
            GS_STEP(n, R1, G1, R0, G0);
            GS_STEP(n + 1, R2, G2, R1, G1);
            GS_STEP(n + 2, R0, G0, R2, G2);
        }
        GS_OUT(255);
#undef GS_LD
#undef GS_ST
#undef GS_OUT
#undef GS_STEP
        return;
    }
    f32x4 S[8];
#pragma unroll
    for (int i = 0; i < 8; ++i) S[i] = (f32x4){0.f, 0.f, 0.f, 0.f};
    const unsigned* fl = FLAG + bh * 256;
#define GS_POLL(c_) do { unsigned sp_ = 0; while (__builtin_amdgcn_readfirstlane(__hip_atomic_load(fl + (c_), __ATOMIC_RELAXED, __HIP_MEMORY_SCOPE_AGENT)) == 0u) { __builtin_amdgcn_s_sleep(2); if (++sp_ > (1u << 22)) break; } } while (0)
    if (wave == 0) { GS_POLL(0); GS_POLL(1); GS_POLL(2); GS_POLL(3); __builtin_amdgcn_fence(__ATOMIC_ACQUIRE, "agent"); asm volatile("s_waitcnt vmcnt(0)" ::: "memory"); }
    __syncthreads();
    __syncthreads();
#pragma unroll 1
    for (int n = 0; n < 256; ++n) {
        LAS unsigned char* buf = lds + (n & 1) * GS_BUF;
        const float egl = GLs[n];
        unsigned fnext = 1u;
        if (wave == 0 && n + 4 < 256) fnext = __hip_atomic_load(fl + n + 4, __ATOMIC_RELAXED, __HIP_MEMORY_SCOPE_AGENT);
        f32x4 rhs[4];
        { const v4u vb0 = *(const LAS v4u*)(buf + GS_VB + wave * 2048 + lane * 32), vb1 = *(const LAS v4u*)(buf + GS_VB + wave * 2048 + lane * 32 + 16);
          rhs[0] = (f32x4){bflo(vb0.x), bfhi(vb0.x), bflo(vb0.y), bfhi(vb0.y)}; rhs[1] = (f32x4){bflo(vb0.z), bfhi(vb0.z), bflo(vb0.w), bfhi(vb0.w)};
          rhs[2] = (f32x4){bflo(vb1.x), bfhi(vb1.x), bflo(vb1.y), bfhi(vb1.y)}; rhs[3] = (f32x4){bflo(vb1.z), bfhi(vb1.z), bflo(vb1.w), bfhi(vb1.w)}; }
        bf16x8 Sb[4];
#pragma unroll
        for (int s = 0; s < 4; ++s) Sb[s] = pack_acc2(S[2 * s], S[2 * s + 1]);
        f32x4 tk[4];
#pragma unroll
        for (int m = 0; m < 4; ++m) tk[m] = (f32x4){0.f, 0.f, 0.f, 0.f};
#pragma unroll
        for (int s = 0; s < 4; ++s)
#pragma unroll
            for (int m = 0; m < 4; ++m) { const LAS unsigned char* kp = buf + (16 * m + r16) * 288 + (32 * s + 4 * q) * 2;
                const v2u lo = *(const LAS v2u*)kp, hi2 = *(const LAS v2u*)(kp + 32);
                v4u w; w.x = lo.x; w.y = lo.y; w.z = hi2.x; w.w = hi2.y;
                tk[m] = MFMA16(__builtin_bit_cast(bf16x8, w), Sb[s], tk[m]); }
#pragma unroll
        for (int m = 0; m < 4; ++m) { const f32x4 sc1 = *(const LAS f32x4*)(buf + GS_SC + (16 * m + 4 * q) * 4); rhs[m] = rhs[m] + sc1 * tk[m]; }
        bf16x8 Rb[2];
#pragma unroll
        for (int s = 0; s < 2; ++s) Rb[s] = pack_acc2(rhs[2 * s], rhs[2 * s + 1]);
        f32x4 vn[4];
#pragma unroll
        for (int m = 0; m < 4; ++m) vn[m] = (f32x4){0.f, 0.f, 0.f, 0.f};
#pragma unroll
        for (int s = 0; s < 2; ++s)
#pragma unroll
            for (int m = 0; m < 4; ++m) { const bf16x8 a = *(const LAS bf16x8*)(buf + GS_TA + (m * 2 + s) * 1024 + lane * 16); vn[m] = MFMA16(a, Rb[s], vn[m]); }
        bf16x8 Vb[2];
#pragma unroll
        for (int s = 0; s < 2; ++s) Vb[s] = pack_acc2(vn[2 * s], vn[2 * s + 1]);
        bf16x8 Vs[2];
        { f32x4 vsc[4];
#pragma unroll
          for (int m = 0; m < 4; ++m) { const f32x4 sc2 = *(const LAS f32x4*)(buf + GS_SC + 256 + (16 * m + 4 * q) * 4); vsc[m] = vn[m] * sc2; }
#pragma unroll
          for (int s = 0; s < 2; ++s) Vs[s] = pack_acc2(vsc[2 * s], vsc[2 * s + 1]); }
#pragma unroll
        for (int m8 = 0; m8 < 8; ++m8) S[m8] = S[m8] * egl;
#pragma unroll
        for (int s = 0; s < 2; ++s)
#pragma unroll
            for (int m8 = 0; m8 < 8; ++m8) {
                const LAS unsigned char* tp = buf + (32 * s + 4 * q + ((lane & 15) >> 2)) * 288 + 32 * m8 + 8 * (lane & 3);
                const v4i16_t lo = fx_vtr(tp), hi4 = fx_vtr(tp + 16 * 288);
                S[m8] = MFMA16(__builtin_shufflevector(lo, hi4, 0, 1, 2, 3, 4, 5, 6, 7), Vs[s], S[m8]); }
        f32x4 o[4];
#pragma unroll
        for (int m = 0; m < 4; ++m) o[m] = (f32x4){0.f, 0.f, 0.f, 0.f};
#pragma unroll
        for (int s = 0; s < 4; ++s)
#pragma unroll
            for (int m = 0; m < 4; ++m) { const bf16x8 a = *(const LAS bf16x8*)(buf + GS_QA + (m * 4 + s) * 1024 + lane * 16); o[m] = MFMA16(a, Sb[s], o[m]); }
#pragma unroll
        for (int s = 0; s < 2; ++s)
#pragma unroll
            for (int m = 0; m < 4; ++m) { const bf16x8 a = *(const LAS bf16x8*)(buf + GS_QK + (m * 2 + s) * 1024 + lane * 16); o[m] = MFMA16(a, Vb[s], o[m]); }
        { LAS bf16* ob = (LAS bf16*)(OB + (n & 1) * 4096);
#pragma unroll
          for (int m = 0; m < 4; ++m)
#pragma unroll
              for (int j = 0; j < 4; ++j) ob[(16 * m + 4 * q + j) * 32 + 16 * wave + r16] = (bf16)f2bf(o[m][j]); }
        if (wave == 0 && n + 4 < 256) { if (__builtin_amdgcn_readfirstlane(fnext) == 0u) GS_POLL(n + 4);
            __builtin_amdgcn_fence(__ATOMIC_ACQUIRE, "agent"); asm volatile("s_waitcnt vmcnt(0)" ::: "memory"); }
        __syncthreads();
    }
#undef GS_POLL
}

DI void gdn_onorm_phase(bf16* OY, const bf16* PROJ, const float* wn, float* ROPE, const int* pos, int gw, int NGW, int lane) {
    constexpr int NR = 4;
    for (int row = gw; row < TT; row += NGW) {
        if (lane < 32) { const float inv = powf(10000.f, -(float)lane * (1.f / 32.f)); const float ang = (float)pos[row] * inv; float sn, cs; sincosf(ang, &sn, &cs);
            ROPE[(size_t)row * 64 + lane] = cs; ROPE[(size_t)row * 64 + 32 + lane] = sn; } }
    float wv[16];
#pragma unroll
    for (int e = 0; e < 16; ++e) wv[e] = wn[16 * (lane & 7) + e];
    for (int row0 = gw * NR; row0 < TT; row0 += NGW * NR) {
        v4u o0[NR], o1[NR], z0[NR], z1[NR];
#pragma unroll
        for (int rr = 0; rr < NR; ++rr) { const bf16* op = OY + (size_t)(row0 + rr) * 1024 + 16 * lane; const bf16* zp = PROJ + (size_t)(row0 + rr) * 4096 + 3072 + 16 * lane;
            o0[rr] = *(const v4u*)op; o1[rr] = *(const v4u*)(op + 8); z0[rr] = *(const v4u*)zp; z1[rr] = *(const v4u*)(zp + 8); }
#pragma unroll
        for (int rr = 0; rr < NR; ++rr) {
            bf16* op = OY + (size_t)(row0 + rr) * 1024 + 16 * lane;
            float ov[16], zv[16];
#pragma unroll
            for (int e = 0; e < 4; ++e) { ov[2 * e] = bflo(o0[rr][e]); ov[2 * e + 1] = bfhi(o0[rr][e]); ov[8 + 2 * e] = bflo(o1[rr][e]); ov[8 + 2 * e + 1] = bfhi(o1[rr][e]);
                zv[2 * e] = bflo(z0[rr][e]); zv[2 * e + 1] = bfhi(z0[rr][e]); zv[8 + 2 * e] = bflo(z1[rr][e]); zv[8 + 2 * e + 1] = bfhi(z1[rr][e]); }
            float ss = 0.f;
#pragma unroll
            for (int e = 0; e < 16; ++e) ss += ov[e] * ov[e];
            ss += __shfl_xor(ss, 1); ss += __shfl_xor(ss, 2); ss += __shfl_xor(ss, 4);
            const float rs = rsqrtf(ss * (1.f / 128.f) + EPS);
            float y[16];
#pragma unroll
            for (int e = 0; e < 16; ++e) y[e] = ov[e] * rs * wv[e] * silu_f(zv[e]);
            v4u a, c; a.x = pk2(y[0], y[1]); a.y = pk2(y[2], y[3]); a.z = pk2(y[4], y[5]); a.w = pk2(y[6], y[7]);
            c.x = pk2(y[8], y[9]); c.y = pk2(y[10], y[11]); c.z = pk2(y[12], y[13]); c.w = pk2(y[14], y[15]);
            *(v4u*)op = a; *(v4u*)(op + 8) = c;
        }
    }
}
DI void swa_phase(const bf16* PROJ, const float* ROPE, const float* sinks, bf16* Y, LAS unsigned char* lds, int bid, int G, int tid, int wave, int lane) {
    LAS bf16* Ks = (LAS bf16*)lds;
    LAS bf16* Vs = (LAS bf16*)(lds + 36864);
    const int r = lane & 31, hi = lane >> 5;
    const float LOG2E = 1.4426950408889634f, c2 = 0.125f * LOG2E;
    for (int it = bid; it < 1024; it += G) {
        const int hk = it & 3, nb = (it >> 2) & 127, b = it >> 9;
        const long tb0 = (long)b * SEQ + (long)(nb - 1) * 128;
#pragma unroll
        for (int u = 0; u < 2; ++u) { const int p = tid + 512 * u, kk = p >> 2, o = p & 3;
            v4u w1 = (v4u){0u, 0u, 0u, 0u}, w2 = (v4u){0u, 0u, 0u, 0u};
            if (nb > 0 || kk >= 128) {
                const size_t t = (size_t)(tb0 + kk);
                const bf16* kp = PROJ + t * 2560 + 1024 + hk * 64 + 8 * o;
                const v4u a = *(const v4u*)kp, c = *(const v4u*)(kp + 32);
                const f32x4 cs0 = *(const f32x4*)(ROPE + t * 64 + 8 * o), cs1 = *(const f32x4*)(ROPE + t * 64 + 8 * o + 4);
                const f32x4 sn0 = *(const f32x4*)(ROPE + t * 64 + 32 + 8 * o), sn1 = *(const f32x4*)(ROPE + t * 64 + 32 + 8 * o + 4);
                float x1[8], x2[8], cs[8], sn[8];
#pragma unroll
                for (int e = 0; e < 4; ++e) { x1[2 * e] = bflo(a[e]); x1[2 * e + 1] = bfhi(a[e]); x2[2 * e] = bflo(c[e]); x2[2 * e + 1] = bfhi(c[e]);
                    cs[e] = cs0[e]; cs[4 + e] = cs1[e]; sn[e] = sn0[e]; sn[4 + e] = sn1[e]; }
                float y1[8], y2[8];
#pragma unroll
                for (int e = 0; e < 8; ++e) { y1[e] = x1[e] * cs[e] - x2[e] * sn[e]; y2[e] = x2[e] * cs[e] + x1[e] * sn[e]; }
                w1.x = pk2(y1[0], y1[1]); w1.y = pk2(y1[2], y1[3]); w1.z = pk2(y1[4], y1[5]); w1.w = pk2(y1[6], y1[7]);
                w2.x = pk2(y2[0], y2[1]); w2.y = pk2(y2[2], y2[3]); w2.z = pk2(y2[4], y2[5]); w2.w = pk2(y2[6], y2[7]);
            }
            *(LAS v4u*)(Ks + kk * 72 + 8 * o) = w1; *(LAS v4u*)(Ks + kk * 72 + 32 + 8 * o) = w2; }
#pragma unroll
        for (int u = 0; u < 4; ++u) { const int p = tid + 512 * u, kk = p >> 3, o8 = p & 7;
            v4u v = (v4u){0u, 0u, 0u, 0u};
            if (nb > 0 || kk >= 128) v = *(const v4u*)(PROJ + (size_t)(tb0 + kk) * 2560 + 1280 + hk * 64 + 8 * o8);
            const int pos = (kk & ~15) + perm16(kk & 15);
            LAS bf16* d = Vs + (8 * o8) * 264 + pos;
            d[0] = (bf16)(v.x & 0xffffu); d[264] = (bf16)(v.x >> 16); d[2 * 264] = (bf16)(v.y & 0xffffu); d[3 * 264] = (bf16)(v.y >> 16);
            d[4 * 264] = (bf16)(v.z & 0xffffu); d[5 * 264] = (bf16)(v.z >> 16); d[6 * 264] = (bf16)(v.w & 0xffffu); d[7 * 264] = (bf16)(v.w >> 16); }
        __syncthreads();
        const int g = wave >> 1, qh = wave & 1, head = hk * 4 + g;
        const float sink2 = sinks[head] * LOG2E;
        for (int sb = 0; sb < 2; ++sb) {
            const int qs = 64 * qh + 32 * sb, qi = qs + r, tbase = qs >> 5;
            const size_t t = (size_t)b * SEQ + (size_t)nb * 128 + qi;
            bf16x8 Qf[4];
            { const bf16* qp = PROJ + t * 2560 + head * 64 + 8 * hi;
              v4u qa[4];
#pragma unroll
              for (int ks = 0; ks < 4; ++ks) qa[ks] = *(const v4u*)(qp + 16 * ks);
#pragma unroll
              for (int k2 = 0; k2 < 2; ++k2) {
                  const f32x4 cs0 = *(const f32x4*)(ROPE + t * 64 + 16 * k2 + 8 * hi), cs1 = *(const f32x4*)(ROPE + t * 64 + 16 * k2 + 8 * hi + 4);
                  const f32x4 sn0 = *(const f32x4*)(ROPE + t * 64 + 32 + 16 * k2 + 8 * hi), sn1 = *(const f32x4*)(ROPE + t * 64 + 32 + 16 * k2 + 8 * hi + 4);
                  float y1[8], y2[8];
#pragma unroll
                  for (int e = 0; e < 4; ++e) {
                      const float a0 = bflo(qa[k2][e]), a1 = bfhi(qa[k2][e]), c0 = bflo(qa[k2 + 2][e]), c1 = bfhi(qa[k2 + 2][e]);
                      const float cA = (e < 2) ? cs0[2 * e] : cs1[2 * e - 4], cB = (e < 2) ? cs0[2 * e + 1] : cs1[2 * e - 3];
                      const float sA = (e < 2) ? sn0[2 * e] : sn1[2 * e - 4], sB = (e < 2) ? sn0[2 * e + 1] : sn1[2 * e - 3];
                      y1[2 * e] = a0 * cA - c0 * sA; y2[2 * e] = c0 * cA + a0 * sA;
                      y1[2 * e + 1] = a1 * cB - c1 * sB; y2[2 * e + 1] = c1 * cB + a1 * sB; }
                  v4u w1, w2;
                  w1.x = pk2(y1[0], y1[1]); w1.y = pk2(y1[2], y1[3]); w1.z = pk2(y1[4], y1[5]); w1.w = pk2(y1[6], y1[7]);
                  w2.x = pk2(y2[0], y2[1]); w2.y = pk2(y2[2], y2[3]); w2.z = pk2(y2[4], y2[5]); w2.w = pk2(y2[6], y2[7]);
                  Qf[k2] = __builtin_bit_cast(bf16x8, w1); Qf[k2 + 2] = __builtin_bit_cast(bf16x8, w2); } }
            f32x16 S[5];
            float mx = sink2;
#pragma unroll
            for (int tk = 0; tk < 5; ++tk) {
#pragma unroll
                for (int i = 0; i < 16; ++i) S[tk][i] = 0.f;
                const int kt = tbase + tk;
#pragma unroll
                for (int ks = 0; ks < 4; ++ks) { const bf16x8 a = *(const LAS bf16x8*)(Ks + (32 * kt + r) * 72 + 16 * ks + 8 * hi); S[tk] = MFMA32(a, Qf[ks], S[tk]); }
#pragma unroll
                for (int i = 0; i < 16; ++i) { const int kk = 32 * kt + crow32(i, hi);
                    const bool ok = (kk > qi) && (kk <= qi + 128) && (nb > 0 || kk >= 128);
                    const float xv = ok ? S[tk][i] * c2 : -INFINITY; S[tk][i] = xv; mx = fmaxf(mx, xv); }
            }
            mx = fmaxf(mx, __shfl_xor(mx, 32));
            float ps = 0.f;
#pragma unroll
            for (int tk = 0; tk < 5; ++tk)
#pragma unroll
                for (int i = 0; i < 16; ++i) { const float p = __builtin_amdgcn_exp2f(S[tk][i] - mx); S[tk][i] = p; ps += p; }
            const float tot = ps + __shfl_xor(ps, 32) + __builtin_amdgcn_exp2f(sink2 - mx);
            const float inv = 1.f / tot;
            f32x16 O[2];
#pragma unroll
            for (int dt = 0; dt < 2; ++dt)
#pragma unroll
                for (int i = 0; i < 16; ++i) O[dt][i] = 0.f;
#pragma unroll
            for (int tk = 0; tk < 5; ++tk)
#pragma unroll
                for (int s = 0; s < 2; ++s) { v4u w;
                    w.x = pk2(S[tk][8 * s], S[tk][8 * s + 1]); w.y = pk2(S[tk][8 * s + 2], S[tk][8 * s + 3]);
                    w.z = pk2(S[tk][8 * s + 4], S[tk][8 * s + 5]); w.w = pk2(S[tk][8 * s + 6], S[tk][8 * s + 7]);
                    const bf16x8 pf = __builtin_bit_cast(bf16x8, w);
                    const int kt = tbase + tk;
#pragma unroll
                    for (int dt = 0; dt < 2; ++dt) { const bf16x8 a = *(const LAS bf16x8*)(Vs + (32 * dt + r) * 264 + 32 * kt + 16 * s + 8 * hi); O[dt] = MFMA32(a, pf, O[dt]); } }
#pragma unroll
            for (int dt = 0; dt < 2; ++dt)
#pragma unroll
                for (int g4 = 0; g4 < 4; ++g4) { const int d = 32 * dt + 8 * g4 + 4 * hi;
                    const v2u z = *(const v2u*)(PROJ + t * 2560 + 1536 + head * 64 + d);
                    const float y0 = O[dt][4 * g4] * inv * silu_f(bflo(z.x)), y1 = O[dt][4 * g4 + 1] * inv * silu_f(bfhi(z.x));
                    const float y2 = O[dt][4 * g4 + 2] * inv * silu_f(bflo(z.y)), y3 = O[dt][4 * g4 + 3] * inv * silu_f(bfhi(z.y));
                    v2u o; o.x = pk2(y0, y1); o.y = pk2(y2, y3);
                    *(v2u*)(Y + t * 1024 + head * 64 + d) = o; }
        }
        __syncthreads();
    }
}
#ifndef LAYER_MASK
#define LAYER_MASK 15
#endif
__global__ void __launch_bounds__(NTHR, 2) mega_fwd(Ptrs P) {
    extern __shared__ __attribute__((aligned(16))) unsigned char lds_raw[];
    LAS unsigned char* lds = (LAS unsigned char*)lds_raw;
    cg::grid_group grid = cg::this_grid();
    int tid_o = threadIdx.x; int tid = tid_o, lane = tid & 63; const int wave = __builtin_amdgcn_readfirstlane(tid >> 6);
    const int G = gridDim.x, bid = blockIdx.x;
    const int gw = bid * NWAVES + wave, NGW = G * NWAVES, NG = G * NTHR; int gtid = bid * NTHR + tid;
    unsigned char* ws = P.ws;
    const float* x_in = P.in[0]; const int* positions = (const int*)P.in[1];
    const float* norm_w = P.in[2]; const float* fnorm_w = P.in[3];
    float* X = P.out;
    bf16* XB = (bf16*)P.out;
    bf16* XB3 = (bf16*)(ws + WS_EX + 64 * MiB);
    bf16* HY = (bf16*)(ws + WS_HY); bf16* PROJ = (bf16*)(ws + WS_PROJ);
#define RELAUNDER() do { asm volatile("" : "+v"(tid_o)); tid = tid_o; lane = tid & 63; gtid = bid * NTHR + tid; } while (0)
#define GSYNC() do { xcd_barrier(xbar); RELAUNDER(); } while (0)

    unsigned* CTL = (unsigned*)(ws + WS_GL + 65536);
    if (bid == 0 && tid < 128) CTL[tid] = 0u;
    unsigned* FLAGS = (unsigned*)(ws + WS_GL + 131072);
    for (int i = gtid; i < 4096; i += NG) FLAGS[i] = 0u;
    unsigned* XBW = (unsigned*)(ws + WS_GL + 262144);
    volatile LAS unsigned* xst = (volatile LAS unsigned*)(lds + LDS_BYTES - 16);
    if (bid == 0) for (int i = tid; i < XCD_BAR_WORDS; i += NTHR) XBW[i] = 0u;
    if (tid < 2) xst[tid] = 0u;
    p0_prologue(P, lds, gw, NGW, wave, lane);
#ifdef DBL_P0
    p0_prologue(P, lds, gw, NGW, wave, lane);
#endif
    norm_phase<0>(x_in, norm_w, HY, nullptr, nullptr, 0, nullptr, nullptr, nullptr, nullptr, nullptr, nullptr, lds, gw, NGW, tid, lane);
    grid.sync();
    RELAUNDER();
    const XcdBarrier xbar = xcd_barrier_post(XBW, xst);
    if (LAYER_MASK & 1) {
        bf16* Y0 = (bf16*)(ws + WS_EX); float* CVH = (float*)(ws + WS_PROJ); float* BND = (float*)(ws + WS_PROJ + 8 * MiB);
        { pg8::Gemm g{HY, (const bf16*)(ws + WS_W0I), TT, 4096, 1024}; pg8::StaticOrder S; S.init(TT, 4096, G, bid);
          pg8::EpiConvGate E{Y0, P.in[5], CVH, BND};
          pg8::gemm_phase<pg8::EpiConvGate, pg8::StaticOrder, true, true>(lds, g, S, E); }
        GSYNC();
        convfix_phase(CVH, BND, P.in[5], Y0, gtid, NG);
        GSYNC();
        { pg8::Gemm g{Y0, (const bf16*)(ws + WS_W0O), TT, 1024, 1024}; pg8::StaticOrder S; S.init(TT, 1024, G, bid);
          pg8::EpiRes<false, true> E{x_in, XB, nullptr};
          pg8::gemm_phase<pg8::EpiRes<false, true>, pg8::StaticOrder, true, true>(lds, g, S, E);
        }
    } else {
        for (size_t i = gtid; i < (size_t)TT * DM / 4; i += NG) { const f32x4 v = ((const f32x4*)x_in)[i]; v2u o; o.x = pk2(v.x, v.y); o.y = pk2(v.z, v.w); ((v2u*)XB)[i] = o; }
    }
    GSYNC();
    if (LAYER_MASK & 2) {
        float* LOGF = (float*)(ws + WS_LOGF); float* CUM = (float*)(ws + WS_CUM); bf16* VT = (bf16*)(ws + WS_EX);
        norm_phase<1, true>((const float*)XB, norm_w + 1024, HY, nullptr, P.in[7], 4104, LOGF, nullptr, P.in[8], nullptr, nullptr, nullptr, lds, gw, NGW, tid, lane);
        GSYNC();
        if (bid < 16) fox_cumsum(LOGF, CUM, bid, lds, tid);
        { pg8::Gemm g{HY, (const bf16*)(ws + WS_W1I), TT, 4096, 1024}; pg8::StaticOrder S; S.init(TT, 4096, G, bid);
          pg8::EpiStore E{PROJ, 4096, nullptr};
          pg8::gemm_phase<pg8::EpiStore, pg8::StaticOrder, true, true>(lds, g, S, E); }
        GSYNC();
        fox_norms_phase(PROJ, (float*)(CTL + 1024), gw, NGW, lane);
#ifdef DBL_VTRANS
        fox_norms_phase(PROJ, (float*)(CTL + 1024), gw, NGW, lane);
#endif
        GSYNC();
        fox_attn_phase(PROJ, CUM, HY, (const float*)(CTL + 1024), CTL + 64, lds, bid, G, tid, wave, lane);
#ifdef DBL_FOX
        fox_attn_phase(PROJ, CUM, HY, (const float*)(CTL + 1024), CTL + 65, lds, bid, G, tid, wave, lane);
#endif
        GSYNC();
        { pg8::Gemm g{HY, (const bf16*)(ws + WS_W1O), TT, 1024, 1024}; pg8::StaticOrder S; S.init(TT, 1024, G, bid);
          pg8::EpiRes<true, true> E{XB, XB, nullptr};
          pg8::gemm_phase<pg8::EpiRes<true, true>, pg8::StaticOrder, true, true>(lds, g, S, E); }
        GSYNC();
    }
    if (LAYER_MASK & 4) {
        float* BETA = (float*)(ws + WS_LOGF); float* GG = (float*)(ws + WS_CUM); float* GL = (float*)(ws + WS_GL); bf16* HALO = (bf16*)(ws + WS_HALO);
        norm_phase<2, true>((const float*)XB, norm_w + 2048, HY, nullptr, P.in[10], 4112, BETA, GG, P.in[12], P.in[13], nullptr, nullptr, lds, gw, NGW, tid, lane);
#ifdef DBL_NORM2
        norm_phase<2, true>((const float*)XB, norm_w + 2048, HY, nullptr, P.in[10], 4112, BETA, GG, P.in[12], P.in[13], nullptr, nullptr, lds, gw, NGW, tid, lane);
#endif
        GSYNC();
        { pg8::Gemm g{HY, (const bf16*)(ws + WS_W2I), TT, 4096, 1024}; pg8::StaticOrder S; S.init(TT, 4096, G, bid);
          pg8::EpiStore E{PROJ, 4096, HALO};
          pg8::gemm_phase<pg8::EpiStore, pg8::StaticOrder, true, true>(lds, g, S, E); }
        GSYNC();
        if (bid >= 64) gdn_prep_phase<false>(PROJ, HY, HALO, P.in[11], BETA, GG, ws + WS_EX, GL, FLAGS, lds, bid, G, 64, tid, wave, lane);
        else gdn_scan_phase(PROJ, ws + WS_EX, GL, FLAGS, HY, lds, bid, tid, wave, lane);
        GSYNC();
        gdn_onorm_phase(HY, PROJ, P.in[14], (float*)(ws + WS_EX), positions, gw, NGW, lane);
        GSYNC();
        { pg8::Gemm g{HY, (const bf16*)(ws + WS_W2O), TT, 1024, 1024}; pg8::StaticOrder S; S.init(TT, 1024, G, bid);
          pg8::EpiRes<true, true, true> E{XB, XB3, (float*)(ws + WS_LOGF)};
          pg8::gemm_phase<pg8::EpiRes<true, true, true>, pg8::StaticOrder, true, true>(lds, g, S, E); }
        GSYNC();
    }
    if (LAYER_MASK & 8) {
        float* ROPE = (float*)(ws + WS_EX);
        { pg8::Gemm g{XB3, (const bf16*)(ws + WS_W3I), TT, 2560, 1024}; pg8::StaticOrder S; S.init(TT, 2560, G, bid);
          pg8::EpiStoreScaled E{PROJ, 2560, (const float*)(ws + WS_LOGF)};
          pg8::gemm_phase<pg8::EpiStoreScaled, pg8::StaticOrder, true, true>(lds, g, S, E); }
        GSYNC();
        swa_phase(PROJ, ROPE, P.in[17], HY, lds, bid, G, tid, wave, lane);
#ifdef DBL_SWA
        swa_phase(PROJ, ROPE, P.in[17], HY, lds, bid, G, tid, wave, lane);
#endif
        GSYNC();
        { pg8::Gemm g{HY, (const bf16*)(ws + WS_W3O), TT, 1024, 1024}; pg8::StaticOrder S; S.init(TT, 1024, G, bid);
          pg8::EpiRes<true, false> E{XB3, X, nullptr};
          pg8::gemm_phase<pg8::EpiRes<true, false>, pg8::StaticOrder, true, true>(lds, g, S, E); }
        GSYNC();
    }
#ifdef DBL_SYNC
    for (int i = 0; i < 10; ++i) GSYNC();
#endif
#ifdef DBL_FINAL
    norm_phase<0>(X, fnorm_w, HY, nullptr, nullptr, 0, nullptr, nullptr, nullptr, nullptr, nullptr, nullptr, lds, gw, NGW, tid, lane);
#endif
    norm_phase<4>(X, fnorm_w, nullptr, X, nullptr, 0, nullptr, nullptr, nullptr, nullptr, nullptr, nullptr, lds, gw, NGW, tid, lane);
}

extern "C" void kernel_launch(void* const* d_in, const int* in_sizes, int n_in, void* d_out, int out_size, void* d_ws, size_t ws_size, hipStream_t stream) {
    static int grid = 0;
    if (grid == 0) {
        int dev = 0, cus = 0, per_cu = 0;
        hipGetDevice(&dev);
        hipDeviceGetAttribute(&cus, hipDeviceAttributeMultiprocessorCount, dev);
        if (hipFuncSetAttribute((const void*)mega_fwd, hipFuncAttributeMaxDynamicSharedMemorySize, LDS_BYTES) != hipSuccess) fprintf(stderr, "kernel_launch: hipFuncSetAttribute failed\n");
        if (hipOccupancyMaxActiveBlocksPerMultiprocessor(&per_cu, (const void*)mega_fwd, NTHR, LDS_BYTES) != hipSuccess || per_cu < 1) { fprintf(stderr, "kernel_launch: occupancy query says %d\n", per_cu); per_cu = 1; }
        (void)hipGetLastError();
        grid = cus;
        if (ws_size < WS_END) fprintf(stderr, "kernel_launch: workspace %zu < %zu\n", ws_size, (size_t)WS_END);
    }
    Ptrs p{};
    for (int i = 0; i < 19; ++i) p.in[i] = (const float*)d_in[i];
    p.out = (float*)d_out; p.ws = (unsigned char*)d_ws; p.ph_lo = 0; p.ph_hi = 0;
    void* args[] = {&p};
    hipError_t e = hipLaunchCooperativeKernel((const void*)mega_fwd, dim3(grid), dim3(NTHR), args, LDS_BYTES, stream);
    if (e != hipSuccess) fprintf(stderr, "cooperative launch failed: %s (grid %d)\n", hipGetErrorString(e), grid);
}
```

```cpp
#include <hip/hip_runtime.h>
#include <hip/hip_cooperative_groups.h>
#include <cstdio>
#include <cstdint>
namespace cg = cooperative_groups;

#define DI __device__ __forceinline__
#define LAS __attribute__((address_space(3)))
#define GAS __attribute__((address_space(1)))
typedef unsigned short bf16;
typedef unsigned v4u __attribute__((ext_vector_type(4)));
typedef unsigned v2u __attribute__((ext_vector_type(2)));
typedef float f32x4 __attribute__((ext_vector_type(4)));
typedef float f32x16 __attribute__((ext_vector_type(16)));
typedef short bf16x8 __attribute__((ext_vector_type(8)));

constexpr int NBATCH = 2, SEQ = 16384, TT = NBATCH * SEQ, DM = 1024;
constexpr float EPS = 1e-6f;
constexpr int NWAVES = 8, NTHR = 512;
constexpr size_t MiB = 1u << 20;
constexpr size_t WS_W0I = 0, WS_W0O = 8 * MiB, WS_W1I = 10 * MiB, WS_W1O = 18 * MiB, WS_W2I = 20 * MiB, WS_W2O = 28 * MiB, WS_W3I = 30 * MiB, WS_W3O = 35 * MiB;
constexpr size_t WS_LOGF = 38 * MiB;
constexpr size_t WS_CUM = 39 * MiB;
constexpr size_t WS_GL = 40 * MiB;
constexpr size_t WS_HALO = 48 * MiB;
constexpr size_t WS_HY = 64 * MiB;
constexpr size_t WS_PROJ = 128 * MiB;
constexpr size_t WS_EX = 384 * MiB;
constexpr size_t WS_END = 512 * MiB;
constexpr int LDS_BYTES = 155648;

DI unsigned f2bf(float f) { unsigned u = __builtin_bit_cast(unsigned, f); return (u + 0x7fffu + ((u >> 16) & 1u)) >> 16; }
typedef float f32x2_t __attribute__((ext_vector_type(2)));
typedef __bf16 bf16x2_t __attribute__((ext_vector_type(2)));
DI unsigned pk2(float lo, float hi) { f32x2_t v = {lo, hi}; bf16x2_t b = __builtin_convertvector(v, bf16x2_t); return __builtin_bit_cast(unsigned, b); }
DI float bflo(unsigned u) { return __builtin_bit_cast(float, u << 16); }
DI float bfhi(unsigned u) { return __builtin_bit_cast(float, u & 0xffff0000u); }
DI float bf2f(bf16 b) { return __builtin_bit_cast(float, (unsigned)b << 16); }
DI float wave_sum(float v) {
#pragma unroll
    for (int o = 1; o < 64; o <<= 1) v += __shfl_xor(v, o);
    return v;
}
DI float silu_f(float x) { return x / (1.f + __expf(-x)); }
DI float softplus_f(float x) { return fmaxf(x, 0.f) + log1pf(__expf(-fabsf(x))); }
namespace pg8 {
#define PG8_LAS __attribute__((address_space(3)))
typedef unsigned short bf16_t;
typedef short bf16x8 __attribute__((ext_vector_type(8)));
typedef float f32x4 __attribute__((ext_vector_type(4)));
typedef unsigned u32x4 __attribute__((ext_vector_type(4)));
constexpr int BM = 256, BK = 64, HALF = 128, HTB = HALF * BK * 2  , STAGE_BYTES = 8 * HTB, NXCD = 8, WGM = 8;

__host__ __device__ __forceinline__ int lds_byte(int r, int c) { const int st = (r >> 4) * 2 + (c >> 5), rr = r & 15, cc = c & 31, ob = rr * 64 + cc * 2; return st * 1024 + (ob ^ (((ob >> 9) & 1) << 5)); }
__host__ __device__ __forceinline__ void stage_rc(int b, int& R, int& C) { const int st = b / 1024, sb = b % 1024, swz = sb ^ (((sb >> 9) & 1) << 5); R = (st >> 1) * 16 + swz / 64; C = (st & 1) * 32 + (swz % 64) / 2; }
__host__ __device__ __forceinline__ int perm32(int rho) { const int n = rho >> 4, i = rho & 15; return 8 * (i >> 2) + 4 * n + (i & 3); }

struct Unit { int pm, pn; };
struct Gemm { const bf16_t* A; const bf16_t* Bt; int M, N, K; };

struct StaticOrder {
    int nM, nN, nwg, G, c;
    __host__ __device__ void init(int M, int N, int G_, int c_) { nM = M / BM; nN = N / BM; nwg = nM * nN; G = G_; c = c_; }
    __host__ __device__ bool next(int i, Unit& u) const {
        const long L = (long)i * G + c; if (L >= nwg) return false;
        int wgid = (int)L; { const int q = nwg / NXCD, r = nwg % NXCD, xcd = wgid % NXCD, off = wgid / NXCD; wgid = (xcd < r ? xcd * (q + 1) : r * (q + 1) + (xcd - r) * q) + off; }
        const int nig = WGM * nN, gid = wgid / nig, fm = gid * WGM, gsz = (nM - fm) < WGM ? (nM - fm) : WGM;
        u.pm = fm + ((wgid % nig) % gsz); u.pn = (wgid % nig) / gsz; return true;
    }
    __device__ __forceinline__ void a_ready(const Unit&) const {}
    __device__ __forceinline__ void done(const Unit&) const {}
};

__device__ __forceinline__ unsigned cvt_pk_bf16(float lo, float hi) { unsigned r; asm volatile("v_cvt_pk_bf16_f32 %0, %1, %2" : "=v"(r) : "v"(lo), "v"(hi)); return r; }
struct EpiStore {
    static constexpr bool PERM = true, AFTER_DRAIN = false;
    bf16_t* O; int ldc; bf16_t* HALO;
    __device__ __forceinline__ void operator()(const f32x4 (&acc)[2][2][4][2], const Unit& u, int wr, int wc, int fr, int fq) const {
        const int row0 = u.pm * BM + wr * 64 + fr; const int col0 = u.pn * BM + wc * 32 + 8 * fq;
#pragma unroll
        for (int ai = 0; ai < 2; ++ai)
#pragma unroll
            for (int m = 0; m < 4; ++m) { const int row = row0 + ai * HALF + m * 16; bf16_t* rowp = O + (size_t)row * ldc + col0;
#pragma unroll
                for (int bj = 0; bj < 2; ++bj) { const f32x4 v0 = acc[ai][bj][m][0], v1 = acc[ai][bj][m][1];
                    u32x4 w; w.x = cvt_pk_bf16(v0[0], v0[1]); w.y = cvt_pk_bf16(v0[2], v0[3]); w.z = cvt_pk_bf16(v1[0], v1[1]); w.w = cvt_pk_bf16(v1[2], v1[3]);
                    *(u32x4*)(rowp + bj * HALF) = w;
                    if (HALO != nullptr && m == 3 && fr >= 13 && (col0 + bj * HALF) < 3072)
                        *(u32x4*)(HALO + ((size_t)(row >> 6) * 3 + (fr - 13)) * 3072 + col0 + bj * HALF) = w;
                } }
    }
};
template <bool RB, bool OB, bool PSUM = false>
struct EpiRes {
    static constexpr bool PERM = true, AFTER_DRAIN = false;
    const void* R; void* O; float* PS;
    __device__ __forceinline__ void operator()(const f32x4 (&acc)[2][2][4][2], const Unit& u, int wr, int wc, int fr, int fq) const {
        const int row0 = u.pm * BM + wr * 64 + fr; const int col0 = u.pn * BM + wc * 32 + 8 * fq;
#pragma unroll
        for (int ai = 0; ai < 2; ++ai)
#pragma unroll
            for (int m = 0; m < 4; ++m) { const size_t off = (size_t)(row0 + ai * HALF + m * 16) * 1024 + col0; float ssq = 0.f;
#pragma unroll
                for (int bj = 0; bj < 2; ++bj) {
                    f32x4 r0, r1;
                    if constexpr (RB) { const u32x4 w = *(const u32x4*)((const bf16_t*)R + off + bj * HALF);
                        r0 = (f32x4){__builtin_bit_cast(float, w.x << 16), __builtin_bit_cast(float, w.x & 0xffff0000u), __builtin_bit_cast(float, w.y << 16), __builtin_bit_cast(float, w.y & 0xffff0000u)};
                        r1 = (f32x4){__builtin_bit_cast(float, w.z << 16), __builtin_bit_cast(float, w.z & 0xffff0000u), __builtin_bit_cast(float, w.w << 16), __builtin_bit_cast(float, w.w & 0xffff0000u)}; }
                    else { r0 = *(const f32x4*)((const float*)R + off + bj * HALF); r1 = *(const f32x4*)((const float*)R + off + bj * HALF + 4); }
                    const f32x4 v0 = r0 + acc[ai][bj][m][0], v1 = r1 + acc[ai][bj][m][1];
                    if constexpr (OB) { u32x4 w; w.x = cvt_pk_bf16(v0[0], v0[1]); w.y = cvt_pk_bf16(v0[2], v0[3]); w.z = cvt_pk_bf16(v1[0], v1[1]); w.w = cvt_pk_bf16(v1[2], v1[3]);
                        *(u32x4*)((bf16_t*)O + off + bj * HALF) = w;
                        if constexpr (PSUM) {
#pragma unroll
                            for (int i = 0; i < 4; ++i) { const unsigned ww = (i == 0) ? w.x : (i == 1 ? w.y : (i == 2 ? w.z : w.w));
                                const float lo = __builtin_bit_cast(float, ww << 16), hi = __builtin_bit_cast(float, ww & 0xffff0000u); ssq += lo * lo + hi * hi; } } }
                    else { *(f32x4*)((float*)O + off + bj * HALF) = v0; *(f32x4*)((float*)O + off + bj * HALF + 4) = v1; }
                }
                if constexpr (PSUM) { ssq += __shfl_xor(ssq, 16); ssq += __shfl_xor(ssq, 32);
                    if (fq == 0) PS[(size_t)(row0 + ai * HALF + m * 16) * 16 + u.pn * 4 + wc] = ssq; } }
    }
};
struct EpiConvGate {
    static constexpr bool PERM = true, AFTER_DRAIN = false;
    bf16_t* Y; const float* wconv; float* CVH; float* BND;
    __device__ __forceinline__ void operator()(const f32x4 (&acc)[2][2][4][2], const Unit& u, int wr, int wc, int fr, int fq) const {
        const int ch0 = 64 * u.pn + 16 * wc + 4 * fq;
        const f32x4 w0 = *(const f32x4*)(wconv + ch0), w1 = *(const f32x4*)(wconv + 1024 + ch0), w2 = *(const f32x4*)(wconv + 2048 + ch0);
#pragma unroll
        for (int ai = 0; ai < 2; ++ai) {
            f32x4 p15 = (f32x4){0.f, 0.f, 0.f, 0.f}, p14 = (f32x4){0.f, 0.f, 0.f, 0.f};
#pragma unroll
            for (int m = 0; m < 4; ++m) {
                const int row = u.pm * BM + ai * HALF + wr * 64 + m * 16 + fr;
                const f32x4 b = acc[ai][0][m][0], c = acc[ai][0][m][1], v = acc[ai][1][m][0], z = acc[ai][1][m][1];
                const f32x4 cv = c * v;
                f32x4 y, n15, n14;
#pragma unroll
                for (int e = 0; e < 4; ++e) {
                    const float up1 = __shfl_up(cv[e], 1, 16), up2 = __shfl_up(cv[e], 2, 16);
                    const float cm1 = (fr >= 1) ? up1 : p15[e];
                    const float cm2 = (fr >= 2) ? up2 : ((fr == 1) ? p15[e] : p14[e]);
                    const float zz = z[e];
                    y[e] = b[e] * (w0[e] * cm2 + w1[e] * cm1 + w2[e] * cv[e]) * (zz / (1.f + __expf(-zz)));
                    n15[e] = __shfl(cv[e], 15, 16); n14[e] = __shfl(cv[e], 14, 16);
                }
                p15 = n15; p14 = n14;
                if (m > 0 || fr >= 2) {
                    unsigned long long o = (unsigned long long)cvt_pk_bf16(y[0], y[1]) | ((unsigned long long)cvt_pk_bf16(y[2], y[3]) << 32);
                    *(unsigned long long*)(Y + (size_t)row * 1024 + ch0) = o;
                } else {
                    float* bp = BND + ((size_t)(row >> 6) * 2 + fr) * 3 * 1024 + ch0;
                    *(f32x4*)bp = b; *(f32x4*)(bp + 1024) = z; *(f32x4*)(bp + 2048) = cv;
                }
                if (m == 3 && fr >= 14) *(f32x4*)(CVH + ((size_t)(row >> 6) * 2 + (fr - 14)) * 1024 + ch0) = cv;
            }
        }
    }
};
struct EpiStoreScaled {
    static constexpr bool PERM = true, AFTER_DRAIN = false;
    bf16_t* O; int ldc; const float* PS;
    __device__ __forceinline__ void operator()(const f32x4 (&acc)[2][2][4][2], const Unit& u, int wr, int wc, int fr, int fq) const {
        const int row0 = u.pm * BM + wr * 64 + fr; const int col0 = u.pn * BM + wc * 32 + 8 * fq;
#pragma unroll
        for (int ai = 0; ai < 2; ++ai)
#pragma unroll
            for (int m = 0; m < 4; ++m) { const int row = row0 + ai * HALF + m * 16; bf16_t* rowp = O + (size_t)row * ldc + col0;
                const f32x4* pp = (const f32x4*)(PS + (size_t)row * 16);
                const f32x4 s4 = (pp[0] + pp[1]) + (pp[2] + pp[3]);
                const float r = rsqrtf(((s4[0] + s4[1]) + (s4[2] + s4[3])) * (1.f / 1024.f) + 1e-6f);
#pragma unroll
                for (int bj = 0; bj < 2; ++bj) { const f32x4 v0 = acc[ai][bj][m][0] * r, v1 = acc[ai][bj][m][1] * r;
                    u32x4 w; w.x = cvt_pk_bf16(v0[0], v0[1]); w.y = cvt_pk_bf16(v0[2], v0[3]); w.z = cvt_pk_bf16(v1[0], v1[1]); w.w = cvt_pk_bf16(v1[2], v1[3]);
                    *(u32x4*)(rowp + bj * HALF) = w; } }
    }
};
template <class Epi, class Sched, bool ALIGN_EPI = false, bool SP2 = false>
__device__ __forceinline__ void gemm_phase(PG8_LAS unsigned char* lds, const Gemm g, const Sched& S, const Epi& E) {
    int tid_l = threadIdx.x; asm volatile("" : "+v"(tid_l));
    const int tid = tid_l, wid = __builtin_amdgcn_readfirstlane(tid >> 6), lane = tid & 63, wr = wid >> 2, wc = wid & 3, fr = lane & 15, fq = lane >> 4;
    const int K = g.K, nt = K / BK;
    unsigned voffA[2], voffB[2];
#pragma unroll
    for (int i = 0; i < 2; ++i) { int R, C; stage_rc(tid * 16 + i * 8192, R, C); const int Rb = Epi::PERM ? ((R & ~31) + perm32(R & 31)) : R;
        voffA[i] = (unsigned)(R * K + C) * 2u; voffB[i] = (unsigned)(Rb * K + C) * 2u; }
    const size_t kstep = (size_t)(BK * 2);
    const size_t hstep = (size_t)HALF * K * 2;
    const size_t tstep = 2 * hstep;
    const unsigned ldsw = (unsigned)wid * 1024u;
    const int aoff = lds_byte(wr * 64 + fr, fq * 8), boff = lds_byte(wc * 32 + fr, fq * 8);
#define PG8_SA(b, h) (((b) * 2 + (h)) * HTB)
#define PG8_SB(b, h) ((4 + (b) * 2 + (h)) * HTB)
#define PG8_STAGE(bufoff, gbase, voff) do { _Pragma("unroll") for (int _i = 0; _i < 2; ++_i) \
        __builtin_amdgcn_global_load_lds((const unsigned*)((const char*)(gbase) + (voff)[_i]), (PG8_LAS unsigned*)(lds + (bufoff) + ldsw + _i * 8192), 16, 0, 0); } while (0)
#define PG8_LDA(dst, b, h) do { _Pragma("unroll") for (int m = 0; m < 4; ++m) _Pragma("unroll") for (int k = 0; k < 2; ++k) dst[m][k] = *(const PG8_LAS bf16x8*)(lds + PG8_SA(b, h) + aoff + m * 2048 + k * 1024); } while (0)
#define PG8_LDB(dst, b, h) do { _Pragma("unroll") for (int n = 0; n < 2; ++n) _Pragma("unroll") for (int k = 0; k < 2; ++k) dst[n][k] = *(const PG8_LAS bf16x8*)(lds + PG8_SB(b, h) + boff + n * 2048 + k * 1024); } while (0)
#define PG8_MMA(ai, bj, At, Bt) do { __builtin_amdgcn_s_setprio(1); _Pragma("unroll") for (int m = 0; m < 4; ++m) _Pragma("unroll") for (int n = 0; n < 2; ++n) _Pragma("unroll") for (int k = 0; k < 2; ++k) \
        acc[ai][bj][m][n] = __builtin_amdgcn_mfma_f32_16x16x32_bf16(Bt[n][k], At[m][k], acc[ai][bj][m][n], 0, 0, 0); __builtin_amdgcn_s_setprio(0); } while (0)
#define PG8_WAIT_V(n) asm volatile("s_waitcnt vmcnt(" #n ")" ::: "memory")
#define PG8_WAIT_L(n) asm volatile("s_waitcnt lgkmcnt(" #n ")" ::: "memory")
#define PG8_BAR __builtin_amdgcn_s_barrier()
#define PG8_SCHED __builtin_amdgcn_sched_barrier(0)
    Unit cur, nxt; int ui = 0;
    if (!S.next(0, cur)) return;
    f32x4 acc[2][2][4][2];
#pragma unroll
    for (int a = 0; a < 2; ++a)
#pragma unroll
        for (int b = 0; b < 2; ++b)
#pragma unroll
            for (int m = 0; m < 4; ++m)
#pragma unroll
                for (int n = 0; n < 2; ++n) acc[a][b][m][n] = (f32x4){0.f, 0.f, 0.f, 0.f};
    bf16x8 At[4][2], B0[2][2], B1[2][2];
    const char* cA = (const char*)g.A + (size_t)cur.pm * tstep; const char* cB = (const char*)g.Bt + (size_t)cur.pn * tstep;
    S.a_ready(cur);
    if constexpr (SP2) {
        PG8_STAGE(PG8_SB(0, 0), cB, voffB); PG8_STAGE(PG8_SB(0, 1), cB + hstep, voffB); PG8_STAGE(PG8_SA(0, 0), cA, voffA); PG8_STAGE(PG8_SA(0, 1), cA + hstep, voffA);
        if (wr == 1) PG8_BAR;
        PG8_WAIT_V(2); PG8_BAR;
        PG8_STAGE(PG8_SB(1, 0), cB + kstep, voffB); PG8_STAGE(PG8_SA(1, 0), cA + kstep, voffA); PG8_STAGE(PG8_SB(1, 1), cB + hstep + kstep, voffB);
        PG8_WAIT_V(6); PG8_BAR;
    } else {
        PG8_STAGE(PG8_SB(0, 0), cB, voffB); PG8_STAGE(PG8_SA(0, 0), cA, voffA); PG8_STAGE(PG8_SB(0, 1), cB + hstep, voffB); PG8_STAGE(PG8_SA(0, 1), cA + hstep, voffA);
        if (wr == 1) PG8_BAR;
        PG8_WAIT_V(4); PG8_BAR;
        PG8_STAGE(PG8_SB(1, 0), cB + kstep, voffB); PG8_STAGE(PG8_SA(1, 0), cA + kstep, voffA); PG8_STAGE(PG8_SB(1, 1), cB + hstep + kstep, voffB);
        PG8_WAIT_V(6); PG8_BAR;
    }
    for (;;) {
        const bool has_next = S.next(ui + 1, nxt);
        const char* nA = has_next ? (const char*)g.A + (size_t)nxt.pm * tstep : cA; const char* nB = has_next ? (const char*)g.Bt + (size_t)nxt.pn * tstep : cB;
        for (int t = 0; t < nt; t += 2) {
            const bool last = (t == nt - 2);
            const char* a1 = cA + (size_t)(t + 1) * kstep;
            const char* a2 = last ? nA : cA + (size_t)(t + 2) * kstep; const char* b2 = last ? nB : cB + (size_t)(t + 2) * kstep;
            const char* a3 = a2 + kstep; const char* b3 = b2 + kstep;
            if (last && has_next) S.a_ready(nxt);
            if constexpr (SP2) {
            PG8_LDB(B0, 0, 0); PG8_LDB(B1, 0, 1); PG8_SCHED; PG8_LDA(At, 0, 0); PG8_STAGE(PG8_SA(1, 1), a1 + hstep, voffA);
            PG8_WAIT_V(8); PG8_WAIT_L(0); PG8_BAR; PG8_MMA(0, 0, At, B0); PG8_MMA(0, 1, At, B1); PG8_BAR; PG8_SCHED;
            PG8_LDA(At, 0, 1); PG8_STAGE(PG8_SB(0, 0), b2, voffB); PG8_STAGE(PG8_SB(0, 1), b2 + hstep, voffB); PG8_STAGE(PG8_SA(0, 0), a2, voffA);
            PG8_WAIT_V(8); PG8_WAIT_L(0); PG8_BAR; PG8_MMA(1, 0, At, B0); PG8_MMA(1, 1, At, B1); PG8_BAR; PG8_SCHED;
            PG8_LDB(B0, 1, 0); PG8_LDB(B1, 1, 1); PG8_SCHED; PG8_LDA(At, 1, 0); PG8_STAGE(PG8_SA(0, 1), a2 + hstep, voffA);
            PG8_WAIT_V(8); PG8_WAIT_L(0); PG8_BAR; PG8_MMA(0, 0, At, B0); PG8_MMA(0, 1, At, B1); PG8_BAR; PG8_SCHED;
            PG8_LDA(At, 1, 1); PG8_STAGE(PG8_SB(1, 0), b3, voffB); PG8_STAGE(PG8_SB(1, 1), b3 + hstep, voffB); PG8_STAGE(PG8_SA(1, 0), a3, voffA);
            PG8_WAIT_V(8); PG8_WAIT_L(0); PG8_BAR; PG8_MMA(1, 0, At, B0); PG8_MMA(1, 1, At, B1); PG8_BAR; PG8_SCHED;
            } else {
            PG8_LDB(B0, 0, 0); PG8_SCHED; PG8_LDA(At, 0, 0); PG8_STAGE(PG8_SA(1, 1), a1 + hstep, voffA);
            PG8_WAIT_L(8); PG8_BAR; PG8_WAIT_L(0); PG8_MMA(0, 0, At, B0); PG8_BAR; PG8_SCHED;
            PG8_LDB(B1, 0, 1); PG8_STAGE(PG8_SB(0, 0), b2, voffB);
            PG8_BAR; PG8_WAIT_L(0); PG8_MMA(0, 1, At, B1); PG8_BAR;
            PG8_LDA(At, 0, 1); PG8_STAGE(PG8_SA(0, 0), a2, voffA);
            PG8_BAR; PG8_WAIT_L(0); PG8_MMA(1, 0, At, B0); PG8_BAR; PG8_SCHED;
            PG8_STAGE(PG8_SB(0, 1), b2 + hstep, voffB);
            PG8_WAIT_V(6); PG8_BAR; PG8_MMA(1, 1, At, B1); PG8_BAR;
            PG8_LDB(B0, 1, 0); PG8_SCHED; PG8_LDA(At, 1, 0); PG8_STAGE(PG8_SA(0, 1), a2 + hstep, voffA);
            PG8_WAIT_L(8); PG8_BAR; PG8_WAIT_L(0); PG8_MMA(0, 0, At, B0); PG8_BAR; PG8_SCHED;
            PG8_LDB(B1, 1, 1); PG8_STAGE(PG8_SB(1, 0), b3, voffB);
            PG8_BAR; PG8_WAIT_L(0); PG8_MMA(0, 1, At, B1); PG8_BAR;
            PG8_LDA(At, 1, 1); PG8_STAGE(PG8_SA(1, 0), a3, voffA);
            PG8_BAR; PG8_WAIT_L(0); PG8_MMA(1, 0, At, B0); PG8_BAR; PG8_SCHED;
            PG8_STAGE(PG8_SB(1, 1), b3 + hstep, voffB);
            PG8_WAIT_V(6); PG8_BAR; PG8_MMA(1, 1, At, B1); PG8_BAR;
            }
        }
        if constexpr (ALIGN_EPI) { if (wr == 0) PG8_BAR; }
        if constexpr (!Epi::AFTER_DRAIN) { E(acc, cur, wr, wc, fr, fq); S.done(cur); }
        if (!has_next) break;
#pragma unroll
        for (int a = 0; a < 2; ++a)
#pragma unroll
            for (int b = 0; b < 2; ++b)
#pragma unroll
                for (int m = 0; m < 4; ++m)
#pragma unroll
                    for (int n = 0; n < 2; ++n) acc[a][b][m][n] = (f32x4){0.f, 0.f, 0.f, 0.f};
        cur = nxt; cA = nA; cB = nB; ++ui;
        if constexpr (ALIGN_EPI) { if (wr == 1) PG8_BAR; }
    }
    PG8_WAIT_V(0);
    if constexpr (!ALIGN_EPI) { if (wr == 0) PG8_BAR; }
    PG8_BAR;
    if constexpr (Epi::AFTER_DRAIN) { E.fused(acc, cur, wr, wc, fr, fq, lds, wid, lane); S.done(cur); }
#undef PG8_SA
#undef PG8_SB
#undef PG8_STAGE
#undef PG8_LDA
#undef PG8_LDB
#undef PG8_MMA
#undef PG8_WAIT_V
#undef PG8_WAIT_L
#undef PG8_BAR
#undef PG8_SCHED
}
}
#define XB_TMO      128
#define XB_XCNT(j)  (256  + 64 * (j))
#define XB_XSUB(j)  (1280 + 64 * (j))
#define XB_XGEN(j)  (2304 + 64 * (j))
#define XB_TOP      3328
#define XB_TOPGEN   3392
#define XCD_BAR_WORDS 3456
#define XB_SPIN_CAP (1u << 18)

__device__ __forceinline__ unsigned xb_ld(unsigned* p)              { return __hip_atomic_load(p, __ATOMIC_RELAXED, __HIP_MEMORY_SCOPE_AGENT); }
__device__ __forceinline__ unsigned xb_add(unsigned* p, unsigned v) { return __hip_atomic_fetch_add(p, v, __ATOMIC_RELAXED, __HIP_MEMORY_SCOPE_AGENT); }
__device__ __forceinline__ unsigned xb_xcc_id() { return (unsigned)__builtin_amdgcn_s_getreg((3 << 11) | 20) & 0xFu; }
#define XB_SPIN(cond, bar) do { unsigned _sp = 0; while (cond) { __builtin_amdgcn_s_sleep(1); \
    if ((++_sp & 255u) == 0u) { if (xb_ld(&(bar)[XB_TMO])) break; if (_sp > XB_SPIN_CAP) { atomicAdd(&(bar)[XB_TMO], 1u); break; } } } } while (0)

struct XcdBarrier {
    unsigned* bar; unsigned x;
    volatile LAS unsigned* st;
};

__device__ __forceinline__ XcdBarrier xcd_barrier_post(unsigned* bar, volatile LAS unsigned* st) {
    XcdBarrier b; b.bar = bar; b.x = xb_xcc_id(); b.st = st;
    if (threadIdx.x == 0) (void)xb_add(&bar[XB_XCNT(b.x)], 1u);
    return b;
}
__device__ __forceinline__ void xcd_barrier_complete(unsigned* bar, unsigned x, unsigned& nloc, unsigned& nx) {
    const unsigned G = gridDim.x * gridDim.y * gridDim.z;
    unsigned sum, cnt, mine, sp = 0u;
    for (;;) {
        sum = 0u; cnt = 0u; mine = 0u;
#pragma unroll
        for (unsigned j = 0; j < 16; ++j) { const unsigned c = xb_ld(&bar[XB_XCNT(j)]); sum += c; cnt += (c > 0u) ? 1u : 0u; mine = (j == x) ? c : mine; }
        if (sum == G) break;
        __builtin_amdgcn_s_sleep(1);
        if ((++sp & 255u) == 0u) { if (xb_ld(&bar[XB_TMO])) break; if (sp > XB_SPIN_CAP) { atomicAdd(&bar[XB_TMO], 1u); break; } }
    }
    nloc = mine > 0u ? mine : 1u; nx = cnt > 0u ? cnt : 1u;
}

__device__ __forceinline__ void xcd_barrier(const XcdBarrier& b) {
    asm volatile("s_waitcnt vmcnt(0)" ::: "memory");
    __syncthreads();
    if (threadIdx.x == 0) {
        unsigned* bar = b.bar;
        __builtin_amdgcn_s_waitcnt(0);
        unsigned nloc = b.st[0], nx = b.st[1];
        if (nloc == 0u) { xcd_barrier_complete(bar, b.x, nloc, nx); b.st[0] = nloc; b.st[1] = nx; }
        const unsigned old = xb_add(&bar[XB_XSUB(b.x)], 1u);
        const unsigned gen = old / nloc;
        if (old + 1u == (gen + 1u) * nloc) {
            __builtin_amdgcn_fence(__ATOMIC_RELEASE, "agent");
            asm volatile("s_waitcnt vmcnt(0)" ::: "memory");
            const unsigned og = xb_add(&bar[XB_TOP], 1u);
            const unsigned tg = og / nx;
            if (og + 1u == (tg + 1u) * nx) xb_add(&bar[XB_TOPGEN], 1u);
            else XB_SPIN(xb_ld(&bar[XB_TOPGEN]) == tg, bar);
            __builtin_amdgcn_fence(__ATOMIC_ACQUIRE, "agent");
            xb_add(&bar[XB_XGEN(b.x)], 1u);
            asm volatile("s_waitcnt vmcnt(0)" ::: "memory");
        } else {
            XB_SPIN(xb_ld(&bar[XB_XGEN(b.x)]) == gen, bar);
            __builtin_amdgcn_fence(__ATOMIC_ACQUIRE, "agent");
            asm volatile("s_waitcnt vmcnt(0)" ::: "memory");
        }
    }
    __syncthreads();
}

template <bool CONVPERM = false>
DI void p0_transpose_item(const float* W, int K, int ldw, int ncols, bf16* WT, LAS float* scr, int item, int lane, const float* rowscale = nullptr) {
    const int nblk = ncols / 32, kb = item / nblk, nb = item % nblk, k0 = 64 * kb, n0 = 32 * nb;
#pragma unroll 8
    for (int i = 0; i < 32; ++i) { const int kk = 2 * i + (lane >> 5); float wv = W[(size_t)(k0 + kk) * ldw + n0 + (lane & 31)]; if (rowscale != nullptr) wv *= rowscale[k0 + kk];
        scr[kk * 33 + (lane & 31)] = wv; }
    asm volatile("s_waitcnt lgkmcnt(0)" ::: "memory");
    const int c = lane & 7;
#pragma unroll
    for (int j = 0; j < 4; ++j) { const int n = (lane >> 3) + 8 * j; const LAS float* s = scr + (8 * c) * 33 + n;
        v4u o; o.x = pk2(s[0 * 33], s[1 * 33]); o.y = pk2(s[2 * 33], s[3 * 33]); o.z = pk2(s[4 * 33], s[5 * 33]); o.w = pk2(s[6 * 33], s[7 * 33]);
        int orow = n0 + n;
        if constexpr (CONVPERM) { const int sct = orow >> 10, ch = orow & 1023;
            orow = 256 * (ch >> 6) + 128 * (sct >> 1) + 32 * ((ch >> 4) & 3) + 8 * ((ch >> 2) & 3) + 4 * (sct & 1) + (ch & 3); }
        *(v4u*)(WT + (size_t)orow * K + k0 + 8 * c) = o; }
    asm volatile("s_waitcnt lgkmcnt(0)" ::: "memory");
}

struct Ptrs {
    const float* in[19]; float* out; unsigned char* ws; int ph_lo, ph_hi;
};

DI void p0_prologue(const Ptrs& P, LAS unsigned char* lds, int gw, int NGW, int wave, int lane) {
    LAS float* scr = (LAS float*)(lds + wave * 16384);
    unsigned char* ws = P.ws;
    constexpr int I_IN = 16 * 128, I_OUT = 16 * 32, I_SWA = 16 * 80;
    constexpr int NIT = 3 * I_IN + I_SWA + 4 * I_OUT;
    for (int it = gw; it < NIT; it += NGW) {
        int r = it;
        if (r < I_IN) { p0_transpose_item<true>(P.in[4], 1024, 4096, 4096, (bf16*)(ws + WS_W0I), scr, r, lane); continue; } r -= I_IN;
        if (r < I_IN) { p0_transpose_item(P.in[7], 1024, 4104, 4096, (bf16*)(ws + WS_W1I), scr, r, lane); continue; } r -= I_IN;
        if (r < I_IN) { p0_transpose_item(P.in[10], 1024, 4112, 4096, (bf16*)(ws + WS_W2I), scr, r, lane); continue; } r -= I_IN;
        if (r < I_SWA) { p0_transpose_item(P.in[16], 1024, 2560, 2560, (bf16*)(ws + WS_W3I), scr, r, lane, P.in[2] + 3072); continue; } r -= I_SWA;
        if (r < I_OUT) { p0_transpose_item(P.in[6], 1024, 1024, 1024, (bf16*)(ws + WS_W0O), scr, r, lane); continue; } r -= I_OUT;
        if (r < I_OUT) { p0_transpose_item(P.in[9], 1024, 1024, 1024, (bf16*)(ws + WS_W1O), scr, r, lane); continue; } r -= I_OUT;
        if (r < I_OUT) { p0_transpose_item(P.in[15], 1024, 1024, 1024, (bf16*)(ws + WS_W2O), scr, r, lane); continue; } r -= I_OUT;
        p0_transpose_item(P.in[18], 1024, 1024, 1024, (bf16*)(ws + WS_W3O), scr, r, lane);
    }
}

template <int MODE, bool XBF = false>
DI void norm_phase(const float* X, const float* nw, bf16* H, float* OUTF, const float* W, int ldw, float* oa, float* ob, const float* p0, const float* p1, const float* p2,
                   const int* pos, LAS unsigned char* lds, int gw, int NGW, int tid, int lane) {
    constexpr int NT = (MODE == 1) ? 8 : (MODE == 2 ? 16 : 0);
    LAS f32x4* thin = (LAS f32x4*)lds;
    if constexpr (NT > 0) {
        for (int i = tid; i < 1024 * (NT / 4); i += NTHR) { const int k = i / (NT / 4), c4 = i % (NT / 4);
            const f32x4 v = *(const f32x4*)(W + (size_t)k * ldw + 4096 + 4 * c4);
            const int j = k >> 8, l = (k & 255) >> 2, e = k & 3;
            thin[c4 * 1024 + (j * 4 + e) * 64 + l] = v; }
        __syncthreads();
    }
    constexpr int NR = (NT == 16) ? 2 : 4;
    f32x4 nwv[4];
#pragma unroll
    for (int j = 0; j < 4; ++j) nwv[j] = *((const f32x4*)nw + lane + 64 * j);
    for (int row0 = gw * NR; row0 < TT; row0 += NGW * NR) {
        f32x4 vv[NR][4];
#pragma unroll
        for (int rr = 0; rr < NR; ++rr) {
            if constexpr (XBF) { const v2u* xr = (const v2u*)((const bf16*)X + (size_t)(row0 + rr) * DM) + lane;
#pragma unroll
                for (int j = 0; j < 4; ++j) { const v2u u = xr[64 * j]; vv[rr][j] = (f32x4){bflo(u.x), bfhi(u.x), bflo(u.y), bfhi(u.y)}; } }
            else { const f32x4* xr = (const f32x4*)(X + (size_t)(row0 + rr) * DM) + lane;
#pragma unroll
                for (int j = 0; j < 4; ++j) vv[rr][j] = xr[64 * j]; } }
#pragma unroll
        for (int rr = 0; rr < NR; ++rr) {
        const int row = row0 + rr;
        f32x4 v[4]; float s = 0.f;
#pragma unroll
        for (int j = 0; j < 4; ++j) { v[j] = vv[rr][j]; s += (v[j].x * v[j].x + v[j].y * v[j].y) + (v[j].z * v[j].z + v[j].w * v[j].w); }
        const float r = rsqrtf(wave_sum(s) * (1.f / DM) + EPS);
#pragma unroll
        for (int j = 0; j < 4; ++j) { v[j] = v[j] * r * nwv[j]; vv[rr][j] = v[j]; }
        if constexpr (MODE == 4) {
            f32x4* o = (f32x4*)(OUTF + (size_t)row * DM) + lane;
#pragma unroll
            for (int j = 0; j < 4; ++j) o[64 * j] = v[j];
        } else {
            unsigned long long* o8 = (unsigned long long*)(H + (size_t)row * DM) + lane;
#pragma unroll
            for (int j = 0; j < 4; ++j) o8[64 * j] = (unsigned long long)pk2(v[j].x, v[j].y) | ((unsigned long long)pk2(v[j].z, v[j].w) << 32);
        }
        if constexpr (MODE == 3) {
            if (lane < 32) { const float inv = powf(10000.f, -(float)lane * (1.f / 32.f)); const float ang = (float)pos[row] * inv; float sn, cs; sincosf(ang, &sn, &cs);
                oa[(size_t)row * 64 + lane] = cs; oa[(size_t)row * 64 + 32 + lane] = sn; }
        }
        }
        if constexpr (NT > 0) {
            constexpr int RG = (NT == 16) ? 1 : NR;
#pragma unroll
            for (int r0 = 0; r0 < NR; r0 += RG) {
            f32x4 a[RG][NT / 4];
#pragma unroll
            for (int rr = 0; rr < RG; ++rr)
#pragma unroll
                for (int c = 0; c < NT / 4; ++c) a[rr][c] = (f32x4){0.f, 0.f, 0.f, 0.f};
#pragma unroll
            for (int j = 0; j < 4; ++j)
#pragma unroll
                for (int e = 0; e < 4; ++e) {
#pragma unroll
                    for (int c = 0; c < NT / 4; ++c) { const f32x4 w = thin[c * 1024 + (j * 4 + e) * 64 + lane];
#pragma unroll
                        for (int rr = 0; rr < RG; ++rr) a[rr][c] += w * vv[r0 + rr][j][e]; }
                    __builtin_amdgcn_sched_barrier(0); }
#pragma unroll
            for (int rr = 0; rr < RG; ++rr) {
                const int row = row0 + r0 + rr;
                float t8[NT / 2];
#pragma unroll
                for (int i = 0; i < NT / 2; ++i) { const float x0 = a[rr][(2 * i) >> 2][(2 * i) & 3], x1 = a[rr][(2 * i + 1) >> 2][(2 * i + 1) & 3];
                    const bool bb = lane & 1; const float mine = bb ? x1 : x0, send = bb ? x0 : x1; t8[i] = mine + __shfl_xor(send, 1); }
                float t4[NT / 4];
#pragma unroll
                for (int i = 0; i < NT / 4; ++i) { const bool bb = lane & 2; const float mine = bb ? t8[2 * i + 1] : t8[2 * i], send = bb ? t8[2 * i] : t8[2 * i + 1]; t4[i] = mine + __shfl_xor(send, 2); }
                float t2[NT / 8];
#pragma unroll
                for (int i = 0; i < NT / 8; ++i) { const bool bb = lane & 4; const float mine = bb ? t4[2 * i + 1] : t4[2 * i], send = bb ? t4[2 * i] : t4[2 * i + 1]; t2[i] = mine + __shfl_xor(send, 4); }
                float tc;
                if constexpr (NT == 16) { const bool bb = lane & 8; const float mine = bb ? t2[1] : t2[0], send = bb ? t2[0] : t2[1]; tc = mine + __shfl_xor(send, 8); }
                else { tc = t2[0]; tc += __shfl_xor(tc, 8); }
                tc += __shfl_xor(tc, 16); tc += __shfl_xor(tc, 32);
                if constexpr (MODE == 1) {
                    if (lane < 8) { const float xx = tc + p0[lane]; oa[(size_t)row * 8 + lane] = fminf(xx, 0.f) - log1pf(__expf(-fabsf(xx))); }
                } else {
                    const float ma = __shfl(tc, (lane + 8) & 63);
                    if (lane < 8) { oa[(size_t)row * 8 + lane] = 1.f / (1.f + __expf(-tc));
                        ob[(size_t)row * 8 + lane] = -__expf(p0[lane]) * softplus_f(ma + p1[lane]); }
                }
            }
            }
        }
    }
    if constexpr (NT > 0) __syncthreads();
}

DI void convgate_phase(const bf16* PROJ, const float* wconv, bf16* Y, int gtid, int NG) {
    for (int it = gtid; it < (TT / 32) * 128; it += NG) {
        const int oct = it & 127, chunk = it >> 7, r0 = chunk * 32, c0 = oct * 8;
        float w0[8], w1[8], w2[8];
#pragma unroll
        for (int e = 0; e < 8; ++e) { w0[e] = wconv[c0 + e]; w1[e] = wconv[1024 + c0 + e]; w2[e] = wconv[2048 + c0 + e]; }
        float p2[8], p1[8];
#pragma unroll
        for (int e = 0; e < 8; ++e) { p2[e] = 0.f; p1[e] = 0.f; }
        if ((r0 & (SEQ - 1)) != 0) {
#pragma unroll
            for (int d = 2; d >= 1; --d) { const bf16* rp = PROJ + (size_t)(r0 - d) * 4096 + c0;
                const v4u cc = *(const v4u*)(rp + 1024), vv = *(const v4u*)(rp + 2048);
#pragma unroll
                for (int e = 0; e < 4; ++e) { const float a = bflo(cc[e]) * bflo(vv[e]), b = bfhi(cc[e]) * bfhi(vv[e]);
                    if (d == 2) { p2[2 * e] = a; p2[2 * e + 1] = b; } else { p1[2 * e] = a; p1[2 * e + 1] = b; } } }
        }
#pragma unroll 4
        for (int r = 0; r < 32; ++r) {
            const bf16* rp = PROJ + (size_t)(r0 + r) * 4096 + c0;
            const v4u bb = *(const v4u*)(rp), cc = *(const v4u*)(rp + 1024), vv = *(const v4u*)(rp + 2048), zz = *(const v4u*)(rp + 3072);
            float y[8];
#pragma unroll
            for (int e = 0; e < 4; ++e) {
                const float cv0 = bflo(cc[e]) * bflo(vv[e]), cv1 = bfhi(cc[e]) * bfhi(vv[e]);
                const float o0 = w0[2 * e] * p2[2 * e] + w1[2 * e] * p1[2 * e] + w2[2 * e] * cv0;
                const float o1 = w0[2 * e + 1] * p2[2 * e + 1] + w1[2 * e + 1] * p1[2 * e + 1] + w2[2 * e + 1] * cv1;
                p2[2 * e] = p1[2 * e]; p1[2 * e] = cv0; p2[2 * e + 1] = p1[2 * e + 1]; p1[2 * e + 1] = cv1;
                y[2 * e] = bflo(bb[e]) * o0 * silu_f(bflo(zz[e])); y[2 * e + 1] = bfhi(bb[e]) * o1 * silu_f(bfhi(zz[e]));
            }
            v4u o; o.x = pk2(y[0], y[1]); o.y = pk2(y[2], y[3]); o.z = pk2(y[4], y[5]); o.w = pk2(y[6], y[7]);
            *(v4u*)(Y + (size_t)(r0 + r) * 1024 + c0) = o;
        }
    }
}

DI void convfix_phase(const float* CVH, const float* BND, const float* wconv, bf16* Y, int gtid, int NG) {
    for (int it = gtid; it < 512 * 2 * 256; it += NG) {
        const int c4 = it & 255, r = (it >> 8) & 1, g = it >> 9, ch0 = 4 * c4;
        const float* bp = BND + ((size_t)g * 2 + r) * 3 * 1024 + ch0;
        const f32x4 b = *(const f32x4*)bp, z = *(const f32x4*)(bp + 1024), cv = *(const f32x4*)(bp + 2048);
        f32x4 cm1 = (f32x4){0.f, 0.f, 0.f, 0.f}, cm2 = (f32x4){0.f, 0.f, 0.f, 0.f};
        const bool first = (g & 255) == 0;
        if (r == 0) { if (!first) { cm1 = *(const f32x4*)(CVH + ((size_t)(g - 1) * 2 + 1) * 1024 + ch0); cm2 = *(const f32x4*)(CVH + ((size_t)(g - 1) * 2) * 1024 + ch0); } }
        else { cm1 = *(const f32x4*)(BND + ((size_t)g * 2) * 3 * 1024 + 2048 + ch0); if (!first) cm2 = *(const f32x4*)(CVH + ((size_t)(g - 1) * 2 + 1) * 1024 + ch0); }
        const f32x4 w0 = *(const f32x4*)(wconv + ch0), w1 = *(const f32x4*)(wconv + 1024 + ch0), w2 = *(const f32x4*)(wconv + 2048 + ch0);
        float y[4];
#pragma unroll
        for (int e = 0; e < 4; ++e) y[e] = b[e] * (w0[e] * cm2[e] + w1[e] * cm1[e] + w2[e] * cv[e]) * silu_f(z[e]);
        v2u o; o.x = pk2(y[0], y[1]); o.y = pk2(y[2], y[3]);
        *(v2u*)(Y + ((size_t)g * 64 + r) * 1024 + ch0) = o;
    }
}
DI int crow32(int i, int hi) { return (i & 3) + 8 * (i >> 2) + 4 * hi; }
DI int perm16(int p) { return (p & 3) | ((p & 4) << 1) | ((p & 8) >> 1); }
#define MFMA32(a, b, c) __builtin_amdgcn_mfma_f32_32x32x16_bf16((a), (b), (c), 0, 0, 0)
#define MFMA16(a, b, c) __builtin_amdgcn_mfma_f32_16x16x32_bf16((a), (b), (c), 0, 0, 0)

DI void fox_cumsum(const float* LOGF, float* CUM, int bh, LAS unsigned char* lds, int tid) {
    LAS double* tot = (LAS double*)lds;
    const int b = bh >> 3, h = bh & 7;
    const float* src = LOGF + ((size_t)b * SEQ + 32 * tid) * 8 + h;
    float v[32]; double s = 0.0;
#pragma unroll
    for (int i = 0; i < 32; ++i) { v[i] = src[i * 8]; s += (double)v[i]; }
    double inc = s;
    const int ln = tid & 63, wv = tid >> 6;
#pragma unroll
    for (int o = 1; o < 64; o <<= 1) { const double t = __shfl_up(inc, o); if (ln >= o) inc += t; }
    if (ln == 63) tot[wv] = inc;
    __syncthreads();
    double pre = inc - s;
    for (int i = 0; i < wv; ++i) pre += tot[i];
    float* dst = CUM + (size_t)bh * SEQ + 32 * tid;
#pragma unroll
    for (int i = 0; i < 32; ++i) { pre += (double)v[i]; dst[i] = (float)pre; }
    __syncthreads();
}

DI void fox_norms_phase(const bf16* PROJ, float* NRMT, int gw, int NGW, int lane) {
    for (int it = gw; it < 16 * 256; it += NGW) {
        const int bh = it >> 8, tl = it & 255, b = bh >> 3, h = bh & 7;
        const size_t r0 = (size_t)b * SEQ + 64 * tl;
        float mk = 0.f;
#pragma unroll
        for (int rr = 0; rr < 8; ++rr) {
            const int row = 8 * rr + (lane >> 3), seg = lane & 7; const bf16* qp = PROJ + (r0 + row) * 4096 + h * 128 + 16 * seg;
            const v4u b0 = *(const v4u*)(qp + 1024), b1 = *(const v4u*)(qp + 1032);
            float sk = 0.f;
#pragma unroll
            for (int e = 0; e < 4; ++e) sk += bflo(b0[e]) * bflo(b0[e]) + bfhi(b0[e]) * bfhi(b0[e]) + bflo(b1[e]) * bflo(b1[e]) + bfhi(b1[e]) * bfhi(b1[e]);
#pragma unroll
            for (int o = 1; o < 8; o <<= 1) sk += __shfl_xor(sk, o);
            mk = fmaxf(mk, sk);
        }
#pragma unroll
        for (int o = 8; o < 64; o <<= 1) mk = fmaxf(mk, __shfl_xor(mk, o));
        if (lane == 0) NRMT[(size_t)it * 2 + 1] = mk;
    }
}

constexpr int FX_KB = 64 * 272, FX_VB = 64 * 320;
typedef short v4i16_t __attribute__((ext_vector_type(4)));
DI v4i16_t fx_vtr(const LAS unsigned char* p) { return __builtin_amdgcn_ds_read_tr16_b64_v4i16((LAS v4i16_t*)p); }
DI void fox_attn_phase(const bf16* PROJ, const float* CUM, bf16* Y, const float* NRMT, unsigned* QCTR, LAS unsigned char* lds, int bid, int G, int tid, int wave, int lane) {
    LAS unsigned char* Kb = lds; LAS unsigned char* Vb = lds + 2 * FX_KB; LAS float* Bs = (LAS float*)(lds + 2 * FX_KB + 2 * FX_VB);
    const int r = lane & 31, hi = lane >> 5;
    const float SQD = 11.313708498984761f;
    const float c2 = 0.08838834764831845f * 1.4426950408889634f;
    LAS unsigned* Qs = (LAS unsigned*)(lds + 2 * FX_KB + 2 * FX_VB + 512);
    LAS float* Mq = (LAS float*)(lds + 2 * FX_KB + 2 * FX_VB + 704);
    LAS float* Ms = (LAS float*)(lds + 2 * FX_KB + 2 * FX_VB + 576);
    for (;;) {
        if (tid == 0) Qs[0] = atomicAdd(QCTR, 1u);
        __syncthreads();
        const int e = (int)Qs[0];
        __syncthreads();
        if (e >= 1024) break;
        {
            const int bh = e & 15, qb = 63 - (e >> 4), b = bh >> 3, h = bh & 7;
            const int q0 = qb * 256, ntiles = 4 * (qb + 1);
            const float cref = CUM[(size_t)bh * SEQ + q0];
            const int qmin = q0 + 32 * wave;
            bf16x8 Qf[8];
            { const bf16* qp = PROJ + ((size_t)b * SEQ + qmin + r) * 4096 + h * 128 + 8 * hi;
#pragma unroll
              for (int ks = 0; ks < 8; ++ks) Qf[ks] = *(const bf16x8*)(qp + 16 * ks); }
            { float qn = 0.f;
#pragma unroll
              for (int ks = 0; ks < 8; ++ks) { const v4u w = __builtin_bit_cast(v4u, Qf[ks]);
#pragma unroll
                  for (int e = 0; e < 4; ++e) qn += bflo(w[e]) * bflo(w[e]) + bfhi(w[e]) * bfhi(w[e]); }
              qn += __shfl_xor(qn, 32);
#pragma unroll
              for (int o = 1; o < 32; o <<= 1) qn = fmaxf(qn, __shfl_xor(qn, o));
              if (lane == 0) Mq[wave] = qn; }
            __syncthreads();
            int jstart; float Bq;
            { float mq = Mq[0], mk = 0.f;
#pragma unroll
              for (int w = 1; w < 8; ++w) mq = fmaxf(mq, Mq[w]);
#pragma unroll
              for (int u = 0; u < 4; ++u) mk = fmaxf(mk, NRMT[((size_t)bh * 256 + lane + 64 * u) * 2 + 1]);
#pragma unroll
              for (int o = 1; o < 64; o <<= 1) mk = fmaxf(mk, __shfl_xor(mk, o));
              Bq = sqrtf(mq * mk);
              const float B2 = 2.f * Bq * 0.08838834764831845f;
              const float thr = -(30.f + B2);
              const int jc = (lane * (4 * qb)) >> 6;
              const bool live = (qb == 0) ? true : ((cref - CUM[(size_t)bh * SEQ + 64 * jc + 63]) > thr);
              const unsigned long long m = __ballot(live);
              const int fl = (m == 0ull) ? 64 : (__ffsll((long long)m) - 1);
              const int pl = fl > 0 ? fl - 1 : 0;
              jstart = (qb == 0) ? 0 : ((pl * (4 * qb)) >> 6);
              jstart = __builtin_amdgcn_readfirstlane(jstart); }
            f32x16 O[4];
#pragma unroll
            for (int dt = 0; dt < 4; ++dt)
#pragma unroll
                for (int i = 0; i < 16; ++i) O[dt][i] = 0.f;
            float m_old = -INFINITY, lsum = 0.f;
            const bf16* kg[2]; const bf16* vg[2]; int klds[2], vlds[2];
#pragma unroll
            for (int u = 0; u < 2; ++u) { const int p = tid + 512 * u;
                kg[u] = PROJ + ((size_t)b * SEQ + (p >> 4)) * 4096 + 1024 + h * 128 + 8 * (p & 15); klds[u] = (p >> 4) * 272 + (p & 15) * 16;
                vg[u] = PROJ + ((size_t)b * SEQ + (p >> 4)) * 4096 + 2048 + h * 128 + 8 * (p & 15); vlds[u] = (p >> 4) * 320 + (p & 15) * 16; }
            v4u kr[2], vr[2]; float br = 0.f;
            const int jlast = ntiles - 1;
#pragma unroll
            for (int u = 0; u < 2; ++u) { kr[u] = *(const v4u*)(kg[u] + (size_t)jlast * 64 * 4096); vr[u] = *(const v4u*)(vg[u] + (size_t)jlast * 64 * 4096); }
            if (tid < 64) br = (cref - CUM[(size_t)bh * SEQ + jlast * 64 + tid]) * SQD;
#pragma unroll
            for (int u = 0; u < 2; ++u) { *(LAS v4u*)(Kb + (jlast & 1) * FX_KB + klds[u]) = kr[u]; *(LAS v4u*)(Vb + (jlast & 1) * FX_VB + vlds[u]) = vr[u]; }
            if (tid < 64) Bs[(jlast & 1) * 64 + tid] = br;
            __syncthreads();
            for (int j = jlast; j >= jstart; --j) {
                const int cur = j & 1, nxt = cur ^ 1;
                if (j > jstart) {
#pragma unroll
                    for (int u = 0; u < 2; ++u) { kr[u] = *(const v4u*)(kg[u] + (size_t)(j - 1) * 64 * 4096); vr[u] = *(const v4u*)(vg[u] + (size_t)(j - 1) * 64 * 4096); }
                    if (tid < 64) br = (cref - CUM[(size_t)bh * SEQ + (j - 1) * 64 + tid]) * SQD;
                }
                if (64 * j <= qmin + 31) {
                    LAS unsigned char* Kc = Kb + cur * FX_KB; LAS unsigned char* Vc = Vb + cur * FX_VB; LAS float* Bc = Bs + cur * 64;
                    f32x16 S[2];
#pragma unroll
                    for (int sub = 0; sub < 2; ++sub) {
#pragma unroll
                        for (int g = 0; g < 4; ++g) { const f32x4 bv = *(const LAS f32x4*)(Bc + 32 * sub + 8 * g + 4 * hi);
                            S[sub][4 * g] = bv.x; S[sub][4 * g + 1] = bv.y; S[sub][4 * g + 2] = bv.z; S[sub][4 * g + 3] = bv.w; }
#pragma unroll
                        for (int ks = 0; ks < 8; ++ks) { const bf16x8 a = *(const LAS bf16x8*)(Kc + (32 * sub + r) * 272 + (16 * ks + 8 * hi) * 2);
                            S[sub] = MFMA32(a, Qf[ks], S[sub]); }
                    }
                    if (64 * j + 63 > qmin) {
                        const int qi = qmin + r;
#pragma unroll
                        for (int sub = 0; sub < 2; ++sub)
#pragma unroll
                            for (int i = 0; i < 16; ++i) { const int key = 64 * j + 32 * sub + crow32(i, hi); if (key > qi) S[sub][i] = -INFINITY; }
                    }
                    float mx = S[0][0];
#pragma unroll
                    for (int i = 1; i < 16; ++i) mx = fmaxf(mx, S[0][i]);
#pragma unroll
                    for (int i = 0; i < 16; ++i) mx = fmaxf(mx, S[1][i]);
                    mx = fmaxf(mx, __shfl_xor(mx, 32));
                    const float m_new = fmaxf(m_old, mx);
                    const float alpha = __builtin_amdgcn_exp2f((m_old - m_new) * c2);
                    const float nm = -m_new * c2;
                    m_old = m_new;
                    float ps = 0.f;
#pragma unroll
                    for (int sub = 0; sub < 2; ++sub)
#pragma unroll
                        for (int i = 0; i < 16; ++i) { const float p = __builtin_amdgcn_exp2f(fmaf(S[sub][i], c2, nm)); S[sub][i] = p; ps += p; }
                    lsum = lsum * alpha + ps;
                    if (!__all(alpha == 1.f)) {
#pragma unroll
                        for (int dt = 0; dt < 4; ++dt)
#pragma unroll
                            for (int i = 0; i < 16; ++i) O[dt][i] *= alpha;
                    }
                    bf16x8 Pf[4];
#pragma unroll
                    for (int kk = 0; kk < 4; ++kk) { const int sub = kk >> 1, s = kk & 1; v4u w;
                        w.x = pk2(S[sub][8 * s], S[sub][8 * s + 1]); w.y = pk2(S[sub][8 * s + 2], S[sub][8 * s + 3]);
                        w.z = pk2(S[sub][8 * s + 4], S[sub][8 * s + 5]); w.w = pk2(S[sub][8 * s + 6], S[sub][8 * s + 7]);
                        Pf[kk] = __builtin_bit_cast(bf16x8, w); }
#pragma unroll
                    for (int dt = 0; dt < 4; ++dt) {
#pragma unroll
                        for (int kk = 0; kk < 4; ++kk) {
                            const LAS unsigned char* vp = Vc + (16 * kk + 4 * hi + ((lane & 15) >> 2)) * 320 + 64 * dt + 32 * ((lane >> 4) & 1) + 8 * (lane & 3);
                            const v4i16_t lo = fx_vtr(vp), hi4 = fx_vtr(vp + 8 * 320);
                            const bf16x8 a = __builtin_shufflevector(lo, hi4, 0, 1, 2, 3, 4, 5, 6, 7);
                            O[dt] = MFMA32(a, Pf[kk], O[dt]); } }
                }
                { float mm = m_old;
#pragma unroll
                  for (int o = 1; o < 32; o <<= 1) mm = fminf(mm, __shfl_xor(mm, o));
                  if (lane == 0) Ms[cur * 8 + wave] = mm; }
                if (j > jstart) {
#pragma unroll
                    for (int u = 0; u < 2; ++u) { *(LAS v4u*)(Kb + nxt * FX_KB + klds[u]) = kr[u]; *(LAS v4u*)(Vb + nxt * FX_VB + vlds[u]) = vr[u]; }
                    if (tid < 64) Bs[nxt * 64 + tid] = br;
                }
                __syncthreads();
                if (j > jstart) { float mn = Ms[cur * 8];
#pragma unroll
                    for (int w = 1; w < 8; ++w) mn = fminf(mn, Ms[cur * 8 + w]);
                    if ((Bq + Bs[nxt * 64 + 63] - mn) * 0.08838834764831845f <= -30.f) break; }
            }
            const float lt = lsum + __shfl_xor(lsum, 32);
            const float inv = 1.f / lt;
            const size_t trow = (size_t)b * SEQ + qmin + r;
#pragma unroll
            for (int dt = 0; dt < 4; ++dt)
#pragma unroll
                for (int g = 0; g < 4; ++g) { const int d = 32 * dt + 8 * g + 4 * hi;
                    const v2u z = *(const v2u*)(PROJ + trow * 4096 + 3072 + h * 128 + d);
                    const float y0 = O[dt][4 * g] * inv * silu_f(bflo(z.x)), y1 = O[dt][4 * g + 1] * inv * silu_f(bfhi(z.x));
                    const float y2 = O[dt][4 * g + 2] * inv * silu_f(bflo(z.y)), y3 = O[dt][4 * g + 3] * inv * silu_f(bfhi(z.y));
                    v2u o; o.x = pk2(y0, y1); o.y = pk2(y2, y3);
                    *(v2u*)(Y + trow * 1024 + h * 128 + d) = o; }
        }
    }
}
DI constexpr int tq_slot(int f) { return f == 0 ? 0 : (f == 2 ? 1 : f - 2); }
DI int kperm(int s, int q, int jj) { return 32 * s + 16 * (jj >> 2) + 4 * q + (jj & 3); }
DI bf16x8 pack_acc2(const f32x4& X, const f32x4& Y) { v4u w; w.x = pk2(X[0], X[1]); w.y = pk2(X[2], X[3]); w.z = pk2(Y[0], Y[1]); w.w = pk2(Y[2], Y[3]); return __builtin_bit_cast(bf16x8, w); }

DI void st16_wt(void* p, v4u v) {
    __hip_atomic_store((unsigned long long*)p, (unsigned long long)v.x | ((unsigned long long)v.y << 32), __ATOMIC_RELAXED, __HIP_MEMORY_SCOPE_AGENT);
    __hip_atomic_store((unsigned long long*)p + 1, (unsigned long long)v.z | ((unsigned long long)v.w << 32), __ATOMIC_RELAXED, __HIP_MEMORY_SCOPE_AGENT);
}
template <bool DRY>
DI void gdn_prep_phase(bf16* PROJ, bf16* DRYBUF, const bf16* HALO, const float* wconv, const float* BETA, const float* GG, unsigned char* EX, float* GL, unsigned* FLAG,
                       LAS unsigned char* lds, int bid, int G, int FIRST, int tid, int wave, int lane) {
    LAS bf16* QB = (LAS bf16*)lds; LAS bf16* KB = (LAS bf16*)(lds + 17408); LAS bf16* VBt = (LAS bf16*)(lds + 34816);
    LAS float* Lm = (LAS float*)(lds + 52224); LAS float* Tm = (LAS float*)(lds + 68864); LAS float* QKm = (LAS float*)(lds + 85504);
    LAS float* gcS = (LAS float*)(lds + 102144); LAS float* btS = (LAS float*)(lds + 102400); LAS float* Mt = (LAS float*)(lds + 102656);
    LAS float* Wc = (LAS float*)(lds + 119296);
    int hcur = -1;
    for (int e0 = bid - FIRST; e0 < 4096; e0 += G - FIRST) {
        const int bh = e0 & 15, n = e0 >> 4, it = bh * 256 + n, b = bh >> 3, h = bh & 7;
        const size_t t0 = (size_t)b * SEQ + 64 * n;
        if (tid < 64) { float gv = GG[(t0 + tid) * 8 + h]; btS[tid] = BETA[(t0 + tid) * 8 + h];
#pragma unroll
            for (int o = 1; o < 64; o <<= 1) { const float tv = __shfl_up(gv, o); if (lane >= o) gv += tv; }
            gcS[tid] = gv; }
        for (int e = tid; e < 6 * 256; e += NTHR) { const int bq = e >> 8, r = (e >> 4) & 15, c = e & 15;
            const int bi = (bq < 3) ? 0 : (bq < 5 ? 1 : 2), bj = (bq < 3) ? bq + 1 : (bq < 5 ? bq - 1 : 3);
            Tm[(16 * bi + r) * 65 + 16 * bj + c] = 0.f; }
        if (h != hcur) {
            __syncthreads();
            for (int i2 = tid; i2 < 4 * 3 * 128; i2 += NTHR) { const int kk = i2 / 384, rem = i2 - kk * 384; Wc[i2] = wconv[kk * 3072 + (rem >> 7) * 1024 + h * 128 + (rem & 127)]; }
            hcur = h;
            __syncthreads();
        }
#pragma unroll 1
        for (int rnd = 0; rnd < 2; ++rnd) {
        v4u PV[3][4];
#pragma unroll
        for (int s3 = 0; s3 < 3; ++s3) {
            const int idx = wave * 6 + rnd * 3 + s3, mat = idx >> 4, rg = idx & 15;
            const int row = 4 * rg + (lane >> 4), oct = lane & 15, colg = mat * 1024 + h * 128 + 8 * oct;
#pragma unroll
            for (int kk = 0; kk < 4; ++kk) {
                const int rr = row - 3 + kk;
                v4u v = (v4u){0u, 0u, 0u, 0u};
                if (rr >= 0) v = *(const v4u*)(PROJ + (t0 + rr) * 4096 + colg);
                else if (n > 0) v = *(const v4u*)(HALO + ((size_t)(b * 256 + n - 1) * 3 + (rr + 3)) * 3072 + colg);
                PV[s3][kk] = v; }
        }
#pragma unroll
        for (int s3 = 0; s3 < 3; ++s3) {
            const int idx = wave * 6 + rnd * 3 + s3, mat = idx >> 4, rg = idx & 15;
            const int row = 4 * rg + (lane >> 4), oct = lane & 15;
            float a[8];
#pragma unroll
            for (int e = 0; e < 8; ++e) a[e] = 0.f;
#pragma unroll
            for (int kk = 0; kk < 4; ++kk) {
                const v4u v = PV[s3][kk];
                const f32x4 w0 = *(const LAS f32x4*)(Wc + (kk * 3 + mat) * 128 + 8 * oct), w1 = *(const LAS f32x4*)(Wc + (kk * 3 + mat) * 128 + 8 * oct + 4);
                a[0] += w0.x * bflo(v.x); a[1] += w0.y * bfhi(v.x); a[2] += w0.z * bflo(v.y); a[3] += w0.w * bfhi(v.y);
                a[4] += w1.x * bflo(v.z); a[5] += w1.y * bfhi(v.z); a[6] += w1.z * bflo(v.w); a[7] += w1.w * bfhi(v.w);
            }
            float ss = 0.f;
#pragma unroll
            for (int e = 0; e < 8; ++e) { a[e] = silu_f(a[e]); ss += a[e] * a[e]; }
            ss += __shfl_xor(ss, 1); ss += __shfl_xor(ss, 2); ss += __shfl_xor(ss, 4); ss += __shfl_xor(ss, 8);
            float rs = 1.f;
            if (mat == 0) rs = rsqrtf(ss + EPS) * 0.08838834764831845f; else if (mat == 1) rs = rsqrtf(ss + EPS);
            v4u o; o.x = pk2(a[0] * rs, a[1] * rs); o.y = pk2(a[2] * rs, a[3] * rs); o.z = pk2(a[4] * rs, a[5] * rs); o.w = pk2(a[6] * rs, a[7] * rs);
            LAS bf16* dst = (mat == 0 ? QB : (mat == 1 ? KB : VBt)) + row * 136 + 8 * oct;
            *(LAS v4u*)dst = o;
        }
        }
        __syncthreads();
#ifdef PREP_DBL_GRAM
        for (int rep = 0; rep < 3; ++rep)
#endif
        { const int isq = wave >> 2, m = wave & 3, r16 = lane & 15, q = lane >> 4;
          LAS bf16* As = isq ? QB : KB;
          bf16x8 af[4];
#pragma unroll
          for (int s = 0; s < 4; ++s) af[s] = *(const LAS bf16x8*)(As + (16 * m + r16) * 136 + 32 * s + 8 * q);
#pragma unroll
          for (int nt = 0; nt < 4; ++nt) { f32x4 acc = (f32x4){0.f, 0.f, 0.f, 0.f};
#pragma unroll
              for (int s = 0; s < 4; ++s) { const bf16x8 bfr = *(const LAS bf16x8*)(KB + (16 * nt + r16) * 136 + 32 * s + 8 * q); acc = MFMA16(af[s], bfr, acc); }
#pragma unroll
              for (int jj = 0; jj < 4; ++jj) { const int i = 16 * m + 4 * q + jj, j = 16 * nt + r16;
                  const float dec = __expf(fminf(gcS[i] - gcS[j], 0.f));
                  if (!isq) Lm[i * 65 + j] = (i > j) ? acc[jj] * btS[i] * dec : 0.f;
                  else QKm[i * 65 + j] = (i >= j) ? acc[jj] * dec : 0.f; } }
        }
        __syncthreads();
        const float gl = gcS[63];
        if (wave == 0) {
            const int blk = lane >> 4, col = lane & 15; const LAS float* Lb = Lm + (16 * blk) * 65 + 16 * blk;
            float t[16];
#pragma unroll
            for (int r = 0; r < 16; ++r) { float a = (r == col) ? 1.f : 0.f;
#pragma unroll
                for (int x = 0; x < r; ++x) a -= Lb[r * 65 + x] * t[x];
                t[r] = a; }
#pragma unroll
            for (int r = 0; r < 16; ++r) Tm[(16 * blk + r) * 65 + 16 * blk + col] = t[r];
        } else {
#pragma unroll 1
            for (int p0 = tid - 64; p0 < 4608; p0 += 448) {
                const int sect = p0 >> 10, p = p0 & 1023, l = p & 63, f = p >> 6, q = l >> 4, r16 = l & 15;
                v4u o;
                bf16* dst;
                if (sect == 0) {
                    const int m = f >> 2, s = f & 3, i = 16 * m + r16, c0 = 32 * s + 4 * q;
                    LAS bf16* src = QB + i * 136 + c0;
                    const v2u x0 = *(const LAS v2u*)src, x1 = *(const LAS v2u*)(src + 16);
                    const float sc = __expf(gcS[i]);
                    o.x = pk2(bflo(x0.x) * sc, bfhi(x0.x) * sc); o.y = pk2(bflo(x0.y) * sc, bfhi(x0.y) * sc);
                    o.z = pk2(bflo(x1.x) * sc, bfhi(x1.x) * sc); o.w = pk2(bflo(x1.y) * sc, bfhi(x1.y) * sc);
                    dst = PROJ + (t0 + (p >> 4)) * 4096 + h * 128 + (p & 15) * 8;
                } else if (sect == 1) {
                    o = *(const LAS v4u*)(KB + (p >> 4) * 136 + (p & 15) * 8);
                    dst = PROJ + (t0 + (p >> 4)) * 4096 + 1024 + h * 128 + (p & 15) * 8;
                } else if (sect == 2) {
                    const int w = p >> 7, ll = (p & 127) >> 1, half = p & 1; float y[8];
#pragma unroll
                    for (int jj = 0; jj < 8; ++jj) { const int m = half * 2 + (jj >> 2), rowi = 16 * m + 4 * (ll >> 4) + (jj & 3);
                        y[jj] = bf2f(VBt[rowi * 136 + 16 * w + (ll & 15)]) * btS[rowi]; }
                    o.x = pk2(y[0], y[1]); o.y = pk2(y[2], y[3]); o.z = pk2(y[4], y[5]); o.w = pk2(y[6], y[7]);
                    dst = PROJ + (t0 + (p >> 4)) * 4096 + 2048 + h * 128 + (p & 15) * 8;
                } else if (sect == 3) {
                    if (p >= 32) continue;
                    float y[4];
#pragma unroll
                    for (int jj = 0; jj < 4; ++jj) { const int i = 4 * (p & 15) + jj; y[jj] = (p < 16) ? -btS[i] * __expf(gcS[i]) : __expf(gl - gcS[i]); }
                    o.x = __builtin_bit_cast(unsigned, y[0]); o.y = __builtin_bit_cast(unsigned, y[1]); o.z = __builtin_bit_cast(unsigned, y[2]); o.w = __builtin_bit_cast(unsigned, y[3]);
                    dst = (bf16*)(EX + (size_t)it * 32768 + p * 16);
                } else {
                    const int m = f >> 1, s = f & 1, i = 16 * m + r16; float y[8];
#pragma unroll
                    for (int jj = 0; jj < 8; ++jj) y[jj] = QKm[i * 65 + kperm(s, q, jj)];
                    o.x = pk2(y[0], y[1]); o.y = pk2(y[2], y[3]); o.z = pk2(y[4], y[5]); o.w = pk2(y[6], y[7]);
                    if (f == 1 || f == 3) continue;
                    dst = (bf16*)(EX + (size_t)it * 32768 + 24576 + tq_slot(f) * 1024 + l * 16);
                }
                if (DRY) { dst = DRYBUF + (size_t)(it & 255) * 40960 + p0 * 8; *(v4u*)dst = o; } else st16_wt(dst, o);
            }
        }
        __syncthreads();
#pragma unroll
        for (int d = 1; d <= 3; ++d) {
            const int nel = (4 - d) * 256;
            for (int e = tid; e < nel; e += NTHR) { const int bj = e >> 8, r = (e >> 4) & 15, c = e & 15, bi = bj + d;
                const LAS float* Lr = Lm + (16 * bi + r) * 65; const LAS float* Tc = Tm + 16 * bj + c; float a = 0.f;
#pragma unroll
                for (int yy = 0; yy < 16 * d; ++yy) { const int y = 16 * bj + yy; a += Lr[y] * Tc[y * 65]; }
                Mt[(16 * bi + r) * 65 + 16 * bj + c] = a; }
            __syncthreads();
            for (int e = tid; e < nel; e += NTHR) { const int bj = e >> 8, r = (e >> 4) & 15, c = e & 15, bi = bj + d;
                const LAS float* Dr = Tm + (16 * bi + r) * 65 + 16 * bi; const LAS float* Mc = Mt + (16 * bi) * 65 + 16 * bj + c; float a = 0.f;
#pragma unroll
                for (int x = 0; x < 16; ++x) a += Dr[x] * Mc[x * 65];
                Tm[(16 * bi + r) * 65 + 16 * bj + c] = -a; }
            __syncthreads();
        }
        { const int p = tid, l = p & 63, f = p >> 6, q = l >> 4, r16 = l & 15, m = f >> 1, s = f & 1, i = 16 * m + r16; float y[8];
#pragma unroll
          for (int jj = 0; jj < 8; ++jj) y[jj] = Tm[i * 65 + kperm(s, q, jj)];
          v4u o; o.x = pk2(y[0], y[1]); o.y = pk2(y[2], y[3]); o.z = pk2(y[4], y[5]); o.w = pk2(y[6], y[7]);
          if (DRY) *(v4u*)(DRYBUF + (size_t)(it & 255) * 40960 + 36864 + p * 8) = o; else if (f != 1 && f != 3) st16_wt(EX + (size_t)it * 32768 + 16384 + tq_slot(f) * 1024 + l * 16, o);
          if (tid == 0 && !DRY) __hip_atomic_store(GL + it, __expf(gl), __ATOMIC_RELAXED, __HIP_MEMORY_SCOPE_AGENT); }
        asm volatile("s_waitcnt vmcnt(0)" ::: "memory");
        __syncthreads();
        if (tid == 0 && !DRY) __hip_atomic_store(FLAG + it, 1u, __ATOMIC_RELAXED, __HIP_MEMORY_SCOPE_AGENT);
    }
}

constexpr int GS_BUF = 57344;
constexpr int GS_QA = 18432, GS_SC = 34816, GS_TA = 36864, GS_QK = 45056, GS_VB = 53248;
DI void gdn_scan_phase(const bf16* PROJ, const unsigned char* EX, const float* GL, const unsigned* FLAG, bf16* ORAW, LAS unsigned char* lds, int bid, int tid, int wave, int lane) {
    if (bid >= 64) return;
    const int bh = bid >> 2, sub = bid & 3, b = bh >> 3, h = bh & 7, q = lane >> 4, r16 = lane & 15;
    LAS unsigned char* OB = lds + 2 * GS_BUF;
    LAS float* GLs = (LAS float*)(lds + 2 * GS_BUF + 8192);
    if (wave >= 2) {
        const int g = (wave - 2) >> 1, i = tid & 127, rowi = i >> 4, pc = i & 15;
        v4u R0[9], R1[9], R2[9]; float G0, G1, G2;
#define GS_LD(R_, G_, n_) do { G_ = GL[bh * 256 + (n_)]; const size_t t0_ = (size_t)b * SEQ + 64 * (n_); const unsigned char* ex_ = EX + (size_t)(bh * 256 + (n_)) * 32768; \
        _Pragma("unroll") for (int u = 0; u < 9; ++u) { int c = g + 3 * u; c = c < 25 ? c : 24; const int k = c < 17 ? c : (c < 20 ? c + 7 : (c < 23 ? c + 8 : c + 9)); \
            const unsigned char* base_; size_t stride_; \
            if (k < 8) { base_ = (const unsigned char*)(PROJ + (t0_ + 8 * k) * 4096 + 1024 + h * 128); stride_ = 8192; } \
            else if (k < 16) { base_ = (const unsigned char*)(PROJ + (t0_ + 8 * (k - 8)) * 4096 + h * 128); stride_ = 8192; } \
            else if (k < 32) { base_ = ex_ + (size_t)(k - 16) * 2048; stride_ = 256; } \
            else { base_ = (const unsigned char*)(PROJ + (t0_ + 8 * (2 * sub + (k - 32))) * 4096 + 2048 + h * 128); stride_ = 8192; } \
            R_[u] = *(const v4u*)(base_ + (size_t)rowi * stride_ + pc * 16); } } while (0)
#define GS_ST(R_, G_, n_, buf_) do { if (g == 0 && i == 0) GLs[(n_)] = G_; _Pragma("unroll") for (int u = 0; u < 9; ++u) { const int c = g + 3 * u; const int k = c < 17 ? c : (c < 20 ? c + 7 : (c < 23 ? c + 8 : c + 9)); \
            int d_; if (k < 8) d_ = (8 * k + rowi) * 288 + pc * 16; else if (k < 16) d_ = GS_QA + (k - 8) * 2048 + i * 16; else if (k == 16) d_ = GS_SC + i * 16; \
            else if (k < 28) d_ = GS_TA + (k - 24) * 2048 + i * 16; else if (k < 32) d_ = GS_QK + (k - 28) * 2048 + i * 16; else d_ = GS_VB + (k - 32) * 2048 + i * 16; \
            if (c < 25) *(LAS v4u*)((buf_) + d_) = R_[u]; } } while (0)
#define GS_OUT(n_) do { if (g == 2) { const size_t t0_ = (size_t)b * SEQ + 64 * (n_); \
        _Pragma("unroll") for (int u = 0; u < 2; ++u) { const int p = i + 128 * u, row = p >> 2, c = p & 3; \
            const v4u v = *(const LAS v4u*)(OB + ((n_) & 1) * 4096 + row * 64 + c * 16); \
            *(v4u*)(ORAW + (t0_ + row) * 1024 + h * 128 + 32 * sub + 8 * c) = v; } } } while (0)
        __syncthreads();
        GS_LD(R0, G0, 0); GS_LD(R1, G1, 1); GS_LD(R2, G2, 2);
        GS_ST(R0, G0, 0, lds);
        __syncthreads();
#define GS_STEP(n_, Rst_, Gst_, Rld_, Gld_) do { if ((n_) < 256) { if ((n_) + 3 < 256) GS_LD(Rld_, Gld_, (n_) + 3); if ((n_) >= 1) GS_OUT((n_) - 1); \
            if ((n_) + 1 < 256) GS_ST(Rst_, Gst_, (n_) + 1, lds + (((n_) + 1) & 1) * GS_BUF); __syncthreads(); } } while (0)
#pragma unroll 1
        for (int n = 0; n < 258; n += 3) {
            GS_STEP(n, R1, G1, R0, G0);
            GS_STEP(n + 1, R2, G2, R1, G1);
            GS_STEP(n + 2, R0, G0, R2, G2);
        }
        GS_OUT(255);
#undef GS_LD
#undef GS_ST
#undef GS_OUT
#undef GS_STEP
        return;
    }
    f32x4 S[8];
#pragma unroll
    for (int i = 0; i < 8; ++i) S[i] = (f32x4){0.f, 0.f, 0.f, 0.f};
    const unsigned* fl = FLAG + bh * 256;
#define GS_POLL(c_) do { unsigned sp_ = 0; while (__builtin_amdgcn_readfirstlane(__hip_atomic_load(fl + (c_), __ATOMIC_RELAXED, __HIP_MEMORY_SCOPE_AGENT)) == 0u) { __builtin_amdgcn_s_sleep(2); if (++sp_ > (1u << 22)) break; } } while (0)
    if (wave == 0) { GS_POLL(0); GS_POLL(1); GS_POLL(2); GS_POLL(3); GS_POLL(4); GS_POLL(5); GS_POLL(6); GS_POLL(7); __builtin_amdgcn_fence(__ATOMIC_ACQUIRE, "agent"); asm volatile("s_waitcnt vmcnt(0)" ::: "memory"); }
    __syncthreads();
    __syncthreads();
#pragma unroll 1
    for (int n = 0; n < 256; ++n) {
        LAS unsigned char* buf = lds + (n & 1) * GS_BUF;
        const float egl = GLs[n];
        const bool pollstep = (wave == 0) && ((n & 3) == 0) && (n + 8 < 256);
        unsigned fn0 = 1u, fn1 = 1u, fn2 = 1u, fn3 = 1u;
        if (pollstep) { fn0 = __hip_atomic_load(fl + n + 8, __ATOMIC_RELAXED, __HIP_MEMORY_SCOPE_AGENT); fn1 = __hip_atomic_load(fl + n + 9, __ATOMIC_RELAXED, __HIP_MEMORY_SCOPE_AGENT);
            fn2 = __hip_atomic_load(fl + n + 10, __ATOMIC_RELAXED, __HIP_MEMORY_SCOPE_AGENT); fn3 = __hip_atomic_load(fl + n + 11, __ATOMIC_RELAXED, __HIP_MEMORY_SCOPE_AGENT); }
        f32x4 rhs[4];
        { const v4u vb0 = *(const LAS v4u*)(buf + GS_VB + wave * 2048 + lane * 32), vb1 = *(const LAS v4u*)(buf + GS_VB + wave * 2048 + lane * 32 + 16);
          rhs[0] = (f32x4){bflo(vb0.x), bfhi(vb0.x), bflo(vb0.y), bfhi(vb0.y)}; rhs[1] = (f32x4){bflo(vb0.z), bfhi(vb0.z), bflo(vb0.w), bfhi(vb0.w)};
          rhs[2] = (f32x4){bflo(vb1.x), bfhi(vb1.x), bflo(vb1.y), bfhi(vb1.y)}; rhs[3] = (f32x4){bflo(vb1.z), bfhi(vb1.z), bflo(vb1.w), bfhi(vb1.w)}; }
        bf16x8 Sb[4];
#pragma unroll
        for (int s = 0; s < 4; ++s) Sb[s] = pack_acc2(S[2 * s], S[2 * s + 1]);
        f32x4 tk[4];
#pragma unroll
        for (int m = 0; m < 4; ++m) tk[m] = (f32x4){0.f, 0.f, 0.f, 0.f};
#pragma unroll
        for (int s = 0; s < 4; ++s)
#pragma unroll
            for (int m = 0; m < 4; ++m) { const LAS unsigned char* kp = buf + (16 * m + r16) * 288 + (32 * s + 4 * q) * 2;
                const v2u lo = *(const LAS v2u*)kp, hi2 = *(const LAS v2u*)(kp + 32);
                v4u w; w.x = lo.x; w.y = lo.y; w.z = hi2.x; w.w = hi2.y;
                tk[m] = MFMA16(__builtin_bit_cast(bf16x8, w), Sb[s], tk[m]); }
#pragma unroll
        for (int m = 0; m < 4; ++m) { const f32x4 sc1 = *(const LAS f32x4*)(buf + GS_SC + (16 * m + 4 * q) * 4); rhs[m] = rhs[m] + sc1 * tk[m]; }
        bf16x8 Rb[2];
#pragma unroll
        for (int s = 0; s < 2; ++s) Rb[s] = pack_acc2(rhs[2 * s], rhs[2 * s + 1]);
        f32x4 vn[4];
#pragma unroll
        for (int m = 0; m < 4; ++m) vn[m] = (f32x4){0.f, 0.f, 0.f, 0.f};
#pragma unroll
        for (int s = 0; s < 2; ++s)
#pragma unroll
            for (int m = 0; m < 4; ++m) { if (s == 1 && m < 2) continue; const bf16x8 a = *(const LAS bf16x8*)(buf + GS_TA + tq_slot(m * 2 + s) * 1024 + lane * 16); vn[m] = MFMA16(a, Rb[s], vn[m]); }
        bf16x8 Vb[2];
#pragma unroll
        for (int s = 0; s < 2; ++s) Vb[s] = pack_acc2(vn[2 * s], vn[2 * s + 1]);
        bf16x8 Vs[2];
        { f32x4 vsc[4];
#pragma unroll
          for (int m = 0; m < 4; ++m) { const f32x4 sc2 = *(const LAS f32x4*)(buf + GS_SC + 256 + (16 * m + 4 * q) * 4); vsc[m] = vn[m] * sc2; }
#pragma unroll
          for (int s = 0; s < 2; ++s) Vs[s] = pack_acc2(vsc[2 * s], vsc[2 * s + 1]); }
#pragma unroll
        for (int m8 = 0; m8 < 8; ++m8) S[m8] = S[m8] * egl;
#pragma unroll
        for (int s = 0; s < 2; ++s)
#pragma unroll
            for (int m8 = 0; m8 < 8; ++m8) {
                const LAS unsigned char* tp = buf + (32 * s + 4 * q + ((lane & 15) >> 2)) * 288 + 32 * m8 + 8 * (lane & 3);
                const v4i16_t lo = fx_vtr(tp), hi4 = fx_vtr(tp + 16 * 288);
                S[m8] = MFMA16(__builtin_shufflevector(lo, hi4, 0, 1, 2, 3, 4, 5, 6, 7), Vs[s], S[m8]); }
        f32x4 o[4];
#pragma unroll
        for (int m = 0; m < 4; ++m) o[m] = (f32x4){0.f, 0.f, 0.f, 0.f};
#pragma unroll
        for (int s = 0; s < 4; ++s)
#pragma unroll
            for (int m = 0; m < 4; ++m) { const bf16x8 a = *(const LAS bf16x8*)(buf + GS_QA + (m * 4 + s) * 1024 + lane * 16); o[m] = MFMA16(a, Sb[s], o[m]); }
#pragma unroll
        for (int s = 0; s < 2; ++s)
#pragma unroll
            for (int m = 0; m < 4; ++m) { if (s == 1 && m < 2) continue; const bf16x8 a = *(const LAS bf16x8*)(buf + GS_QK + tq_slot(m * 2 + s) * 1024 + lane * 16); o[m] = MFMA16(a, Vb[s], o[m]); }
        { LAS bf16* ob = (LAS bf16*)(OB + (n & 1) * 4096);
#pragma unroll
          for (int m = 0; m < 4; ++m)
#pragma unroll
              for (int j = 0; j < 4; ++j) ob[(16 * m + 4 * q + j) * 32 + 16 * wave + r16] = (bf16)f2bf(o[m][j]); }
        if (pollstep) { if (__builtin_amdgcn_readfirstlane(fn0) == 0u) GS_POLL(n + 8); if (__builtin_amdgcn_readfirstlane(fn1) == 0u) GS_POLL(n + 9);
            if (__builtin_amdgcn_readfirstlane(fn2) == 0u) GS_POLL(n + 10); if (__builtin_amdgcn_readfirstlane(fn3) == 0u) GS_POLL(n + 11);
            __builtin_amdgcn_fence(__ATOMIC_ACQUIRE, "agent"); asm volatile("s_waitcnt vmcnt(0)" ::: "memory"); }
        __syncthreads();
    }
#undef GS_POLL
}

DI void gdn_onorm_phase(bf16* OY, const bf16* PROJ, const float* wn, float* ROPE, const int* pos, int gw, int NGW, int lane) {
    constexpr int NR = 4;
    for (int row = gw; row < TT; row += NGW) {
        if (lane < 32) { const float inv = powf(10000.f, -(float)lane * (1.f / 32.f)); const float ang = (float)pos[row] * inv; float sn, cs; sincosf(ang, &sn, &cs);
            ROPE[(size_t)row * 64 + lane] = cs; ROPE[(size_t)row * 64 + 32 + lane] = sn; } }
    float wv[16];
#pragma unroll
    for (int e = 0; e < 16; ++e) wv[e] = wn[16 * (lane & 7) + e];
    for (int row0 = gw * NR; row0 < TT; row0 += NGW * NR) {
        v4u o0[NR], o1[NR], z0[NR], z1[NR];
#pragma unroll
        for (int rr = 0; rr < NR; ++rr) { const bf16* op = OY + (size_t)(row0 + rr) * 1024 + 16 * lane; const bf16* zp = PROJ + (size_t)(row0 + rr) * 4096 + 3072 + 16 * lane;
            o0[rr] = *(const v4u*)op; o1[rr] = *(const v4u*)(op + 8); z0[rr] = *(const v4u*)zp; z1[rr] = *(const v4u*)(zp + 8); }
#pragma unroll
        for (int rr = 0; rr < NR; ++rr) {
            bf16* op = OY + (size_t)(row0 + rr) * 1024 + 16 * lane;
            float ov[16], zv[16];
#pragma unroll
            for (int e = 0; e < 4; ++e) { ov[2 * e] = bflo(o0[rr][e]); ov[2 * e + 1] = bfhi(o0[rr][e]); ov[8 + 2 * e] = bflo(o1[rr][e]); ov[8 + 2 * e + 1] = bfhi(o1[rr][e]);
                zv[2 * e] = bflo(z0[rr][e]); zv[2 * e + 1] = bfhi(z0[rr][e]); zv[8 + 2 * e] = bflo(z1[rr][e]); zv[8 + 2 * e + 1] = bfhi(z1[rr][e]); }
            float ss = 0.f;
#pragma unroll
            for (int e = 0; e < 16; ++e) ss += ov[e] * ov[e];
            ss += __shfl_xor(ss, 1); ss += __shfl_xor(ss, 2); ss += __shfl_xor(ss, 4);
            const float rs = rsqrtf(ss * (1.f / 128.f) + EPS);
            float y[16];
#pragma unroll
            for (int e = 0; e < 16; ++e) y[e] = ov[e] * rs * wv[e] * silu_f(zv[e]);
            v4u a, c; a.x = pk2(y[0], y[1]); a.y = pk2(y[2], y[3]); a.z = pk2(y[4], y[5]); a.w = pk2(y[6], y[7]);
            c.x = pk2(y[8], y[9]); c.y = pk2(y[10], y[11]); c.z = pk2(y[12], y[13]); c.w = pk2(y[14], y[15]);
            *(v4u*)op = a; *(v4u*)(op + 8) = c;
        }
    }
}
DI void swa_phase(const bf16* PROJ, const float* ROPE, const float* sinks, bf16* Y, LAS unsigned char* lds, int bid, int G, int tid, int wave, int lane) {
    LAS bf16* Ks = (LAS bf16*)lds;
    LAS bf16* Vs = (LAS bf16*)(lds + 36864);
    const int r = lane & 31, hi = lane >> 5;
    const float LOG2E = 1.4426950408889634f, c2 = 0.125f * LOG2E;
    for (int it = bid; it < 1024; it += G) {
        const int hk = it & 3, nb = (it >> 2) & 127, b = it >> 9;
        const long tb0 = (long)b * SEQ + (long)(nb - 1) * 128;
#pragma unroll
        for (int u = 0; u < 2; ++u) { const int p = tid + 512 * u, kk = p >> 2, o = p & 3;
            v4u w1 = (v4u){0u, 0u, 0u, 0u}, w2 = (v4u){0u, 0u, 0u, 0u};
            if (nb > 0 || kk >= 128) {
                const size_t t = (size_t)(tb0 + kk);
                const bf16* kp = PROJ + t * 2560 + 1024 + hk * 64 + 8 * o;
                const v4u a = *(const v4u*)kp, c = *(const v4u*)(kp + 32);
                const f32x4 cs0 = *(const f32x4*)(ROPE + t * 64 + 8 * o), cs1 = *(const f32x4*)(ROPE + t * 64 + 8 * o + 4);
                const f32x4 sn0 = *(const f32x4*)(ROPE + t * 64 + 32 + 8 * o), sn1 = *(const f32x4*)(ROPE + t * 64 + 32 + 8 * o + 4);
                float x1[8], x2[8], cs[8], sn[8];
#pragma unroll
                for (int e = 0; e < 4; ++e) { x1[2 * e] = bflo(a[e]); x1[2 * e + 1] = bfhi(a[e]); x2[2 * e] = bflo(c[e]); x2[2 * e + 1] = bfhi(c[e]);
                    cs[e] = cs0[e]; cs[4 + e] = cs1[e]; sn[e] = sn0[e]; sn[4 + e] = sn1[e]; }
                float y1[8], y2[8];
#pragma unroll
                for (int e = 0; e < 8; ++e) { y1[e] = x1[e] * cs[e] - x2[e] * sn[e]; y2[e] = x2[e] * cs[e] + x1[e] * sn[e]; }
                w1.x = pk2(y1[0], y1[1]); w1.y = pk2(y1[2], y1[3]); w1.z = pk2(y1[4], y1[5]); w1.w = pk2(y1[6], y1[7]);
                w2.x = pk2(y2[0], y2[1]); w2.y = pk2(y2[2], y2[3]); w2.z = pk2(y2[4], y2[5]); w2.w = pk2(y2[6], y2[7]);
            }
            *(LAS v4u*)(Ks + kk * 72 + 8 * o) = w1; *(LAS v4u*)(Ks + kk * 72 + 32 + 8 * o) = w2; }
#pragma unroll
        for (int u = 0; u < 4; ++u) { const int p = tid + 512 * u, kk = p >> 3, o8 = p & 7;
            v4u v = (v4u){0u, 0u, 0u, 0u};
            if (nb > 0 || kk >= 128) v = *(const v4u*)(PROJ + (size_t)(tb0 + kk) * 2560 + 1280 + hk * 64 + 8 * o8);
            const int pos = (kk & ~15) + perm16(kk & 15);
            LAS bf16* d = Vs + (8 * o8) * 264 + pos;
            d[0] = (bf16)(v.x & 0xffffu); d[264] = (bf16)(v.x >> 16); d[2 * 264] = (bf16)(v.y & 0xffffu); d[3 * 264] = (bf16)(v.y >> 16);
            d[4 * 264] = (bf16)(v.z & 0xffffu); d[5 * 264] = (bf16)(v.z >> 16); d[6 * 264] = (bf16)(v.w & 0xffffu); d[7 * 264] = (bf16)(v.w >> 16); }
        __syncthreads();
        const int g = wave >> 1, qh = wave & 1, head = hk * 4 + g;
        const float sink2 = sinks[head] * LOG2E;
        for (int sb = 0; sb < 2; ++sb) {
            const int qs = 64 * qh + 32 * sb, qi = qs + r, tbase = qs >> 5;
            const size_t t = (size_t)b * SEQ + (size_t)nb * 128 + qi;
            bf16x8 Qf[4];
            { const bf16* qp = PROJ + t * 2560 + head * 64 + 8 * hi;
              v4u qa[4];
#pragma unroll
              for (int ks = 0; ks < 4; ++ks) qa[ks] = *(const v4u*)(qp + 16 * ks);
#pragma unroll
              for (int k2 = 0; k2 < 2; ++k2) {
                  const f32x4 cs0 = *(const f32x4*)(ROPE + t * 64 + 16 * k2 + 8 * hi), cs1 = *(const f32x4*)(ROPE + t * 64 + 16 * k2 + 8 * hi + 4);
                  const f32x4 sn0 = *(const f32x4*)(ROPE + t * 64 + 32 + 16 * k2 + 8 * hi), sn1 = *(const f32x4*)(ROPE + t * 64 + 32 + 16 * k2 + 8 * hi + 4);
                  float y1[8], y2[8];
#pragma unroll
                  for (int e = 0; e < 4; ++e) {
                      const float a0 = bflo(qa[k2][e]), a1 = bfhi(qa[k2][e]), c0 = bflo(qa[k2 + 2][e]), c1 = bfhi(qa[k2 + 2][e]);
                      const float cA = (e < 2) ? cs0[2 * e] : cs1[2 * e - 4], cB = (e < 2) ? cs0[2 * e + 1] : cs1[2 * e - 3];
                      const float sA = (e < 2) ? sn0[2 * e] : sn1[2 * e - 4], sB = (e < 2) ? sn0[2 * e + 1] : sn1[2 * e - 3];
                      y1[2 * e] = a0 * cA - c0 * sA; y2[2 * e] = c0 * cA + a0 * sA;
                      y1[2 * e + 1] = a1 * cB - c1 * sB; y2[2 * e + 1] = c1 * cB + a1 * sB; }
                  v4u w1, w2;
                  w1.x = pk2(y1[0], y1[1]); w1.y = pk2(y1[2], y1[3]); w1.z = pk2(y1[4], y1[5]); w1.w = pk2(y1[6], y1[7]);
                  w2.x = pk2(y2[0], y2[1]); w2.y = pk2(y2[2], y2[3]); w2.z = pk2(y2[4], y2[5]); w2.w = pk2(y2[6], y2[7]);
                  Qf[k2] = __builtin_bit_cast(bf16x8, w1); Qf[k2 + 2] = __builtin_bit_cast(bf16x8, w2); } }
            f32x16 S[5];
            float mx = sink2;
#pragma unroll
            for (int tk = 0; tk < 5; ++tk) {
#pragma unroll
                for (int i = 0; i < 16; ++i) S[tk][i] = 0.f;
                const int kt = tbase + tk;
#pragma unroll
                for (int ks = 0; ks < 4; ++ks) { const bf16x8 a = *(const LAS bf16x8*)(Ks + (32 * kt + r) * 72 + 16 * ks + 8 * hi); S[tk] = MFMA32(a, Qf[ks], S[tk]); }
#pragma unroll
                for (int i = 0; i < 16; ++i) { const int kk = 32 * kt + crow32(i, hi);
                    const bool ok = (kk > qi) && (kk <= qi + 128) && (nb > 0 || kk >= 128);
                    const float xv = ok ? S[tk][i] * c2 : -INFINITY; S[tk][i] = xv; mx = fmaxf(mx, xv); }
            }
            mx = fmaxf(mx, __shfl_xor(mx, 32));
            float ps = 0.f;
#pragma unroll
            for (int tk = 0; tk < 5; ++tk)
#pragma unroll
                for (int i = 0; i < 16; ++i) { const float p = __builtin_amdgcn_exp2f(S[tk][i] - mx); S[tk][i] = p; ps += p; }
            const float tot = ps + __shfl_xor(ps, 32) + __builtin_amdgcn_exp2f(sink2 - mx);
            const float inv = 1.f / tot;
            f32x16 O[2];
#pragma unroll
            for (int dt = 0; dt < 2; ++dt)
#pragma unroll
                for (int i = 0; i < 16; ++i) O[dt][i] = 0.f;
#pragma unroll
            for (int tk = 0; tk < 5; ++tk)
#pragma unroll
                for (int s = 0; s < 2; ++s) { v4u w;
                    w.x = pk2(S[tk][8 * s], S[tk][8 * s + 1]); w.y = pk2(S[tk][8 * s + 2], S[tk][8 * s + 3]);
                    w.z = pk2(S[tk][8 * s + 4], S[tk][8 * s + 5]); w.w = pk2(S[tk][8 * s + 6], S[tk][8 * s + 7]);
                    const bf16x8 pf = __builtin_bit_cast(bf16x8, w);
                    const int kt = tbase + tk;
#pragma unroll
                    for (int dt = 0; dt < 2; ++dt) { const bf16x8 a = *(const LAS bf16x8*)(Vs + (32 * dt + r) * 264 + 32 * kt + 16 * s + 8 * hi); O[dt] = MFMA32(a, pf, O[dt]); } }
#pragma unroll
            for (int dt = 0; dt < 2; ++dt)
#pragma unroll
                for (int g4 = 0; g4 < 4; ++g4) { const int d = 32 * dt + 8 * g4 + 4 * hi;
                    const v2u z = *(const v2u*)(PROJ + t * 2560 + 1536 + head * 64 + d);
                    const float y0 = O[dt][4 * g4] * inv * silu_f(bflo(z.x)), y1 = O[dt][4 * g4 + 1] * inv * silu_f(bfhi(z.x));
                    const float y2 = O[dt][4 * g4 + 2] * inv * silu_f(bflo(z.y)), y3 = O[dt][4 * g4 + 3] * inv * silu_f(bfhi(z.y));
                    v2u o; o.x = pk2(y0, y1); o.y = pk2(y2, y3);
                    *(v2u*)(Y + t * 1024 + head * 64 + d) = o; }
        }
        __syncthreads();
    }
}
#ifndef LAYER_MASK
#define LAYER_MASK 15
#endif
__global__ void __launch_bounds__(NTHR, 2) mega_fwd(Ptrs P) {
    extern __shared__ __attribute__((aligned(16))) unsigned char lds_raw[];
    LAS unsigned char* lds = (LAS unsigned char*)lds_raw;
    cg::grid_group grid = cg::this_grid();
    int tid_o = threadIdx.x; int tid = tid_o, lane = tid & 63; const int wave = __builtin_amdgcn_readfirstlane(tid >> 6);
    const int G = gridDim.x, bid = blockIdx.x;
    const int gw = bid * NWAVES + wave, NGW = G * NWAVES, NG = G * NTHR; int gtid = bid * NTHR + tid;
    unsigned char* ws = P.ws;
    const float* x_in = P.in[0]; const int* positions = (const int*)P.in[1];
    const float* norm_w = P.in[2]; const float* fnorm_w = P.in[3];
    float* X = P.out;
    bf16* XB = (bf16*)P.out;
    bf16* XB3 = (bf16*)(ws + WS_EX + 64 * MiB);
    bf16* HY = (bf16*)(ws + WS_HY); bf16* PROJ = (bf16*)(ws + WS_PROJ);
#define RELAUNDER() do { asm volatile("" : "+v"(tid_o)); tid = tid_o; lane = tid & 63; gtid = bid * NTHR + tid; } while (0)
#define GSYNC() do { xcd_barrier(xbar); RELAUNDER(); } while (0)

    unsigned* CTL = (unsigned*)(ws + WS_GL + 65536);
    if (bid == 0 && tid < 128) CTL[tid] = 0u;
    unsigned* FLAGS = (unsigned*)(ws + WS_GL + 131072);
    for (int i = gtid; i < 4096; i += NG) FLAGS[i] = 0u;
    unsigned* XBW = (unsigned*)(ws + WS_GL + 262144);
    volatile LAS unsigned* xst = (volatile LAS unsigned*)(lds + LDS_BYTES - 16);
    if (bid == 0) for (int i = tid; i < XCD_BAR_WORDS; i += NTHR) XBW[i] = 0u;
    if (tid < 2) xst[tid] = 0u;
    p0_prologue(P, lds, gw, NGW, wave, lane);
#ifdef DBL_P0
    p0_prologue(P, lds, gw, NGW, wave, lane);
#endif
    norm_phase<0>(x_in, norm_w, HY, nullptr, nullptr, 0, nullptr, nullptr, nullptr, nullptr, nullptr, nullptr, lds, gw, NGW, tid, lane);
    grid.sync();
    RELAUNDER();
    const XcdBarrier xbar = xcd_barrier_post(XBW, xst);
    if (LAYER_MASK & 1) {
        bf16* Y0 = (bf16*)(ws + WS_EX); float* CVH = (float*)(ws + WS_PROJ); float* BND = (float*)(ws + WS_PROJ + 8 * MiB);
        { pg8::Gemm g{HY, (const bf16*)(ws + WS_W0I), TT, 4096, 1024}; pg8::StaticOrder S; S.init(TT, 4096, G, bid);
          pg8::EpiConvGate E{Y0, P.in[5], CVH, BND};
          pg8::gemm_phase<pg8::EpiConvGate, pg8::StaticOrder, true, true>(lds, g, S, E); }
        GSYNC();
        convfix_phase(CVH, BND, P.in[5], Y0, gtid, NG);
        GSYNC();
        { pg8::Gemm g{Y0, (const bf16*)(ws + WS_W0O), TT, 1024, 1024}; pg8::StaticOrder S; S.init(TT, 1024, G, bid);
          pg8::EpiRes<false, true> E{x_in, XB, nullptr};
          pg8::gemm_phase<pg8::EpiRes<false, true>, pg8::StaticOrder, true, true>(lds, g, S, E);
        }
    } else {
        for (size_t i = gtid; i < (size_t)TT * DM / 4; i += NG) { const f32x4 v = ((const f32x4*)x_in)[i]; v2u o; o.x = pk2(v.x, v.y); o.y = pk2(v.z, v.w); ((v2u*)XB)[i] = o; }
    }
    GSYNC();
    if (LAYER_MASK & 2) {
        float* LOGF = (float*)(ws + WS_LOGF); float* CUM = (float*)(ws + WS_CUM); bf16* VT = (bf16*)(ws + WS_EX);
        norm_phase<1, true>((const float*)XB, norm_w + 1024, HY, nullptr, P.in[7], 4104, LOGF, nullptr, P.in[8], nullptr, nullptr, nullptr, lds, gw, NGW, tid, lane);
        GSYNC();
        if (bid < 16) fox_cumsum(LOGF, CUM, bid, lds, tid);
        { pg8::Gemm g{HY, (const bf16*)(ws + WS_W1I), TT, 4096, 1024}; pg8::StaticOrder S; S.init(TT, 4096, G, bid);
          pg8::EpiStore E{PROJ, 4096, nullptr};
          pg8::gemm_phase<pg8::EpiStore, pg8::StaticOrder, true, true>(lds, g, S, E); }
        GSYNC();
        fox_norms_phase(PROJ, (float*)(CTL + 1024), gw, NGW, lane);
#ifdef DBL_VTRANS
        fox_norms_phase(PROJ, (float*)(CTL + 1024), gw, NGW, lane);
#endif
        GSYNC();
        fox_attn_phase(PROJ, CUM, HY, (const float*)(CTL + 1024), CTL + 64, lds, bid, G, tid, wave, lane);
#ifdef DBL_FOX
        fox_attn_phase(PROJ, CUM, HY, (const float*)(CTL + 1024), CTL + 65, lds, bid, G, tid, wave, lane);
#endif
        GSYNC();
        { pg8::Gemm g{HY, (const bf16*)(ws + WS_W1O), TT, 1024, 1024}; pg8::StaticOrder S; S.init(TT, 1024, G, bid);
          pg8::EpiRes<true, true> E{XB, XB, nullptr};
          pg8::gemm_phase<pg8::EpiRes<true, true>, pg8::StaticOrder, true, true>(lds, g, S, E); }
        GSYNC();
    }
    if (LAYER_MASK & 4) {
        float* BETA = (float*)(ws + WS_LOGF); float* GG = (float*)(ws + WS_CUM); float* GL = (float*)(ws + WS_GL); bf16* HALO = (bf16*)(ws + WS_HALO);
        norm_phase<2, true>((const float*)XB, norm_w + 2048, HY, nullptr, P.in[10], 4112, BETA, GG, P.in[12], P.in[13], nullptr, nullptr, lds, gw, NGW, tid, lane);
#ifdef DBL_NORM2
        norm_phase<2, true>((const float*)XB, norm_w + 2048, HY, nullptr, P.in[10], 4112, BETA, GG, P.in[12], P.in[13], nullptr, nullptr, lds, gw, NGW, tid, lane);
#endif
        GSYNC();
        { pg8::Gemm g{HY, (const bf16*)(ws + WS_W2I), TT, 4096, 1024}; pg8::StaticOrder S; S.init(TT, 4096, G, bid);
          pg8::EpiStore E{PROJ, 4096, HALO};
          pg8::gemm_phase<pg8::EpiStore, pg8::StaticOrder, true, true>(lds, g, S, E); }
        GSYNC();
        if (bid >= 64) gdn_prep_phase<false>(PROJ, HY, HALO, P.in[11], BETA, GG, ws + WS_EX, GL, FLAGS, lds, bid, G, 64, tid, wave, lane);
        else gdn_scan_phase(PROJ, ws + WS_EX, GL, FLAGS, HY, lds, bid, tid, wave, lane);
        GSYNC();
        gdn_onorm_phase(HY, PROJ, P.in[14], (float*)(ws + WS_EX), positions, gw, NGW, lane);
        GSYNC();
        { pg8::Gemm g{HY, (const bf16*)(ws + WS_W2O), TT, 1024, 1024}; pg8::StaticOrder S; S.init(TT, 1024, G, bid);
          pg8::EpiRes<true, true, true> E{XB, XB3, (float*)(ws + WS_LOGF)};
          pg8::gemm_phase<pg8::EpiRes<true, true, true>, pg8::StaticOrder, true, true>(lds, g, S, E); }
        GSYNC();
    }
    if (LAYER_MASK & 8) {
        float* ROPE = (float*)(ws + WS_EX);
        { pg8::Gemm g{XB3, (const bf16*)(ws + WS_W3I), TT, 2560, 1024}; pg8::StaticOrder S; S.init(TT, 2560, G, bid);
          pg8::EpiStoreScaled E{PROJ, 2560, (const float*)(ws + WS_LOGF)};
          pg8::gemm_phase<pg8::EpiStoreScaled, pg8::StaticOrder, true, true>(lds, g, S, E); }
        GSYNC();
        swa_phase(PROJ, ROPE, P.in[17], HY, lds, bid, G, tid, wave, lane);
#ifdef DBL_SWA
        swa_phase(PROJ, ROPE, P.in[17], HY, lds, bid, G, tid, wave, lane);
#endif
        GSYNC();
        { pg8::Gemm g{HY, (const bf16*)(ws + WS_W3O), TT, 1024, 1024}; pg8::StaticOrder S; S.init(TT, 1024, G, bid);
          pg8::EpiRes<true, false> E{XB3, X, nullptr};
          pg8::gemm_phase<pg8::EpiRes<true, false>, pg8::StaticOrder, true, true>(lds, g, S, E); }
        GSYNC();
    }
#ifdef DBL_SYNC
    for (int i = 0; i < 10; ++i) GSYNC();
#endif
#ifdef DBL_FINAL
    norm_phase<0>(X, fnorm_w, HY, nullptr, nullptr, 0, nullptr, nullptr, nullptr, nullptr, nullptr, nullptr, lds, gw, NGW, tid, lane);
#endif
    norm_phase<4>(X, fnorm_w, nullptr, X, nullptr, 0, nullptr, nullptr, nullptr, nullptr, nullptr, nullptr, lds, gw, NGW, tid, lane);
}

extern "C" void kernel_launch(void* const* d_in, const int* in_sizes, int n_in, void* d_out, int out_size, void* d_ws, size_t ws_size, hipStream_t stream) {
    static int grid = 0;
    if (grid == 0) {
        int dev = 0, cus = 0, per_cu = 0;
        hipGetDevice(&dev);
        hipDeviceGetAttribute(&cus, hipDeviceAttributeMultiprocessorCount, dev);
        if (hipFuncSetAttribute((const void*)mega_fwd, hipFuncAttributeMaxDynamicSharedMemorySize, LDS_BYTES) != hipSuccess) fprintf(stderr, "kernel_launch: hipFuncSetAttribute failed\n");
        if (hipOccupancyMaxActiveBlocksPerMultiprocessor(&per_cu, (const void*)mega_fwd, NTHR, LDS_BYTES) != hipSuccess || per_cu < 1) { fprintf(stderr, "kernel_launch: occupancy query says %d\n", per_cu); per_cu = 1; }
        (void)hipGetLastError();
        grid = cus;
        if (ws_size < WS_END) fprintf(stderr, "kernel_launch: workspace %zu < %zu\n", ws_size, (size_t)WS_END);
    }
    Ptrs p{};
    for (int i = 0; i < 19; ++i) p.in[i] = (const float*)d_in[i];
    p.out = (float*)d_out; p.ws = (unsigned char*)d_ws; p.ph_lo = 0; p.ph_hi = 0;
    void* args[] = {&p};
    hipError_t e = hipLaunchCooperativeKernel((const void*)mega_fwd, dim3(grid), dim3(NTHR), args, LDS_BYTES, stream);
    if (e != hipSuccess) fprintf(stderr, "cooperative launch failed: %s (grid %d)\n", hipGetErrorString(e), grid);
}
```

```cpp
#include <hip/hip_runtime.h>
#include <hip/hip_cooperative_groups.h>
#include <cstdio>
#include <cstdint>
namespace cg = cooperative_groups;

#define DI __device__ __forceinline__
#define LAS __attribute__((address_space(3)))
#define GAS __attribute__((address_space(1)))
typedef unsigned short bf16;
typedef unsigned v4u __attribute__((ext_vector_type(4)));
typedef unsigned v2u __attribute__((ext_vector_type(2)));
typedef float f32x4 __attribute__((ext_vector_type(4)));
typedef float f32x16 __attribute__((ext_vector_type(16)));
typedef short bf16x8 __attribute__((ext_vector_type(8)));

constexpr int NBATCH = 2, SEQ = 16384, TT = NBATCH * SEQ, DM = 1024;
constexpr float EPS = 1e-6f;
constexpr int NWAVES = 8, NTHR = 512;
constexpr size_t MiB = 1u << 20;
constexpr size_t WS_W0I = 0, WS_W0O = 8 * MiB, WS_W1I = 10 * MiB, WS_W1O = 18 * MiB, WS_W2I = 20 * MiB, WS_W2O = 28 * MiB, WS_W3I = 30 * MiB, WS_W3O = 35 * MiB;
constexpr size_t WS_LOGF = 38 * MiB;
constexpr size_t WS_CUM = 39 * MiB;
constexpr size_t WS_GL = 40 * MiB;
constexpr size_t WS_HALO = 48 * MiB;
constexpr size_t WS_HY = 64 * MiB;
constexpr size_t WS_PROJ = 128 * MiB;
constexpr size_t WS_EX = 384 * MiB;
constexpr size_t WS_END = 512 * MiB;
constexpr int LDS_BYTES = 155648;

DI unsigned f2bf(float f) { unsigned u = __builtin_bit_cast(unsigned, f); return (u + 0x7fffu + ((u >> 16) & 1u)) >> 16; }
typedef float f32x2_t __attribute__((ext_vector_type(2)));
typedef __bf16 bf16x2_t __attribute__((ext_vector_type(2)));
DI unsigned pk2(float lo, float hi) { f32x2_t v = {lo, hi}; bf16x2_t b = __builtin_convertvector(v, bf16x2_t); return __builtin_bit_cast(unsigned, b); }
DI float bflo(unsigned u) { return __builtin_bit_cast(float, u << 16); }
DI float bfhi(unsigned u) { return __builtin_bit_cast(float, u & 0xffff0000u); }
DI float bf2f(bf16 b) { return __builtin_bit_cast(float, (unsigned)b << 16); }
DI float wave_sum(float v) {
#pragma unroll
    for (int o = 1; o < 64; o <<= 1) v += __shfl_xor(v, o);
    return v;
}
DI float silu_f(float x) { return x / (1.f + __expf(-x)); }
DI float softplus_f(float x) { return fmaxf(x, 0.f) + log1pf(__expf(-fabsf(x))); }
namespace pg8 {
#define PG8_LAS __attribute__((address_space(3)))
typedef unsigned short bf16_t;
typedef short bf16x8 __attribute__((ext_vector_type(8)));
typedef float f32x4 __attribute__((ext_vector_type(4)));
typedef unsigned u32x4 __attribute__((ext_vector_type(4)));
constexpr int BM = 256, BK = 64, HALF = 128, HTB = HALF * BK * 2  , STAGE_BYTES = 8 * HTB, NXCD = 8, WGM = 8;

__host__ __device__ __forceinline__ int lds_byte(int r, int c) { const int st = (r >> 4) * 2 + (c >> 5), rr = r & 15, cc = c & 31, ob = rr * 64 + cc * 2; return st * 1024 + (ob ^ (((ob >> 9) & 1) << 5)); }
__host__ __device__ __forceinline__ void stage_rc(int b, int& R, int& C) { const int st = b / 1024, sb = b % 1024, swz = sb ^ (((sb >> 9) & 1) << 5); R = (st >> 1) * 16 + swz / 64; C = (st & 1) * 32 + (swz % 64) / 2; }
__host__ __device__ __forceinline__ int perm32(int rho) { const int n = rho >> 4, i = rho & 15; return 8 * (i >> 2) + 4 * n + (i & 3); }

struct Unit { int pm, pn; };
struct Gemm { const bf16_t* A; const bf16_t* Bt; int M, N, K; };

struct StaticOrder {
    int nM, nN, nwg, G, c;
    __host__ __device__ void init(int M, int N, int G_, int c_) { nM = M / BM; nN = N / BM; nwg = nM * nN; G = G_; c = c_; }
    __host__ __device__ bool next(int i, Unit& u) const {
        const long L = (long)i * G + c; if (L >= nwg) return false;
        int wgid = (int)L; { const int q = nwg / NXCD, r = nwg % NXCD, xcd = wgid % NXCD, off = wgid / NXCD; wgid = (xcd < r ? xcd * (q + 1) : r * (q + 1) + (xcd - r) * q) + off; }
        const int nig = WGM * nN, gid = wgid / nig, fm = gid * WGM, gsz = (nM - fm) < WGM ? (nM - fm) : WGM;
        u.pm = fm + ((wgid % nig) % gsz); u.pn = (wgid % nig) / gsz; return true;
    }
    __device__ __forceinline__ void a_ready(const Unit&) const {}
    __device__ __forceinline__ void done(const Unit&) const {}
};

__device__ __forceinline__ unsigned cvt_pk_bf16(float lo, float hi) { unsigned r; asm volatile("v_cvt_pk_bf16_f32 %0, %1, %2" : "=v"(r) : "v"(lo), "v"(hi)); return r; }
struct EpiStore {
    static constexpr bool PERM = true, AFTER_DRAIN = false;
    bf16_t* O; int ldc; bf16_t* HALO;
    __device__ __forceinline__ void operator()(const f32x4 (&acc)[2][2][4][2], const Unit& u, int wr, int wc, int fr, int fq) const {
        const int row0 = u.pm * BM + wr * 64 + fr; const int col0 = u.pn * BM + wc * 32 + 8 * fq;
#pragma unroll
        for (int ai = 0; ai < 2; ++ai)
#pragma unroll
            for (int m = 0; m < 4; ++m) { const int row = row0 + ai * HALF + m * 16; bf16_t* rowp = O + (size_t)row * ldc + col0;
#pragma unroll
                for (int bj = 0; bj < 2; ++bj) { const f32x4 v0 = acc[ai][bj][m][0], v1 = acc[ai][bj][m][1];
                    u32x4 w; w.x = cvt_pk_bf16(v0[0], v0[1]); w.y = cvt_pk_bf16(v0[2], v0[3]); w.z = cvt_pk_bf16(v1[0], v1[1]); w.w = cvt_pk_bf16(v1[2], v1[3]);
                    *(u32x4*)(rowp + bj * HALF) = w;
                    if (HALO != nullptr && m == 3 && fr >= 13 && (col0 + bj * HALF) < 3072)
                        *(u32x4*)(HALO + ((size_t)(row >> 6) * 3 + (fr - 13)) * 3072 + col0 + bj * HALF) = w;
                } }
    }
};
template <bool RB, bool OB, bool PSUM = false>
struct EpiRes {
    static constexpr bool PERM = true, AFTER_DRAIN = false;
    const void* R; void* O; float* PS;
    __device__ __forceinline__ void operator()(const f32x4 (&acc)[2][2][4][2], const Unit& u, int wr, int wc, int fr, int fq) const {
        const int row0 = u.pm * BM + wr * 64 + fr; const int col0 = u.pn * BM + wc * 32 + 8 * fq;
#pragma unroll
        for (int ai = 0; ai < 2; ++ai)
#pragma unroll
            for (int m = 0; m < 4; ++m) { const size_t off = (size_t)(row0 + ai * HALF + m * 16) * 1024 + col0; float ssq = 0.f;
#pragma unroll
                for (int bj = 0; bj < 2; ++bj) {
                    f32x4 r0, r1;
                    if constexpr (RB) { const u32x4 w = *(const u32x4*)((const bf16_t*)R + off + bj * HALF);
                        r0 = (f32x4){__builtin_bit_cast(float, w.x << 16), __builtin_bit_cast(float, w.x & 0xffff0000u), __builtin_bit_cast(float, w.y << 16), __builtin_bit_cast(float, w.y & 0xffff0000u)};
                        r1 = (f32x4){__builtin_bit_cast(float, w.z << 16), __builtin_bit_cast(float, w.z & 0xffff0000u), __builtin_bit_cast(float, w.w << 16), __builtin_bit_cast(float, w.w & 0xffff0000u)}; }
                    else { r0 = *(const f32x4*)((const float*)R + off + bj * HALF); r1 = *(const f32x4*)((const float*)R + off + bj * HALF + 4); }
                    const f32x4 v0 = r0 + acc[ai][bj][m][0], v1 = r1 + acc[ai][bj][m][1];
                    if constexpr (OB) { u32x4 w; w.x = cvt_pk_bf16(v0[0], v0[1]); w.y = cvt_pk_bf16(v0[2], v0[3]); w.z = cvt_pk_bf16(v1[0], v1[1]); w.w = cvt_pk_bf16(v1[2], v1[3]);
                        *(u32x4*)((bf16_t*)O + off + bj * HALF) = w;
                        if constexpr (PSUM) {
#pragma unroll
                            for (int i = 0; i < 4; ++i) { const unsigned ww = (i == 0) ? w.x : (i == 1 ? w.y : (i == 2 ? w.z : w.w));
                                const float lo = __builtin_bit_cast(float, ww << 16), hi = __builtin_bit_cast(float, ww & 0xffff0000u); ssq += lo * lo + hi * hi; } } }
                    else { *(f32x4*)((float*)O + off + bj * HALF) = v0; *(f32x4*)((float*)O + off + bj * HALF + 4) = v1; }
                }
                if constexpr (PSUM) { ssq += __shfl_xor(ssq, 16); ssq += __shfl_xor(ssq, 32);
                    if (fq == 0) PS[(size_t)(row0 + ai * HALF + m * 16) * 16 + u.pn * 4 + wc] = ssq; } }
    }
};
struct EpiConvGate {
    static constexpr bool PERM = true, AFTER_DRAIN = false;
    bf16_t* Y; const float* wconv; float* CVH; float* BND;
    __device__ __forceinline__ void operator()(const f32x4 (&acc)[2][2][4][2], const Unit& u, int wr, int wc, int fr, int fq) const {
        const int ch0 = 64 * u.pn + 16 * wc + 4 * fq;
        const f32x4 w0 = *(const f32x4*)(wconv + ch0), w1 = *(const f32x4*)(wconv + 1024 + ch0), w2 = *(const f32x4*)(wconv + 2048 + ch0);
#pragma unroll
        for (int ai = 0; ai < 2; ++ai) {
            f32x4 p15 = (f32x4){0.f, 0.f, 0.f, 0.f}, p14 = (f32x4){0.f, 0.f, 0.f, 0.f};
#pragma unroll
            for (int m = 0; m < 4; ++m) {
                const int row = u.pm * BM + ai * HALF + wr * 64 + m * 16 + fr;
                const f32x4 b = acc[ai][0][m][0], c = acc[ai][0][m][1], v = acc[ai][1][m][0], z = acc[ai][1][m][1];
                const f32x4 cv = c * v;
                f32x4 y, n15, n14;
#pragma unroll
                for (int e = 0; e < 4; ++e) {
                    const float up1 = __shfl_up(cv[e], 1, 16), up2 = __shfl_up(cv[e], 2, 16);
                    const float cm1 = (fr >= 1) ? up1 : p15[e];
                    const float cm2 = (fr >= 2) ? up2 : ((fr == 1) ? p15[e] : p14[e]);
                    const float zz = z[e];
                    y[e] = b[e] * (w0[e] * cm2 + w1[e] * cm1 + w2[e] * cv[e]) * (zz / (1.f + __expf(-zz)));
                    n15[e] = __shfl(cv[e], 15, 16); n14[e] = __shfl(cv[e], 14, 16);
                }
                p15 = n15; p14 = n14;
                if (m > 0 || fr >= 2) {
                    unsigned long long o = (unsigned long long)cvt_pk_bf16(y[0], y[1]) | ((unsigned long long)cvt_pk_bf16(y[2], y[3]) << 32);
                    *(unsigned long long*)(Y + (size_t)row * 1024 + ch0) = o;
                } else {
                    float* bp = BND + ((size_t)(row >> 6) * 2 + fr) * 3 * 1024 + ch0;
                    *(f32x4*)bp = b; *(f32x4*)(bp + 1024) = z; *(f32x4*)(bp + 2048) = cv;
                }
                if (m == 3 && fr >= 14) *(f32x4*)(CVH + ((size_t)(row >> 6) * 2 + (fr - 14)) * 1024 + ch0) = cv;
            }
        }
    }
};
struct EpiStoreScaled {
    static constexpr bool PERM = true, AFTER_DRAIN = false;
    bf16_t* O; int ldc; const float* PS;
    __device__ __forceinline__ void operator()(const f32x4 (&acc)[2][2][4][2], const Unit& u, int wr, int wc, int fr, int fq) const {
        const int row0 = u.pm * BM + wr * 64 + fr; const int col0 = u.pn * BM + wc * 32 + 8 * fq;
#pragma unroll
        for (int ai = 0; ai < 2; ++ai)
#pragma unroll
            for (int m = 0; m < 4; ++m) { const int row = row0 + ai * HALF + m * 16; bf16_t* rowp = O + (size_t)row * ldc + col0;
                const f32x4* pp = (const f32x4*)(PS + (size_t)row * 16);
                const f32x4 s4 = (pp[0] + pp[1]) + (pp[2] + pp[3]);
                const float r = rsqrtf(((s4[0] + s4[1]) + (s4[2] + s4[3])) * (1.f / 1024.f) + 1e-6f);
#pragma unroll
                for (int bj = 0; bj < 2; ++bj) { const f32x4 v0 = acc[ai][bj][m][0] * r, v1 = acc[ai][bj][m][1] * r;
                    u32x4 w; w.x = cvt_pk_bf16(v0[0], v0[1]); w.y = cvt_pk_bf16(v0[2], v0[3]); w.z = cvt_pk_bf16(v1[0], v1[1]); w.w = cvt_pk_bf16(v1[2], v1[3]);
                    *(u32x4*)(rowp + bj * HALF) = w; } }
    }
};
template <class Epi, class Sched, bool ALIGN_EPI = false, bool SP2 = false>
__device__ __forceinline__ void gemm_phase(PG8_LAS unsigned char* lds, const Gemm g, const Sched& S, const Epi& E) {
    int tid_l = threadIdx.x; asm volatile("" : "+v"(tid_l));
    const int tid = tid_l, wid = __builtin_amdgcn_readfirstlane(tid >> 6), lane = tid & 63, wr = wid >> 2, wc = wid & 3, fr = lane & 15, fq = lane >> 4;
    const int K = g.K, nt = K / BK;
    unsigned voffA[2], voffB[2];
#pragma unroll
    for (int i = 0; i < 2; ++i) { int R, C; stage_rc(tid * 16 + i * 8192, R, C); const int Rb = Epi::PERM ? ((R & ~31) + perm32(R & 31)) : R;
        voffA[i] = (unsigned)(R * K + C) * 2u; voffB[i] = (unsigned)(Rb * K + C) * 2u; }
    const size_t kstep = (size_t)(BK * 2);
    const size_t hstep = (size_t)HALF * K * 2;
    const size_t tstep = 2 * hstep;
    const unsigned ldsw = (unsigned)wid * 1024u;
    const int aoff = lds_byte(wr * 64 + fr, fq * 8), boff = lds_byte(wc * 32 + fr, fq * 8);
#define PG8_SA(b, h) (((b) * 2 + (h)) * HTB)
#define PG8_SB(b, h) ((4 + (b) * 2 + (h)) * HTB)
#define PG8_STAGE(bufoff, gbase, voff) do { _Pragma("unroll") for (int _i = 0; _i < 2; ++_i) \
        __builtin_amdgcn_global_load_lds((const unsigned*)((const char*)(gbase) + (voff)[_i]), (PG8_LAS unsigned*)(lds + (bufoff) + ldsw + _i * 8192), 16, 0, 0); } while (0)
#define PG8_LDA(dst, b, h) do { _Pragma("unroll") for (int m = 0; m < 4; ++m) _Pragma("unroll") for (int k = 0; k < 2; ++k) dst[m][k] = *(const PG8_LAS bf16x8*)(lds + PG8_SA(b, h) + aoff + m * 2048 + k * 1024); } while (0)
#define PG8_LDB(dst, b, h) do { _Pragma("unroll") for (int n = 0; n < 2; ++n) _Pragma("unroll") for (int k = 0; k < 2; ++k) dst[n][k] = *(const PG8_LAS bf16x8*)(lds + PG8_SB(b, h) + boff + n * 2048 + k * 1024); } while (0)
#define PG8_MMA(ai, bj, At, Bt) do { __builtin_amdgcn_s_setprio(1); _Pragma("unroll") for (int m = 0; m < 4; ++m) _Pragma("unroll") for (int n = 0; n < 2; ++n) _Pragma("unroll") for (int k = 0; k < 2; ++k) \
        acc[ai][bj][m][n] = __builtin_amdgcn_mfma_f32_16x16x32_bf16(Bt[n][k], At[m][k], acc[ai][bj][m][n], 0, 0, 0); __builtin_amdgcn_s_setprio(0); } while (0)
#define PG8_WAIT_V(n) asm volatile("s_waitcnt vmcnt(" #n ")" ::: "memory")
#define PG8_WAIT_L(n) asm volatile("s_waitcnt lgkmcnt(" #n ")" ::: "memory")
#define PG8_BAR __builtin_amdgcn_s_barrier()
#define PG8_SCHED __builtin_amdgcn_sched_barrier(0)
    Unit cur, nxt; int ui = 0;
    if (!S.next(0, cur)) return;
    f32x4 acc[2][2][4][2];
#pragma unroll
    for (int a = 0; a < 2; ++a)
#pragma unroll
        for (int b = 0; b < 2; ++b)
#pragma unroll
            for (int m = 0; m < 4; ++m)
#pragma unroll
                for (int n = 0; n < 2; ++n) acc[a][b][m][n] = (f32x4){0.f, 0.f, 0.f, 0.f};
    bf16x8 At[4][2], B0[2][2], B1[2][2];
    const char* cA = (const char*)g.A + (size_t)cur.pm * tstep; const char* cB = (const char*)g.Bt + (size_t)cur.pn * tstep;
    S.a_ready(cur);
    if constexpr (SP2) {
        PG8_STAGE(PG8_SB(0, 0), cB, voffB); PG8_STAGE(PG8_SB(0, 1), cB + hstep, voffB); PG8_STAGE(PG8_SA(0, 0), cA, voffA); PG8_STAGE(PG8_SA(0, 1), cA + hstep, voffA);
        if (wr == 1) PG8_BAR;
        PG8_WAIT_V(2); PG8_BAR;
        PG8_STAGE(PG8_SB(1, 0), cB + kstep, voffB); PG8_STAGE(PG8_SA(1, 0), cA + kstep, voffA); PG8_STAGE(PG8_SB(1, 1), cB + hstep + kstep, voffB);
        PG8_WAIT_V(6); PG8_BAR;
    } else {
        PG8_STAGE(PG8_SB(0, 0), cB, voffB); PG8_STAGE(PG8_SA(0, 0), cA, voffA); PG8_STAGE(PG8_SB(0, 1), cB + hstep, voffB); PG8_STAGE(PG8_SA(0, 1), cA + hstep, voffA);
        if (wr == 1) PG8_BAR;
        PG8_WAIT_V(4); PG8_BAR;
        PG8_STAGE(PG8_SB(1, 0), cB + kstep, voffB); PG8_STAGE(PG8_SA(1, 0), cA + kstep, voffA); PG8_STAGE(PG8_SB(1, 1), cB + hstep + kstep, voffB);
        PG8_WAIT_V(6); PG8_BAR;
    }
    for (;;) {
        const bool has_next = S.next(ui + 1, nxt);
        const char* nA = has_next ? (const char*)g.A + (size_t)nxt.pm * tstep : cA; const char* nB = has_next ? (const char*)g.Bt + (size_t)nxt.pn * tstep : cB;
        for (int t = 0; t < nt; t += 2) {
            const bool last = (t == nt - 2);
            const char* a1 = cA + (size_t)(t + 1) * kstep;
            const char* a2 = last ? nA : cA + (size_t)(t + 2) * kstep; const char* b2 = last ? nB : cB + (size_t)(t + 2) * kstep;
            const char* a3 = a2 + kstep; const char* b3 = b2 + kstep;
            if (last && has_next) S.a_ready(nxt);
            if constexpr (SP2) {
            PG8_LDB(B0, 0, 0); PG8_LDB(B1, 0, 1); PG8_SCHED; PG8_LDA(At, 0, 0); PG8_STAGE(PG8_SA(1, 1), a1 + hstep, voffA);
            PG8_WAIT_V(8); PG8_WAIT_L(0); PG8_BAR; PG8_MMA(0, 0, At, B0); PG8_MMA(0, 1, At, B1); PG8_BAR; PG8_SCHED;
            PG8_LDA(At, 0, 1); PG8_STAGE(PG8_SB(0, 0), b2, voffB); PG8_STAGE(PG8_SB(0, 1), b2 + hstep, voffB); PG8_STAGE(PG8_SA(0, 0), a2, voffA);
            PG8_WAIT_V(8); PG8_WAIT_L(0); PG8_BAR; PG8_MMA(1, 0, At, B0); PG8_MMA(1, 1, At, B1); PG8_BAR; PG8_SCHED;
            PG8_LDB(B0, 1, 0); PG8_LDB(B1, 1, 1); PG8_SCHED; PG8_LDA(At, 1, 0); PG8_STAGE(PG8_SA(0, 1), a2 + hstep, voffA);
            PG8_WAIT_V(8); PG8_WAIT_L(0); PG8_BAR; PG8_MMA(0, 0, At, B0); PG8_MMA(0, 1, At, B1); PG8_BAR; PG8_SCHED;
            PG8_LDA(At, 1, 1); PG8_STAGE(PG8_SB(1, 0), b3, voffB); PG8_STAGE(PG8_SB(1, 1), b3 + hstep, voffB); PG8_STAGE(PG8_SA(1, 0), a3, voffA);
            PG8_WAIT_V(8); PG8_WAIT_L(0); PG8_BAR; PG8_MMA(1, 0, At, B0); PG8_MMA(1, 1, At, B1); PG8_BAR; PG8_SCHED;
            } else {
            PG8_LDB(B0, 0, 0); PG8_SCHED; PG8_LDA(At, 0, 0); PG8_STAGE(PG8_SA(1, 1), a1 + hstep, voffA);
            PG8_WAIT_L(8); PG8_BAR; PG8_WAIT_L(0); PG8_MMA(0, 0, At, B0); PG8_BAR; PG8_SCHED;
            PG8_LDB(B1, 0, 1); PG8_STAGE(PG8_SB(0, 0), b2, voffB);
            PG8_BAR; PG8_WAIT_L(0); PG8_MMA(0, 1, At, B1); PG8_BAR;
            PG8_LDA(At, 0, 1); PG8_STAGE(PG8_SA(0, 0), a2, voffA);
            PG8_BAR; PG8_WAIT_L(0); PG8_MMA(1, 0, At, B0); PG8_BAR; PG8_SCHED;
            PG8_STAGE(PG8_SB(0, 1), b2 + hstep, voffB);
            PG8_WAIT_V(6); PG8_BAR; PG8_MMA(1, 1, At, B1); PG8_BAR;
            PG8_LDB(B0, 1, 0); PG8_SCHED; PG8_LDA(At, 1, 0); PG8_STAGE(PG8_SA(0, 1), a2 + hstep, voffA);
            PG8_WAIT_L(8); PG8_BAR; PG8_WAIT_L(0); PG8_MMA(0, 0, At, B0); PG8_BAR; PG8_SCHED;
            PG8_LDB(B1, 1, 1); PG8_STAGE(PG8_SB(1, 0), b3, voffB);
            PG8_BAR; PG8_WAIT_L(0); PG8_MMA(0, 1, At, B1); PG8_BAR;
            PG8_LDA(At, 1, 1); PG8_STAGE(PG8_SA(1, 0), a3, voffA);
            PG8_BAR; PG8_WAIT_L(0); PG8_MMA(1, 0, At, B0); PG8_BAR; PG8_SCHED;
            PG8_STAGE(PG8_SB(1, 1), b3 + hstep, voffB);
            PG8_WAIT_V(6); PG8_BAR; PG8_MMA(1, 1, At, B1); PG8_BAR;
            }
        }
        if constexpr (ALIGN_EPI) { if (wr == 0) PG8_BAR; }
        if constexpr (!Epi::AFTER_DRAIN) { E(acc, cur, wr, wc, fr, fq); S.done(cur); }
        if (!has_next) break;
#pragma unroll
        for (int a = 0; a < 2; ++a)
#pragma unroll
            for (int b = 0; b < 2; ++b)
#pragma unroll
                for (int m = 0; m < 4; ++m)
#pragma unroll
                    for (int n = 0; n < 2; ++n) acc[a][b][m][n] = (f32x4){0.f, 0.f, 0.f, 0.f};
        cur = nxt; cA = nA; cB = nB; ++ui;
        if constexpr (ALIGN_EPI) { if (wr == 1) PG8_BAR; }
    }
    PG8_WAIT_V(0);
    if constexpr (!ALIGN_EPI) { if (wr == 0) PG8_BAR; }
    PG8_BAR;
    if constexpr (Epi::AFTER_DRAIN) { E.fused(acc, cur, wr, wc, fr, fq, lds, wid, lane); S.done(cur); }
#undef PG8_SA
#undef PG8_SB
#undef PG8_STAGE
#undef PG8_LDA
#undef PG8_LDB
#undef PG8_MMA
#undef PG8_WAIT_V
#undef PG8_WAIT_L
#undef PG8_BAR
#undef PG8_SCHED
}
}
#define XB_TMO      128
#define XB_XCNT(j)  (256  + 64 * (j))
#define XB_XSUB(j)  (1280 + 64 * (j))
#define XB_XGEN(j)  (2304 + 64 * (j))
#define XB_TOP      3328
#define XB_TOPGEN   3392
#define XCD_BAR_WORDS 3456
#define XB_SPIN_CAP (1u << 18)

__device__ __forceinline__ unsigned xb_ld(unsigned* p)              { return __hip_atomic_load(p, __ATOMIC_RELAXED, __HIP_MEMORY_SCOPE_AGENT); }
__device__ __forceinline__ unsigned xb_add(unsigned* p, unsigned v) { return __hip_atomic_fetch_add(p, v, __ATOMIC_RELAXED, __HIP_MEMORY_SCOPE_AGENT); }
__device__ __forceinline__ unsigned xb_xcc_id() { return (unsigned)__builtin_amdgcn_s_getreg((3 << 11) | 20) & 0xFu; }
#define XB_SPIN(cond, bar) do { unsigned _sp = 0; while (cond) { __builtin_amdgcn_s_sleep(1); \
    if ((++_sp & 255u) == 0u) { if (xb_ld(&(bar)[XB_TMO])) break; if (_sp > XB_SPIN_CAP) { atomicAdd(&(bar)[XB_TMO], 1u); break; } } } } while (0)

struct XcdBarrier {
    unsigned* bar; unsigned x;
    volatile LAS unsigned* st;
};

__device__ __forceinline__ XcdBarrier xcd_barrier_post(unsigned* bar, volatile LAS unsigned* st) {
    XcdBarrier b; b.bar = bar; b.x = xb_xcc_id(); b.st = st;
    if (threadIdx.x == 0) (void)xb_add(&bar[XB_XCNT(b.x)], 1u);
    return b;
}
__device__ __forceinline__ void xcd_barrier_complete(unsigned* bar, unsigned x, unsigned& nloc, unsigned& nx) {
    const unsigned G = gridDim.x * gridDim.y * gridDim.z;
    unsigned sum, cnt, mine, sp = 0u;
    for (;;) {
        sum = 0u; cnt = 0u; mine = 0u;
#pragma unroll
        for (unsigned j = 0; j < 16; ++j) { const unsigned c = xb_ld(&bar[XB_XCNT(j)]); sum += c; cnt += (c > 0u) ? 1u : 0u; mine = (j == x) ? c : mine; }
        if (sum == G) break;
        __builtin_amdgcn_s_sleep(1);
        if ((++sp & 255u) == 0u) { if (xb_ld(&bar[XB_TMO])) break; if (sp > XB_SPIN_CAP) { atomicAdd(&bar[XB_TMO], 1u); break; } }
    }
    nloc = mine > 0u ? mine : 1u; nx = cnt > 0u ? cnt : 1u;
}

__device__ __forceinline__ void xcd_barrier(const XcdBarrier& b) {
    asm volatile("s_waitcnt vmcnt(0)" ::: "memory");
    __syncthreads();
    if (threadIdx.x == 0) {
        unsigned* bar = b.bar;
        __builtin_amdgcn_s_waitcnt(0);
        unsigned nloc = b.st[0], nx = b.st[1];
        if (nloc == 0u) { xcd_barrier_complete(bar, b.x, nloc, nx); b.st[0] = nloc; b.st[1] = nx; }
        const unsigned old = xb_add(&bar[XB_XSUB(b.x)], 1u);
        const unsigned gen = old / nloc;
        if (old + 1u == (gen + 1u) * nloc) {
            __builtin_amdgcn_fence(__ATOMIC_RELEASE, "agent");
            asm volatile("s_waitcnt vmcnt(0)" ::: "memory");
            const unsigned og = xb_add(&bar[XB_TOP], 1u);
            const unsigned tg = og / nx;
            if (og + 1u == (tg + 1u) * nx) xb_add(&bar[XB_TOPGEN], 1u);
            else XB_SPIN(xb_ld(&bar[XB_TOPGEN]) == tg, bar);
            __builtin_amdgcn_fence(__ATOMIC_ACQUIRE, "agent");
            xb_add(&bar[XB_XGEN(b.x)], 1u);
            asm volatile("s_waitcnt vmcnt(0)" ::: "memory");
        } else {
            XB_SPIN(xb_ld(&bar[XB_XGEN(b.x)]) == gen, bar);
            __builtin_amdgcn_fence(__ATOMIC_ACQUIRE, "agent");
            asm volatile("s_waitcnt vmcnt(0)" ::: "memory");
        }
    }
    __syncthreads();
}

template <bool CONVPERM = false>
DI void p0_transpose_item(const float* W, int K, int ldw, int ncols, bf16* WT, LAS float* scr, int item, int lane, const float* rowscale = nullptr) {
    const int nblk = ncols / 32, kb = item / nblk, nb = item % nblk, k0 = 64 * kb, n0 = 32 * nb;
#pragma unroll 8
    for (int i = 0; i < 32; ++i) { const int kk = 2 * i + (lane >> 5); float wv = W[(size_t)(k0 + kk) * ldw + n0 + (lane & 31)]; if (rowscale != nullptr) wv *= rowscale[k0 + kk];
        scr[kk * 33 + (lane & 31)] = wv; }
    asm volatile("s_waitcnt lgkmcnt(0)" ::: "memory");
    const int c = lane & 7;
#pragma unroll
    for (int j = 0; j < 4; ++j) { const int n = (lane >> 3) + 8 * j; const LAS float* s = scr + (8 * c) * 33 + n;
        v4u o; o.x = pk2(s[0 * 33], s[1 * 33]); o.y = pk2(s[2 * 33], s[3 * 33]); o.z = pk2(s[4 * 33], s[5 * 33]); o.w = pk2(s[6 * 33], s[7 * 33]);
        int orow = n0 + n;
        if constexpr (CONVPERM) { const int sct = orow >> 10, ch = orow & 1023;
            orow = 256 * (ch >> 6) + 128 * (sct >> 1) + 32 * ((ch >> 4) & 3) + 8 * ((ch >> 2) & 3) + 4 * (sct & 1) + (ch & 3); }
        *(v4u*)(WT + (size_t)orow * K + k0 + 8 * c) = o; }
    asm volatile("s_waitcnt lgkmcnt(0)" ::: "memory");
}

struct Ptrs {
    const float* in[19]; float* out; unsigned char* ws; int ph_lo, ph_hi;
};

DI void p0_prologue(const Ptrs& P, LAS unsigned char* lds, int gw, int NGW, int wave, int lane) {
    LAS float* scr = (LAS float*)(lds + wave * 16384);
    unsigned char* ws = P.ws;
    constexpr int I_IN = 16 * 128, I_OUT = 16 * 32, I_SWA = 16 * 80;
    constexpr int NIT = 3 * I_IN + I_SWA + 4 * I_OUT;
    for (int it = gw; it < NIT; it += NGW) {
        int r = it;
        if (r < I_IN) { p0_transpose_item<true>(P.in[4], 1024, 4096, 4096, (bf16*)(ws + WS_W0I), scr, r, lane); continue; } r -= I_IN;
        if (r < I_IN) { p0_transpose_item(P.in[7], 1024, 4104, 4096, (bf16*)(ws + WS_W1I), scr, r, lane); continue; } r -= I_IN;
        if (r < I_IN) { p0_transpose_item(P.in[10], 1024, 4112, 4096, (bf16*)(ws + WS_W2I), scr, r, lane); continue; } r -= I_IN;
        if (r < I_SWA) { p0_transpose_item(P.in[16], 1024, 2560, 2560, (bf16*)(ws + WS_W3I), scr, r, lane, P.in[2] + 3072); continue; } r -= I_SWA;
        if (r < I_OUT) { p0_transpose_item(P.in[6], 1024, 1024, 1024, (bf16*)(ws + WS_W0O), scr, r, lane); continue; } r -= I_OUT;
        if (r < I_OUT) { p0_transpose_item(P.in[9], 1024, 1024, 1024, (bf16*)(ws + WS_W1O), scr, r, lane); continue; } r -= I_OUT;
        if (r < I_OUT) { p0_transpose_item(P.in[15], 1024, 1024, 1024, (bf16*)(ws + WS_W2O), scr, r, lane); continue; } r -= I_OUT;
        p0_transpose_item(P.in[18], 1024, 1024, 1024, (bf16*)(ws + WS_W3O), scr, r, lane);
    }
}

template <int MODE, bool XBF = false>
DI void norm_phase(const float* X, const float* nw, bf16* H, float* OUTF, const float* W, int ldw, float* oa, float* ob, const float* p0, const float* p1, const float* p2,
                   const int* pos, LAS unsigned char* lds, int gw, int NGW, int tid, int lane) {
    constexpr int NT = (MODE == 1) ? 8 : (MODE == 2 ? 16 : 0);
    LAS f32x4* thin = (LAS f32x4*)lds;
    if constexpr (NT > 0) {
        for (int i = tid; i < 1024 * (NT / 4); i += NTHR) { const int k = i / (NT / 4), c4 = i % (NT / 4);
            const f32x4 v = *(const f32x4*)(W + (size_t)k * ldw + 4096 + 4 * c4);
            const int j = k >> 8, l = (k & 255) >> 2, e = k & 3;
            thin[c4 * 1024 + (j * 4 + e) * 64 + l] = v; }
        __syncthreads();
    }
    constexpr int NR = (NT == 16) ? 2 : 4;
    f32x4 nwv[4];
#pragma unroll
    for (int j = 0; j < 4; ++j) nwv[j] = *((const f32x4*)nw + lane + 64 * j);
    for (int row0 = gw * NR; row0 < TT; row0 += NGW * NR) {
        f32x4 vv[NR][4];
#pragma unroll
        for (int rr = 0; rr < NR; ++rr) {
            if constexpr (XBF) { const v2u* xr = (const v2u*)((const bf16*)X + (size_t)(row0 + rr) * DM) + lane;
#pragma unroll
                for (int j = 0; j < 4; ++j) { const v2u u = xr[64 * j]; vv[rr][j] = (f32x4){bflo(u.x), bfhi(u.x), bflo(u.y), bfhi(u.y)}; } }
            else { const f32x4* xr = (const f32x4*)(X + (size_t)(row0 + rr) * DM) + lane;
#pragma unroll
                for (int j = 0; j < 4; ++j) vv[rr][j] = xr[64 * j]; } }
#pragma unroll
        for (int rr = 0; rr < NR; ++rr) {
        const int row = row0 + rr;
        f32x4 v[4]; float s = 0.f;
#pragma unroll
        for (int j = 0; j < 4; ++j) { v[j] = vv[rr][j]; s += (v[j].x * v[j].x + v[j].y * v[j].y) + (v[j].z * v[j].z + v[j].w * v[j].w); }
        const float r = rsqrtf(wave_sum(s) * (1.f / DM) + EPS);
#pragma unroll
        for (int j = 0; j < 4; ++j) { v[j] = v[j] * r * nwv[j]; vv[rr][j] = v[j]; }
        if constexpr (MODE == 4) {
            f32x4* o = (f32x4*)(OUTF + (size_t)row * DM) + lane;
#pragma unroll
            for (int j = 0; j < 4; ++j) o[64 * j] = v[j];
        } else {
            unsigned long long* o8 = (unsigned long long*)(H + (size_t)row * DM) + lane;
#pragma unroll
            for (int j = 0; j < 4; ++j) o8[64 * j] = (unsigned long long)pk2(v[j].x, v[j].y) | ((unsigned long long)pk2(v[j].z, v[j].w) << 32);
        }
        if constexpr (MODE == 3) {
            if (lane < 32) { const float inv = powf(10000.f, -(float)lane * (1.f / 32.f)); const float ang = (float)pos[row] * inv; float sn, cs; sincosf(ang, &sn, &cs);
                oa[(size_t)row * 64 + lane] = cs; oa[(size_t)row * 64 + 32 + lane] = sn; }
        }
        }
        if constexpr (NT > 0) {
            constexpr int RG = (NT == 16) ? 1 : NR;
#pragma unroll
            for (int r0 = 0; r0 < NR; r0 += RG) {
            f32x4 a[RG][NT / 4];
#pragma unroll
            for (int rr = 0; rr < RG; ++rr)
#pragma unroll
                for (int c = 0; c < NT / 4; ++c) a[rr][c] = (f32x4){0.f, 0.f, 0.f, 0.f};
#pragma unroll
            for (int j = 0; j < 4; ++j)
#pragma unroll
                for (int e = 0; e < 4; ++e) {
#pragma unroll
                    for (int c = 0; c < NT / 4; ++c) { const f32x4 w = thin[c * 1024 + (j * 4 + e) * 64 + lane];
#pragma unroll
                        for (int rr = 0; rr < RG; ++rr) a[rr][c] += w * vv[r0 + rr][j][e]; }
                    __builtin_amdgcn_sched_barrier(0); }
#pragma unroll
            for (int rr = 0; rr < RG; ++rr) {
                const int row = row0 + r0 + rr;
                float t8[NT / 2];
#pragma unroll
                for (int i = 0; i < NT / 2; ++i) { const float x0 = a[rr][(2 * i) >> 2][(2 * i) & 3], x1 = a[rr][(2 * i + 1) >> 2][(2 * i + 1) & 3];
                    const bool bb = lane & 1; const float mine = bb ? x1 : x0, send = bb ? x0 : x1; t8[i] = mine + __shfl_xor(send, 1); }
                float t4[NT / 4];
#pragma unroll
                for (int i = 0; i < NT / 4; ++i) { const bool bb = lane & 2; const float mine = bb ? t8[2 * i + 1] : t8[2 * i], send = bb ? t8[2 * i] : t8[2 * i + 1]; t4[i] = mine + __shfl_xor(send, 2); }
                float t2[NT / 8];
#pragma unroll
                for (int i = 0; i < NT / 8; ++i) { const bool bb = lane & 4; const float mine = bb ? t4[2 * i + 1] : t4[2 * i], send = bb ? t4[2 * i] : t4[2 * i + 1]; t2[i] = mine + __shfl_xor(send, 4); }
                float tc;
                if constexpr (NT == 16) { const bool bb = lane & 8; const float mine = bb ? t2[1] : t2[0], send = bb ? t2[0] : t2[1]; tc = mine + __shfl_xor(send, 8); }
                else { tc = t2[0]; tc += __shfl_xor(tc, 8); }
                tc += __shfl_xor(tc, 16); tc += __shfl_xor(tc, 32);
                if constexpr (MODE == 1) {
                    if (lane < 8) { const float xx = tc + p0[lane]; oa[(size_t)row * 8 + lane] = fminf(xx, 0.f) - log1pf(__expf(-fabsf(xx))); }
                } else {
                    const float ma = __shfl(tc, (lane + 8) & 63);
                    if (lane < 8) { oa[(size_t)row * 8 + lane] = 1.f / (1.f + __expf(-tc));
                        ob[(size_t)row * 8 + lane] = -__expf(p0[lane]) * softplus_f(ma + p1[lane]); }
                }
            }
            }
        }
    }
    if constexpr (NT > 0) __syncthreads();
}

DI void convgate_phase(const bf16* PROJ, const float* wconv, bf16* Y, int gtid, int NG) {
    for (int it = gtid; it < (TT / 32) * 128; it += NG) {
        const int oct = it & 127, chunk = it >> 7, r0 = chunk * 32, c0 = oct * 8;
        float w0[8], w1[8], w2[8];
#pragma unroll
        for (int e = 0; e < 8; ++e) { w0[e] = wconv[c0 + e]; w1[e] = wconv[1024 + c0 + e]; w2[e] = wconv[2048 + c0 + e]; }
        float p2[8], p1[8];
#pragma unroll
        for (int e = 0; e < 8; ++e) { p2[e] = 0.f; p1[e] = 0.f; }
        if ((r0 & (SEQ - 1)) != 0) {
#pragma unroll
            for (int d = 2; d >= 1; --d) { const bf16* rp = PROJ + (size_t)(r0 - d) * 4096 + c0;
                const v4u cc = *(const v4u*)(rp + 1024), vv = *(const v4u*)(rp + 2048);
#pragma unroll
                for (int e = 0; e < 4; ++e) { const float a = bflo(cc[e]) * bflo(vv[e]), b = bfhi(cc[e]) * bfhi(vv[e]);
                    if (d == 2) { p2[2 * e] = a; p2[2 * e + 1] = b; } else { p1[2 * e] = a; p1[2 * e + 1] = b; } } }
        }
#pragma unroll 4
        for (int r = 0; r < 32; ++r) {
            const bf16* rp = PROJ + (size_t)(r0 + r) * 4096 + c0;
            const v4u bb = *(const v4u*)(rp), cc = *(const v4u*)(rp + 1024), vv = *(const v4u*)(rp + 2048), zz = *(const v4u*)(rp + 3072);
            float y[8];
#pragma unroll
            for (int e = 0; e < 4; ++e) {
                const float cv0 = bflo(cc[e]) * bflo(vv[e]), cv1 = bfhi(cc[e]) * bfhi(vv[e]);
                const float o0 = w0[2 * e] * p2[2 * e] + w1[2 * e] * p1[2 * e] + w2[2 * e] * cv0;
                const float o1 = w0[2 * e + 1] * p2[2 * e + 1] + w1[2 * e + 1] * p1[2 * e + 1] + w2[2 * e + 1] * cv1;
                p2[2 * e] = p1[2 * e]; p1[2 * e] = cv0; p2[2 * e + 1] = p1[2 * e + 1]; p1[2 * e + 1] = cv1;
                y[2 * e] = bflo(bb[e]) * o0 * silu_f(bflo(zz[e])); y[2 * e + 1] = bfhi(bb[e]) * o1 * silu_f(bfhi(zz[e]));
            }
            v4u o; o.x = pk2(y[0], y[1]); o.y = pk2(y[2], y[3]); o.z = pk2(y[4], y[5]); o.w = pk2(y[6], y[7]);
            *(v4u*)(Y + (size_t)(r0 + r) * 1024 + c0) = o;
        }
    }
}

DI void convfix_phase(const float* CVH, const float* BND, const float* wconv, bf16* Y, int gtid, int NG) {
    for (int it = gtid; it < 512 * 2 * 256; it += NG) {
        const int c4 = it & 255, r = (it >> 8) & 1, g = it >> 9, ch0 = 4 * c4;
        const float* bp = BND + ((size_t)g * 2 + r) * 3 * 1024 + ch0;
        const f32x4 b = *(const f32x4*)bp, z = *(const f32x4*)(bp + 1024), cv = *(const f32x4*)(bp + 2048);
        f32x4 cm1 = (f32x4){0.f, 0.f, 0.f, 0.f}, cm2 = (f32x4){0.f, 0.f, 0.f, 0.f};
        const bool first = (g & 255) == 0;
        if (r == 0) { if (!first) { cm1 = *(const f32x4*)(CVH + ((size_t)(g - 1) * 2 + 1) * 1024 + ch0); cm2 = *(const f32x4*)(CVH + ((size_t)(g - 1) * 2) * 1024 + ch0); } }
        else { cm1 = *(const f32x4*)(BND + ((size_t)g * 2) * 3 * 1024 + 2048 + ch0); if (!first) cm2 = *(const f32x4*)(CVH + ((size_t)(g - 1) * 2 + 1) * 1024 + ch0); }
        const f32x4 w0 = *(const f32x4*)(wconv + ch0), w1 = *(const f32x4*)(wconv + 1024 + ch0), w2 = *(const f32x4*)(wconv + 2048 + ch0);
        float y[4];
#pragma unroll
        for (int e = 0; e < 4; ++e) y[e] = b[e] * (w0[e] * cm2[e] + w1[e] * cm1[e] + w2[e] * cv[e]) * silu_f(z[e]);
        v2u o; o.x = pk2(y[0], y[1]); o.y = pk2(y[2], y[3]);
        *(v2u*)(Y + ((size_t)g * 64 + r) * 1024 + ch0) = o;
    }
}
DI int crow32(int i, int hi) { return (i & 3) + 8 * (i >> 2) + 4 * hi; }
DI int perm16(int p) { return (p & 3) | ((p & 4) << 1) | ((p & 8) >> 1); }
#define MFMA32(a, b, c) __builtin_amdgcn_mfma_f32_32x32x16_bf16((a), (b), (c), 0, 0, 0)
#define MFMA16(a, b, c) __builtin_amdgcn_mfma_f32_16x16x32_bf16((a), (b), (c), 0, 0, 0)

DI void fox_cumsum(const float* LOGF, float* CUM, int bh, LAS unsigned char* lds, int tid) {
    LAS double* tot = (LAS double*)lds;
    const int b = bh >> 3, h = bh & 7;
    const float* src = LOGF + ((size_t)b * SEQ + 32 * tid) * 8 + h;
    float v[32]; double s = 0.0;
#pragma unroll
    for (int i = 0; i < 32; ++i) { v[i] = src[i * 8]; s += (double)v[i]; }
    double inc = s;
    const int ln = tid & 63, wv = tid >> 6;
#pragma unroll
    for (int o = 1; o < 64; o <<= 1) { const double t = __shfl_up(inc, o); if (ln >= o) inc += t; }
    if (ln == 63) tot[wv] = inc;
    __syncthreads();
    double pre = inc - s;
    for (int i = 0; i < wv; ++i) pre += tot[i];
    float* dst = CUM + (size_t)bh * SEQ + 32 * tid;
#pragma unroll
    for (int i = 0; i < 32; ++i) { pre += (double)v[i]; dst[i] = (float)pre; }
    __syncthreads();
}

DI void fox_norms_phase(const bf16* PROJ, float* NRMT, int gw, int NGW, int lane) {
    for (int it = gw; it < 16 * 256; it += NGW) {
        const int bh = it >> 8, tl = it & 255, b = bh >> 3, h = bh & 7;
        const size_t r0 = (size_t)b * SEQ + 64 * tl;
        float mk = 0.f;
#pragma unroll
        for (int rr = 0; rr < 8; ++rr) {
            const int row = 8 * rr + (lane >> 3), seg = lane & 7; const bf16* qp = PROJ + (r0 + row) * 4096 + h * 128 + 16 * seg;
            const v4u b0 = *(const v4u*)(qp + 1024), b1 = *(const v4u*)(qp + 1032);
            float sk = 0.f;
#pragma unroll
            for (int e = 0; e < 4; ++e) sk += bflo(b0[e]) * bflo(b0[e]) + bfhi(b0[e]) * bfhi(b0[e]) + bflo(b1[e]) * bflo(b1[e]) + bfhi(b1[e]) * bfhi(b1[e]);
#pragma unroll
            for (int o = 1; o < 8; o <<= 1) sk += __shfl_xor(sk, o);
            mk = fmaxf(mk, sk);
        }
#pragma unroll
        for (int o = 8; o < 64; o <<= 1) mk = fmaxf(mk, __shfl_xor(mk, o));
        if (lane == 0) NRMT[(size_t)it * 2 + 1] = mk;
    }
}

constexpr int FX_KB = 64 * 272, FX_VB = 64 * 320;
typedef short v4i16_t __attribute__((ext_vector_type(4)));
DI v4i16_t fx_vtr(const LAS unsigned char* p) { return __builtin_amdgcn_ds_read_tr16_b64_v4i16((LAS v4i16_t*)p); }
DI void fox_attn_phase(const bf16* PROJ, const float* CUM, bf16* Y, const float* NRMT, unsigned* QCTR, LAS unsigned char* lds, int bid, int G, int tid, int wave, int lane) {
    LAS unsigned char* Kb = lds; LAS unsigned char* Vb = lds + 2 * FX_KB; LAS float* Bs = (LAS float*)(lds + 2 * FX_KB + 2 * FX_VB);
    const int r = lane & 31, hi = lane >> 5;
    const float SQD = 11.313708498984761f;
    const float c2 = 0.08838834764831845f * 1.4426950408889634f;
    LAS unsigned* Qs = (LAS unsigned*)(lds + 2 * FX_KB + 2 * FX_VB + 512);
    LAS float* Mq = (LAS float*)(lds + 2 * FX_KB + 2 * FX_VB + 704);
    LAS float* Ms = (LAS float*)(lds + 2 * FX_KB + 2 * FX_VB + 576);
    for (;;) {
        if (tid == 0) Qs[0] = atomicAdd(QCTR, 1u);
        __syncthreads();
        const int e = (int)Qs[0];
        __syncthreads();
        if (e >= 1024) break;
        {
            const int bh = e & 15, qb = 63 - (e >> 4), b = bh >> 3, h = bh & 7;
            const int q0 = qb * 256, ntiles = 4 * (qb + 1);
            const float cref = CUM[(size_t)bh * SEQ + q0];
            const int qmin = q0 + 32 * wave;
            bf16x8 Qf[8];
            { const bf16* qp = PROJ + ((size_t)b * SEQ + qmin + r) * 4096 + h * 128 + 8 * hi;
#pragma unroll
              for (int ks = 0; ks < 8; ++ks) Qf[ks] = *(const bf16x8*)(qp + 16 * ks); }
            { float qn = 0.f;
#pragma unroll
              for (int ks = 0; ks < 8; ++ks) { const v4u w = __builtin_bit_cast(v4u, Qf[ks]);
#pragma unroll
                  for (int e = 0; e < 4; ++e) qn += bflo(w[e]) * bflo(w[e]) + bfhi(w[e]) * bfhi(w[e]); }
              qn += __shfl_xor(qn, 32);
#pragma unroll
              for (int o = 1; o < 32; o <<= 1) qn = fmaxf(qn, __shfl_xor(qn, o));
              if (lane == 0) Mq[wave] = qn; }
            __syncthreads();
            int jstart; float Bq;
            { float mq = Mq[0], mk = 0.f;
#pragma unroll
              for (int w = 1; w < 8; ++w) mq = fmaxf(mq, Mq[w]);
#pragma unroll
              for (int u = 0; u < 4; ++u) mk = fmaxf(mk, NRMT[((size_t)bh * 256 + lane + 64 * u) * 2 + 1]);
#pragma unroll
              for (int o = 1; o < 64; o <<= 1) mk = fmaxf(mk, __shfl_xor(mk, o));
              Bq = sqrtf(mq * mk);
              const float B2 = 2.f * Bq * 0.08838834764831845f;
              const float thr = -(30.f + B2);
              const int jc = (lane * (4 * qb)) >> 6;
              const bool live = (qb == 0) ? true : ((cref - CUM[(size_t)bh * SEQ + 64 * jc + 63]) > thr);
              const unsigned long long m = __ballot(live);
              const int fl = (m == 0ull) ? 64 : (__ffsll((long long)m) - 1);
              const int pl = fl > 0 ? fl - 1 : 0;
              jstart = (qb == 0) ? 0 : ((pl * (4 * qb)) >> 6);
              jstart = __builtin_amdgcn_readfirstlane(jstart); }
            f32x16 O[4];
#pragma unroll
            for (int dt = 0; dt < 4; ++dt)
#pragma unroll
                for (int i = 0; i < 16; ++i) O[dt][i] = 0.f;
            float m_old = -INFINITY, lsum = 0.f;
            const bf16* kg[2]; const bf16* vg[2]; int klds[2], vlds[2];
#pragma unroll
            for (int u = 0; u < 2; ++u) { const int p = tid + 512 * u;
                kg[u] = PROJ + ((size_t)b * SEQ + (p >> 4)) * 4096 + 1024 + h * 128 + 8 * (p & 15); klds[u] = (p >> 4) * 272 + (p & 15) * 16;
                vg[u] = PROJ + ((size_t)b * SEQ + (p >> 4)) * 4096 + 2048 + h * 128 + 8 * (p & 15); vlds[u] = (p >> 4) * 320 + (p & 15) * 16; }
            v4u kr[2], vr[2]; float br = 0.f;
            const int jlast = ntiles - 1;
#pragma unroll
            for (int u = 0; u < 2; ++u) { kr[u] = *(const v4u*)(kg[u] + (size_t)jlast * 64 * 4096); vr[u] = *(const v4u*)(vg[u] + (size_t)jlast * 64 * 4096); }
            if (tid < 64) br = (cref - CUM[(size_t)bh * SEQ + jlast * 64 + tid]) * SQD;
#pragma unroll
            for (int u = 0; u < 2; ++u) { *(LAS v4u*)(Kb + (jlast & 1) * FX_KB + klds[u]) = kr[u]; *(LAS v4u*)(Vb + (jlast & 1) * FX_VB + vlds[u]) = vr[u]; }
            if (tid < 64) Bs[(jlast & 1) * 64 + tid] = br;
            __syncthreads();
            for (int j = jlast; j >= jstart; --j) {
                const int cur = j & 1, nxt = cur ^ 1;
                if (j > jstart) {
#pragma unroll
                    for (int u = 0; u < 2; ++u) { kr[u] = *(const v4u*)(kg[u] + (size_t)(j - 1) * 64 * 4096); vr[u] = *(const v4u*)(vg[u] + (size_t)(j - 1) * 64 * 4096); }
                    if (tid < 64) br = (cref - CUM[(size_t)bh * SEQ + (j - 1) * 64 + tid]) * SQD;
                }
                if (64 * j <= qmin + 31) {
                    LAS unsigned char* Kc = Kb + cur * FX_KB; LAS unsigned char* Vc = Vb + cur * FX_VB; LAS float* Bc = Bs + cur * 64;
                    f32x16 S[2];
#pragma unroll
                    for (int sub = 0; sub < 2; ++sub) {
#pragma unroll
                        for (int g = 0; g < 4; ++g) { const f32x4 bv = *(const LAS f32x4*)(Bc + 32 * sub + 8 * g + 4 * hi);
                            S[sub][4 * g] = bv.x; S[sub][4 * g + 1] = bv.y; S[sub][4 * g + 2] = bv.z; S[sub][4 * g + 3] = bv.w; }
#pragma unroll
                        for (int ks = 0; ks < 8; ++ks) { const bf16x8 a = *(const LAS bf16x8*)(Kc + (32 * sub + r) * 272 + (16 * ks + 8 * hi) * 2);
                            S[sub] = MFMA32(a, Qf[ks], S[sub]); }
                    }
                    if (64 * j + 63 > qmin) {
                        const int qi = qmin + r;
#pragma unroll
                        for (int sub = 0; sub < 2; ++sub)
#pragma unroll
                            for (int i = 0; i < 16; ++i) { const int key = 64 * j + 32 * sub + crow32(i, hi); if (key > qi) S[sub][i] = -INFINITY; }
                    }
                    float mx = S[0][0];
#pragma unroll
                    for (int i = 1; i < 16; ++i) mx = fmaxf(mx, S[0][i]);
#pragma unroll
                    for (int i = 0; i < 16; ++i) mx = fmaxf(mx, S[1][i]);
                    mx = fmaxf(mx, __shfl_xor(mx, 32));
                    const float m_new = fmaxf(m_old, mx);
                    const float alpha = __builtin_amdgcn_exp2f((m_old - m_new) * c2);
                    const float nm = -m_new * c2;
                    m_old = m_new;
                    float ps = 0.f;
#pragma unroll
                    for (int sub = 0; sub < 2; ++sub)
#pragma unroll
                        for (int i = 0; i < 16; ++i) { const float p = __builtin_amdgcn_exp2f(fmaf(S[sub][i], c2, nm)); S[sub][i] = p; ps += p; }
                    lsum = lsum * alpha + ps;
                    if (!__all(alpha == 1.f)) {
#pragma unroll
                        for (int dt = 0; dt < 4; ++dt)
#pragma unroll
                            for (int i = 0; i < 16; ++i) O[dt][i] *= alpha;
                    }
                    bf16x8 Pf[4];
#pragma unroll
                    for (int kk = 0; kk < 4; ++kk) { const int sub = kk >> 1, s = kk & 1; v4u w;
                        w.x = pk2(S[sub][8 * s], S[sub][8 * s + 1]); w.y = pk2(S[sub][8 * s + 2], S[sub][8 * s + 3]);
                        w.z = pk2(S[sub][8 * s + 4], S[sub][8 * s + 5]); w.w = pk2(S[sub][8 * s + 6], S[sub][8 * s + 7]);
                        Pf[kk] = __builtin_bit_cast(bf16x8, w); }
#pragma unroll
                    for (int dt = 0; dt < 4; ++dt) {
#pragma unroll
                        for (int kk = 0; kk < 4; ++kk) {
                            const LAS unsigned char* vp = Vc + (16 * kk + 4 * hi + ((lane & 15) >> 2)) * 320 + 64 * dt + 32 * ((lane >> 4) & 1) + 8 * (lane & 3);
                            const v4i16_t lo = fx_vtr(vp), hi4 = fx_vtr(vp + 8 * 320);
                            const bf16x8 a = __builtin_shufflevector(lo, hi4, 0, 1, 2, 3, 4, 5, 6, 7);
                            O[dt] = MFMA32(a, Pf[kk], O[dt]); } }
                }
                { float mm = m_old;
#pragma unroll
                  for (int o = 1; o < 32; o <<= 1) mm = fminf(mm, __shfl_xor(mm, o));
                  if (lane == 0) Ms[cur * 8 + wave] = mm; }
                if (j > jstart) {
#pragma unroll
                    for (int u = 0; u < 2; ++u) { *(LAS v4u*)(Kb + nxt * FX_KB + klds[u]) = kr[u]; *(LAS v4u*)(Vb + nxt * FX_VB + vlds[u]) = vr[u]; }
                    if (tid < 64) Bs[nxt * 64 + tid] = br;
                }
                __syncthreads();
                if (j > jstart) { float mn = Ms[cur * 8];
#pragma unroll
                    for (int w = 1; w < 8; ++w) mn = fminf(mn, Ms[cur * 8 + w]);
                    if ((Bq + Bs[nxt * 64 + 63] - mn) * 0.08838834764831845f <= -30.f) break; }
            }
            const float lt = lsum + __shfl_xor(lsum, 32);
            const float inv = 1.f / lt;
            const size_t trow = (size_t)b * SEQ + qmin + r;
#pragma unroll
            for (int dt = 0; dt < 4; ++dt)
#pragma unroll
                for (int g = 0; g < 4; ++g) { const int d = 32 * dt + 8 * g + 4 * hi;
                    const v2u z = *(const v2u*)(PROJ + trow * 4096 + 3072 + h * 128 + d);
                    const float y0 = O[dt][4 * g] * inv * silu_f(bflo(z.x)), y1 = O[dt][4 * g + 1] * inv * silu_f(bfhi(z.x));
                    const float y2 = O[dt][4 * g + 2] * inv * silu_f(bflo(z.y)), y3 = O[dt][4 * g + 3] * inv * silu_f(bfhi(z.y));
                    v2u o; o.x = pk2(y0, y1); o.y = pk2(y2, y3);
                    *(v2u*)(Y + trow * 1024 + h * 128 + d) = o; }
        }
    }
}
DI constexpr int tq_slot(int f) { return f == 0 ? 0 : (f == 2 ? 1 : f - 2); }
DI int kperm(int s, int q, int jj) { return 32 * s + 16 * (jj >> 2) + 4 * q + (jj & 3); }
DI bf16x8 pack_acc2(const f32x4& X, const f32x4& Y) { v4u w; w.x = pk2(X[0], X[1]); w.y = pk2(X[2], X[3]); w.z = pk2(Y[0], Y[1]); w.w = pk2(Y[2], Y[3]); return __builtin_bit_cast(bf16x8, w); }

DI void st16_wt(void* p, v4u v) {
    __hip_atomic_store((unsigned long long*)p, (unsigned long long)v.x | ((unsigned long long)v.y << 32), __ATOMIC_RELAXED, __HIP_MEMORY_SCOPE_AGENT);
    __hip_atomic_store((unsigned long long*)p + 1, (unsigned long long)v.z | ((unsigned long long)v.w << 32), __ATOMIC_RELAXED, __HIP_MEMORY_SCOPE_AGENT);
}
template <bool DRY>
DI void gdn_prep_phase(bf16* PROJ, bf16* DRYBUF, const bf16* HALO, const float* wconv, const float* BETA, const float* GG, unsigned char* EX, float* GL, unsigned* FLAG,
                       LAS unsigned char* lds, int bid, int G, int FIRST, int tid, int wave, int lane) {
    LAS bf16* QB = (LAS bf16*)lds; LAS bf16* KB = (LAS bf16*)(lds + 17408); LAS bf16* VBt = (LAS bf16*)(lds + 34816);
    LAS float* Lm = (LAS float*)(lds + 52224); LAS float* Tm = (LAS float*)(lds + 68864); LAS float* QKm = (LAS float*)(lds + 85504);
    LAS float* gcS = (LAS float*)(lds + 102144); LAS float* btS = (LAS float*)(lds + 102400); LAS float* Mt = (LAS float*)(lds + 102656);
    LAS float* Wc = (LAS float*)(lds + 119296);
    int hcur = -1;
    for (int e0 = bid - FIRST; e0 < 4096; e0 += G - FIRST) {
        const int bh = e0 & 15, n = e0 >> 4, it = bh * 256 + n, b = bh >> 3, h = bh & 7;
        const size_t t0 = (size_t)b * SEQ + 64 * n;
        if (tid < 64) { float gv = GG[(t0 + tid) * 8 + h]; btS[tid] = BETA[(t0 + tid) * 8 + h];
#pragma unroll
            for (int o = 1; o < 64; o <<= 1) { const float tv = __shfl_up(gv, o); if (lane >= o) gv += tv; }
            gcS[tid] = gv; }
        for (int e = tid; e < 6 * 256; e += NTHR) { const int bq = e >> 8, r = (e >> 4) & 15, c = e & 15;
            const int bi = (bq < 3) ? 0 : (bq < 5 ? 1 : 2), bj = (bq < 3) ? bq + 1 : (bq < 5 ? bq - 1 : 3);
            Tm[(16 * bi + r) * 65 + 16 * bj + c] = 0.f; }
        if (h != hcur) {
            __syncthreads();
            for (int i2 = tid; i2 < 4 * 3 * 128; i2 += NTHR) { const int kk = i2 / 384, rem = i2 - kk * 384; Wc[i2] = wconv[kk * 3072 + (rem >> 7) * 1024 + h * 128 + (rem & 127)]; }
            hcur = h;
            __syncthreads();
        }
#pragma unroll 1
        for (int rnd = 0; rnd < 2; ++rnd) {
        v4u PV[3][4];
#pragma unroll
        for (int s3 = 0; s3 < 3; ++s3) {
            const int idx = wave * 6 + rnd * 3 + s3, mat = idx >> 4, rg = idx & 15;
            const int row = 4 * rg + (lane >> 4), oct = lane & 15, colg = mat * 1024 + h * 128 + 8 * oct;
#pragma unroll
            for (int kk = 0; kk < 4; ++kk) {
                const int rr = row - 3 + kk;
                v4u v = (v4u){0u, 0u, 0u, 0u};
                if (rr >= 0) v = *(const v4u*)(PROJ + (t0 + rr) * 4096 + colg);
                else if (n > 0) v = *(const v4u*)(HALO + ((size_t)(b * 256 + n - 1) * 3 + (rr + 3)) * 3072 + colg);
                PV[s3][kk] = v; }
        }
#pragma unroll
        for (int s3 = 0; s3 < 3; ++s3) {
            const int idx = wave * 6 + rnd * 3 + s3, mat = idx >> 4, rg = idx & 15;
            const int row = 4 * rg + (lane >> 4), oct = lane & 15;
            float a[8];
#pragma unroll
            for (int e = 0; e < 8; ++e) a[e] = 0.f;
#pragma unroll
            for (int kk = 0; kk < 4; ++kk) {
                const v4u v = PV[s3][kk];
                const f32x4 w0 = *(const LAS f32x4*)(Wc + (kk * 3 + mat) * 128 + 8 * oct), w1 = *(const LAS f32x4*)(Wc + (kk * 3 + mat) * 128 + 8 * oct + 4);
                a[0] += w0.x * bflo(v.x); a[1] += w0.y * bfhi(v.x); a[2] += w0.z * bflo(v.y); a[3] += w0.w * bfhi(v.y);
                a[4] += w1.x * bflo(v.z); a[5] += w1.y * bfhi(v.z); a[6] += w1.z * bflo(v.w); a[7] += w1.w * bfhi(v.w);
            }
            float ss = 0.f;
#pragma unroll
            for (int e = 0; e < 8; ++e) { a[e] = silu_f(a[e]); ss += a[e] * a[e]; }
            ss += __shfl_xor(ss, 1); ss += __shfl_xor(ss, 2); ss += __shfl_xor(ss, 4); ss += __shfl_xor(ss, 8);
            float rs = 1.f;
            if (mat == 0) rs = rsqrtf(ss + EPS) * 0.08838834764831845f; else if (mat == 1) rs = rsqrtf(ss + EPS);
            v4u o; o.x = pk2(a[0] * rs, a[1] * rs); o.y = pk2(a[2] * rs, a[3] * rs); o.z = pk2(a[4] * rs, a[5] * rs); o.w = pk2(a[6] * rs, a[7] * rs);
            LAS bf16* dst = (mat == 0 ? QB : (mat == 1 ? KB : VBt)) + row * 136 + 8 * oct;
            *(LAS v4u*)dst = o;
        }
        }
        __syncthreads();
#ifdef PREP_DBL_GRAM
        for (int rep = 0; rep < 3; ++rep)
#endif
        { const int isq = wave >> 2, m = wave & 3, r16 = lane & 15, q = lane >> 4;
          LAS bf16* As = isq ? QB : KB;
          bf16x8 af[4];
#pragma unroll
          for (int s = 0; s < 4; ++s) af[s] = *(const LAS bf16x8*)(As + (16 * m + r16) * 136 + 32 * s + 8 * q);
#pragma unroll
          for (int nt = 0; nt < 4; ++nt) { f32x4 acc = (f32x4){0.f, 0.f, 0.f, 0.f};
#pragma unroll
              for (int s = 0; s < 4; ++s) { const bf16x8 bfr = *(const LAS bf16x8*)(KB + (16 * nt + r16) * 136 + 32 * s + 8 * q); acc = MFMA16(af[s], bfr, acc); }
#pragma unroll
              for (int jj = 0; jj < 4; ++jj) { const int i = 16 * m + 4 * q + jj, j = 16 * nt + r16;
                  const float dec = __expf(fminf(gcS[i] - gcS[j], 0.f));
                  if (!isq) Lm[i * 65 + j] = (i > j) ? acc[jj] * btS[i] * dec : 0.f;
                  else QKm[i * 65 + j] = (i >= j) ? acc[jj] * dec : 0.f; } }
        }
        __syncthreads();
        const float gl = gcS[63];
        if (wave == 0) {
            const int blk = lane >> 4, col = lane & 15; const LAS float* Lb = Lm + (16 * blk) * 65 + 16 * blk;
            float t[16];
#pragma unroll
            for (int r = 0; r < 16; ++r) { float a = (r == col) ? 1.f : 0.f;
#pragma unroll
                for (int x = 0; x < r; ++x) a -= Lb[r * 65 + x] * t[x];
                t[r] = a; }
#pragma unroll
            for (int r = 0; r < 16; ++r) Tm[(16 * blk + r) * 65 + 16 * blk + col] = t[r];
        } else {
#pragma unroll 1
            for (int p0 = tid - 64; p0 < 4608; p0 += 448) {
                const int sect = p0 >> 10, p = p0 & 1023, l = p & 63, f = p >> 6, q = l >> 4, r16 = l & 15;
                v4u o;
                bf16* dst;
                if (sect == 0) {
                    const int m = f >> 2, s = f & 3, i = 16 * m + r16, c0 = 32 * s + 4 * q;
                    LAS bf16* src = QB + i * 136 + c0;
                    const v2u x0 = *(const LAS v2u*)src, x1 = *(const LAS v2u*)(src + 16);
                    const float sc = __expf(gcS[i]);
                    o.x = pk2(bflo(x0.x) * sc, bfhi(x0.x) * sc); o.y = pk2(bflo(x0.y) * sc, bfhi(x0.y) * sc);
                    o.z = pk2(bflo(x1.x) * sc, bfhi(x1.x) * sc); o.w = pk2(bflo(x1.y) * sc, bfhi(x1.y) * sc);
                    dst = PROJ + (t0 + (p >> 4)) * 4096 + h * 128 + (p & 15) * 8;
                } else if (sect == 1) {
                    o = *(const LAS v4u*)(KB + (p >> 4) * 136 + (p & 15) * 8);
                    dst = PROJ + (t0 + (p >> 4)) * 4096 + 1024 + h * 128 + (p & 15) * 8;
                } else if (sect == 2) {
                    const int w = p >> 7, ll = (p & 127) >> 1, half = p & 1; float y[8];
#pragma unroll
                    for (int jj = 0; jj < 8; ++jj) { const int m = half * 2 + (jj >> 2), rowi = 16 * m + 4 * (ll >> 4) + (jj & 3);
                        y[jj] = bf2f(VBt[rowi * 136 + 16 * w + (ll & 15)]) * btS[rowi]; }
                    o.x = pk2(y[0], y[1]); o.y = pk2(y[2], y[3]); o.z = pk2(y[4], y[5]); o.w = pk2(y[6], y[7]);
                    dst = PROJ + (t0 + (p >> 4)) * 4096 + 2048 + h * 128 + (p & 15) * 8;
                } else if (sect == 3) {
                    if (p >= 32) continue;
                    float y[4];
#pragma unroll
                    for (int jj = 0; jj < 4; ++jj) { const int i = 4 * (p & 15) + jj; y[jj] = (p < 16) ? -btS[i] * __expf(gcS[i]) : __expf(gl - gcS[i]); }
                    o.x = __builtin_bit_cast(unsigned, y[0]); o.y = __builtin_bit_cast(unsigned, y[1]); o.z = __builtin_bit_cast(unsigned, y[2]); o.w = __builtin_bit_cast(unsigned, y[3]);
                    dst = (bf16*)(EX + (size_t)it * 32768 + p * 16);
                } else {
                    const int m = f >> 1, s = f & 1, i = 16 * m + r16; float y[8];
#pragma unroll
                    for (int jj = 0; jj < 8; ++jj) y[jj] = QKm[i * 65 + kperm(s, q, jj)];
                    o.x = pk2(y[0], y[1]); o.y = pk2(y[2], y[3]); o.z = pk2(y[4], y[5]); o.w = pk2(y[6], y[7]);
                    if (f == 1 || f == 3) continue;
                    dst = (bf16*)(EX + (size_t)it * 32768 + 24576 + tq_slot(f) * 1024 + l * 16);
                }
                if (DRY) { dst = DRYBUF + (size_t)(it & 255) * 40960 + p0 * 8; *(v4u*)dst = o; } else st16_wt(dst, o);
            }
        }
        __syncthreads();
#pragma unroll
        for (int d = 1; d <= 3; ++d) {
            const int nel = (4 - d) * 256;
            for (int e = tid; e < nel; e += NTHR) { const int bj = e >> 8, r = (e >> 4) & 15, c = e & 15, bi = bj + d;
                const LAS float* Lr = Lm + (16 * bi + r) * 65; const LAS float* Tc = Tm + 16 * bj + c; float a = 0.f;
#pragma unroll
                for (int yy = 0; yy < 16 * d; ++yy) { const int y = 16 * bj + yy; a += Lr[y] * Tc[y * 65]; }
                Mt[(16 * bi + r) * 65 + 16 * bj + c] = a; }
            __syncthreads();
            for (int e = tid; e < nel; e += NTHR) { const int bj = e >> 8, r = (e >> 4) & 15, c = e & 15, bi = bj + d;
                const LAS float* Dr = Tm + (16 * bi + r) * 65 + 16 * bi; const LAS float* Mc = Mt + (16 * bi) * 65 + 16 * bj + c; float a = 0.f;
#pragma unroll
                for (int x = 0; x < 16; ++x) a += Dr[x] * Mc[x * 65];
                Tm[(16 * bi + r) * 65 + 16 * bj + c] = -a; }
            __syncthreads();
        }
        { const int p = tid, l = p & 63, f = p >> 6, q = l >> 4, r16 = l & 15, m = f >> 1, s = f & 1, i = 16 * m + r16; float y[8];
#pragma unroll
          for (int jj = 0; jj < 8; ++jj) y[jj] = Tm[i * 65 + kperm(s, q, jj)];
          v4u o; o.x = pk2(y[0], y[1]); o.y = pk2(y[2], y[3]); o.z = pk2(y[4], y[5]); o.w = pk2(y[6], y[7]);
          if (DRY) *(v4u*)(DRYBUF + (size_t)(it & 255) * 40960 + 36864 + p * 8) = o; else if (f != 1 && f != 3) st16_wt(EX + (size_t)it * 32768 + 16384 + tq_slot(f) * 1024 + l * 16, o);
          if (tid == 0 && !DRY) __hip_atomic_store(GL + it, __expf(gl), __ATOMIC_RELAXED, __HIP_MEMORY_SCOPE_AGENT); }
        asm volatile("s_waitcnt vmcnt(0)" ::: "memory");
        __syncthreads();
        if (tid == 0 && !DRY) __hip_atomic_store(FLAG + it, 1u, __ATOMIC_RELAXED, __HIP_MEMORY_SCOPE_AGENT);
    }
}

constexpr int GS_BUF = 57344;
constexpr int GS_QA = 18432, GS_SC = 34816, GS_TA = 36864, GS_QK = 45056, GS_VB = 53248;
DI void gdn_scan_phase(const bf16* PROJ, const unsigned char* EX, const float* GL, const unsigned* FLAG, bf16* ORAW, LAS unsigned char* lds, int bid, int tid, int wave, int lane) {
    if (bid >= 64) return;
    const int bh = (bid & 7) * 2 + (bid >> 5), sub = (bid >> 3) & 3, b = bh >> 3, h = bh & 7, q = lane >> 4, r16 = lane & 15;
    LAS unsigned char* OB = lds + 2 * GS_BUF;
    LAS float* GLs = (LAS float*)(lds + 2 * GS_BUF + 8192);
    if (wave >= 2) {
        const int g = (wave - 2) >> 1, i = tid & 127, rowi = i >> 4, pc = i & 15;
        v4u R0[9], R1[9], R2[9]; float G0, G1, G2;
#define GS_LD(R_, G_, n_) do { G_ = GL[bh * 256 + (n_)]; const size_t t0_ = (size_t)b * SEQ + 64 * (n_); const unsigned char* ex_ = EX + (size_t)(bh * 256 + (n_)) * 32768; \
        _Pragma("unroll") for (int u = 0; u < 9; ++u) { int c = g + 3 * u; c = c < 25 ? c : 24; const int k = c < 17 ? c : (c < 20 ? c + 7 : (c < 23 ? c + 8 : c + 9)); \
            const unsigned char* base_; size_t stride_; \
            if (k < 8) { base_ = (const unsigned char*)(PROJ + (t0_ + 8 * k) * 4096 + 1024 + h * 128); stride_ = 8192; } \
            else if (k < 16) { base_ = (const unsigned char*)(PROJ + (t0_ + 8 * (k - 8)) * 4096 + h * 128); stride_ = 8192; } \
            else if (k < 32) { base_ = ex_ + (size_t)(k - 16) * 2048; stride_ = 256; } \
            else { base_ = (const unsigned char*)(PROJ + (t0_ + 8 * (2 * sub + (k - 32))) * 4096 + 2048 + h * 128); stride_ = 8192; } \
            R_[u] = *(const v4u*)(base_ + (size_t)rowi * stride_ + pc * 16); } } while (0)
#define GS_ST(R_, G_, n_, buf_) do { if (g == 0 && i == 0) GLs[(n_)] = G_; _Pragma("unroll") for (int u = 0; u < 9; ++u) { const int c = g + 3 * u; const int k = c < 17 ? c : (c < 20 ? c + 7 : (c < 23 ? c + 8 : c + 9)); \
            int d_; if (k < 8) d_ = (8 * k + rowi) * 288 + pc * 16; else if (k < 16) d_ = GS_QA + (k - 8) * 2048 + i * 16; else if (k == 16) d_ = GS_SC + i * 16; \
            else if (k < 28) d_ = GS_TA + (k - 24) * 2048 + i * 16; else if (k < 32) d_ = GS_QK + (k - 28) * 2048 + i * 16; else d_ = GS_VB + (k - 32) * 2048 + i * 16; \
            if (c < 25) *(LAS v4u*)((buf_) + d_) = R_[u]; } } while (0)
#define GS_OUT(n_) do { if (g == 2) { const size_t t0_ = (size_t)b * SEQ + 64 * (n_); \
        _Pragma("unroll") for (int u = 0; u < 2; ++u) { const int p = i + 128 * u, row = p >> 2, c = p & 3; \
            const v4u v = *(const LAS v4u*)(OB + ((n_) & 1) * 4096 + row * 64 + c * 16); \
            *(v4u*)(ORAW + (t0_ + row) * 1024 + h * 128 + 32 * sub + 8 * c) = v; } } } while (0)
        __syncthreads();
        GS_LD(R0, G0, 0); GS_LD(R1, G1, 1); GS_LD(R2, G2, 2);
        GS_ST(R0, G0, 0, lds);
        __syncthreads();
#define GS_STEP(n_, Rst_, Gst_, Rld_, Gld_) do { if ((n_) < 256) { if ((n_) + 3 < 256) GS_LD(Rld_, Gld_, (n_) + 3); if ((n_) >= 1) GS_OUT((n_) - 1); \
            if ((n_) + 1 < 256) GS_ST(Rst_, Gst_, (n_) + 1, lds + (((n_) + 1) & 1) * GS_BUF); __syncthreads(); } } while (0)
#pragma unroll 1
        for (int n = 0; n < 258; n += 3) {
            GS_STEP(n, R1, G1, R0, G0);
            GS_STEP(n + 1, R2, G2, R1, G1);
            GS_STEP(n + 2, R0, G0, R2, G2);
        }
        GS_OUT(255);
#undef GS_LD
#undef GS_ST
#undef GS_OUT
#undef GS_STEP
        return;
    }
    f32x4 S[8];
#pragma unroll
    for (int i = 0; i < 8; ++i) S[i] = (f32x4){0.f, 0.f, 0.f, 0.f};
    const unsigned* fl = FLAG + bh * 256;
#define GS_POLL(c_) do { unsigned sp_ = 0; while (__builtin_amdgcn_readfirstlane(__hip_atomic_load(fl + (c_), __ATOMIC_RELAXED, __HIP_MEMORY_SCOPE_AGENT)) == 0u) { __builtin_amdgcn_s_sleep(2); if (++sp_ > (1u << 22)) break; } } while (0)
    if (wave == 0) { GS_POLL(0); GS_POLL(1); GS_POLL(2); GS_POLL(3); GS_POLL(4); GS_POLL(5); GS_POLL(6); GS_POLL(7); __builtin_amdgcn_fence(__ATOMIC_ACQUIRE, "agent"); asm volatile("s_waitcnt vmcnt(0)" ::: "memory"); }
    __syncthreads();
    __syncthreads();
#pragma unroll 1
    for (int n = 0; n < 256; ++n) {
        LAS unsigned char* buf = lds + (n & 1) * GS_BUF;
        const float egl = GLs[n];
        const bool pollstep = (wave == 0) && ((n & 3) == 0) && (n + 8 < 256);
        unsigned fn0 = 1u, fn1 = 1u, fn2 = 1u, fn3 = 1u;
        if (pollstep) { fn0 = __hip_atomic_load(fl + n + 8, __ATOMIC_RELAXED, __HIP_MEMORY_SCOPE_AGENT); fn1 = __hip_atomic_load(fl + n + 9, __ATOMIC_RELAXED, __HIP_MEMORY_SCOPE_AGENT);
            fn2 = __hip_atomic_load(fl + n + 10, __ATOMIC_RELAXED, __HIP_MEMORY_SCOPE_AGENT); fn3 = __hip_atomic_load(fl + n + 11, __ATOMIC_RELAXED, __HIP_MEMORY_SCOPE_AGENT); }
        f32x4 rhs[4];
        { const v4u vb0 = *(const LAS v4u*)(buf + GS_VB + wave * 2048 + lane * 32), vb1 = *(const LAS v4u*)(buf + GS_VB + wave * 2048 + lane * 32 + 16);
          rhs[0] = (f32x4){bflo(vb0.x), bfhi(vb0.x), bflo(vb0.y), bfhi(vb0.y)}; rhs[1] = (f32x4){bflo(vb0.z), bfhi(vb0.z), bflo(vb0.w), bfhi(vb0.w)};
          rhs[2] = (f32x4){bflo(vb1.x), bfhi(vb1.x), bflo(vb1.y), bfhi(vb1.y)}; rhs[3] = (f32x4){bflo(vb1.z), bfhi(vb1.z), bflo(vb1.w), bfhi(vb1.w)}; }
        bf16x8 Sb[4];
#pragma unroll
        for (int s = 0; s < 4; ++s) Sb[s] = pack_acc2(S[2 * s], S[2 * s + 1]);
        f32x4 tk[4];
#pragma unroll
        for (int m = 0; m < 4; ++m) tk[m] = (f32x4){0.f, 0.f, 0.f, 0.f};
#pragma unroll
        for (int s = 0; s < 4; ++s)
#pragma unroll
            for (int m = 0; m < 4; ++m) { const LAS unsigned char* kp = buf + (16 * m + r16) * 288 + (32 * s + 4 * q) * 2;
                const v2u lo = *(const LAS v2u*)kp, hi2 = *(const LAS v2u*)(kp + 32);
                v4u w; w.x = lo.x; w.y = lo.y; w.z = hi2.x; w.w = hi2.y;
                tk[m] = MFMA16(__builtin_bit_cast(bf16x8, w), Sb[s], tk[m]); }
#pragma unroll
        for (int m = 0; m < 4; ++m) { const f32x4 sc1 = *(const LAS f32x4*)(buf + GS_SC + (16 * m + 4 * q) * 4); rhs[m] = rhs[m] + sc1 * tk[m]; }
        bf16x8 Rb[2];
#pragma unroll
        for (int s = 0; s < 2; ++s) Rb[s] = pack_acc2(rhs[2 * s], rhs[2 * s + 1]);
        f32x4 vn[4];
#pragma unroll
        for (int m = 0; m < 4; ++m) vn[m] = (f32x4){0.f, 0.f, 0.f, 0.f};
#pragma unroll
        for (int s = 0; s < 2; ++s)
#pragma unroll
            for (int m = 0; m < 4; ++m) { if (s == 1 && m < 2) continue; const bf16x8 a = *(const LAS bf16x8*)(buf + GS_TA + tq_slot(m * 2 + s) * 1024 + lane * 16); vn[m] = MFMA16(a, Rb[s], vn[m]); }
        bf16x8 Vb[2];
#pragma unroll
        for (int s = 0; s < 2; ++s) Vb[s] = pack_acc2(vn[2 * s], vn[2 * s + 1]);
        bf16x8 Vs[2];
        { f32x4 vsc[4];
#pragma unroll
          for (int m = 0; m < 4; ++m) { const f32x4 sc2 = *(const LAS f32x4*)(buf + GS_SC + 256 + (16 * m + 4 * q) * 4); vsc[m] = vn[m] * sc2; }
#pragma unroll
          for (int s = 0; s < 2; ++s) Vs[s] = pack_acc2(vsc[2 * s], vsc[2 * s + 1]); }
#pragma unroll
        for (int m8 = 0; m8 < 8; ++m8) S[m8] = S[m8] * egl;
#pragma unroll
        for (int s = 0; s < 2; ++s)
#pragma unroll
            for (int m8 = 0; m8 < 8; ++m8) {
                const LAS unsigned char* tp = buf + (32 * s + 4 * q + ((lane & 15) >> 2)) * 288 + 32 * m8 + 8 * (lane & 3);
                const v4i16_t lo = fx_vtr(tp), hi4 = fx_vtr(tp + 16 * 288);
                S[m8] = MFMA16(__builtin_shufflevector(lo, hi4, 0, 1, 2, 3, 4, 5, 6, 7), Vs[s], S[m8]); }
        f32x4 o[4];
#pragma unroll
        for (int m = 0; m < 4; ++m) o[m] = (f32x4){0.f, 0.f, 0.f, 0.f};
#pragma unroll
        for (int s = 0; s < 4; ++s)
#pragma unroll
            for (int m = 0; m < 4; ++m) { const bf16x8 a = *(const LAS bf16x8*)(buf + GS_QA + (m * 4 + s) * 1024 + lane * 16); o[m] = MFMA16(a, Sb[s], o[m]); }
#pragma unroll
        for (int s = 0; s < 2; ++s)
#pragma unroll
            for (int m = 0; m < 4; ++m) { if (s == 1 && m < 2) continue; const bf16x8 a = *(const LAS bf16x8*)(buf + GS_QK + tq_slot(m * 2 + s) * 1024 + lane * 16); o[m] = MFMA16(a, Vb[s], o[m]); }
        { LAS bf16* ob = (LAS bf16*)(OB + (n & 1) * 4096);
#pragma unroll
          for (int m = 0; m < 4; ++m)
#pragma unroll
              for (int j = 0; j < 4; ++j) ob[(16 * m + 4 * q + j) * 32 + 16 * wave + r16] = (bf16)f2bf(o[m][j]); }
        if (pollstep) { if (__builtin_amdgcn_readfirstlane(fn0) == 0u) GS_POLL(n + 8); if (__builtin_amdgcn_readfirstlane(fn1) == 0u) GS_POLL(n + 9);
            if (__builtin_amdgcn_readfirstlane(fn2) == 0u) GS_POLL(n + 10); if (__builtin_amdgcn_readfirstlane(fn3) == 0u) GS_POLL(n + 11);
            __builtin_amdgcn_fence(__ATOMIC_ACQUIRE, "agent"); asm volatile("s_waitcnt vmcnt(0)" ::: "memory"); }
        __syncthreads();
    }
#undef GS_POLL
}

DI void gdn_onorm_phase(bf16* OY, const bf16* PROJ, const float* wn, float* ROPE, const int* pos, int gw, int NGW, int lane) {
    constexpr int NR = 4;
    for (int row = gw; row < TT; row += NGW) {
        if (lane < 32) { const float inv = powf(10000.f, -(float)lane * (1.f / 32.f)); const float ang = (float)pos[row] * inv; float sn, cs; sincosf(ang, &sn, &cs);
            ROPE[(size_t)row * 64 + lane] = cs; ROPE[(size_t)row * 64 + 32 + lane] = sn; } }
    float wv[16];
#pragma unroll
    for (int e = 0; e < 16; ++e) wv[e] = wn[16 * (lane & 7) + e];
    for (int row0 = gw * NR; row0 < TT; row0 += NGW * NR) {
        v4u o0[NR], o1[NR], z0[NR], z1[NR];
#pragma unroll
        for (int rr = 0; rr < NR; ++rr) { const bf16* op = OY + (size_t)(row0 + rr) * 1024 + 16 * lane; const bf16* zp = PROJ + (size_t)(row0 + rr) * 4096 + 3072 + 16 * lane;
            o0[rr] = *(const v4u*)op; o1[rr] = *(const v4u*)(op + 8); z0[rr] = *(const v4u*)zp; z1[rr] = *(const v4u*)(zp + 8); }
#pragma unroll
        for (int rr = 0; rr < NR; ++rr) {
            bf16* op = OY + (size_t)(row0 + rr) * 1024 + 16 * lane;
            float ov[16], zv[16];
#pragma unroll
            for (int e = 0; e < 4; ++e) { ov[2 * e] = bflo(o0[rr][e]); ov[2 * e + 1] = bfhi(o0[rr][e]); ov[8 + 2 * e] = bflo(o1[rr][e]); ov[8 + 2 * e + 1] = bfhi(o1[rr][e]);
                zv[2 * e] = bflo(z0[rr][e]); zv[2 * e + 1] = bfhi(z0[rr][e]); zv[8 + 2 * e] = bflo(z1[rr][e]); zv[8 + 2 * e + 1] = bfhi(z1[rr][e]); }
            float ss = 0.f;
#pragma unroll
            for (int e = 0; e < 16; ++e) ss += ov[e] * ov[e];
            ss += __shfl_xor(ss, 1); ss += __shfl_xor(ss, 2); ss += __shfl_xor(ss, 4);
            const float rs = rsqrtf(ss * (1.f / 128.f) + EPS);
            float y[16];
#pragma unroll
            for (int e = 0; e < 16; ++e) y[e] = ov[e] * rs * wv[e] * silu_f(zv[e]);
            v4u a, c; a.x = pk2(y[0], y[1]); a.y = pk2(y[2], y[3]); a.z = pk2(y[4], y[5]); a.w = pk2(y[6], y[7]);
            c.x = pk2(y[8], y[9]); c.y = pk2(y[10], y[11]); c.z = pk2(y[12], y[13]); c.w = pk2(y[14], y[15]);
            *(v4u*)op = a; *(v4u*)(op + 8) = c;
        }
    }
}
DI void swa_phase(const bf16* PROJ, const float* ROPE, const float* sinks, bf16* Y, LAS unsigned char* lds, int bid, int G, int tid, int wave, int lane) {
    LAS bf16* Ks = (LAS bf16*)lds;
    LAS bf16* Vs = (LAS bf16*)(lds + 36864);
    const int r = lane & 31, hi = lane >> 5;
    const float LOG2E = 1.4426950408889634f, c2 = 0.125f * LOG2E;
    for (int it = bid; it < 1024; it += G) {
        const int hk = it & 3, nb = (it >> 2) & 127, b = it >> 9;
        const long tb0 = (long)b * SEQ + (long)(nb - 1) * 128;
#pragma unroll
        for (int u = 0; u < 2; ++u) { const int p = tid + 512 * u, kk = p >> 2, o = p & 3;
            v4u w1 = (v4u){0u, 0u, 0u, 0u}, w2 = (v4u){0u, 0u, 0u, 0u};
            if (nb > 0 || kk >= 128) {
                const size_t t = (size_t)(tb0 + kk);
                const bf16* kp = PROJ + t * 2560 + 1024 + hk * 64 + 8 * o;
                const v4u a = *(const v4u*)kp, c = *(const v4u*)(kp + 32);
                const f32x4 cs0 = *(const f32x4*)(ROPE + t * 64 + 8 * o), cs1 = *(const f32x4*)(ROPE + t * 64 + 8 * o + 4);
                const f32x4 sn0 = *(const f32x4*)(ROPE + t * 64 + 32 + 8 * o), sn1 = *(const f32x4*)(ROPE + t * 64 + 32 + 8 * o + 4);
                float x1[8], x2[8], cs[8], sn[8];
#pragma unroll
                for (int e = 0; e < 4; ++e) { x1[2 * e] = bflo(a[e]); x1[2 * e + 1] = bfhi(a[e]); x2[2 * e] = bflo(c[e]); x2[2 * e + 1] = bfhi(c[e]);
                    cs[e] = cs0[e]; cs[4 + e] = cs1[e]; sn[e] = sn0[e]; sn[4 + e] = sn1[e]; }
                float y1[8], y2[8];
#pragma unroll
                for (int e = 0; e < 8; ++e) { y1[e] = x1[e] * cs[e] - x2[e] * sn[e]; y2[e] = x2[e] * cs[e] + x1[e] * sn[e]; }
                w1.x = pk2(y1[0], y1[1]); w1.y = pk2(y1[2], y1[3]); w1.z = pk2(y1[4], y1[5]); w1.w = pk2(y1[6], y1[7]);
                w2.x = pk2(y2[0], y2[1]); w2.y = pk2(y2[2], y2[3]); w2.z = pk2(y2[4], y2[5]); w2.w = pk2(y2[6], y2[7]);
            }
            *(LAS v4u*)(Ks + kk * 72 + 8 * o) = w1; *(LAS v4u*)(Ks + kk * 72 + 32 + 8 * o) = w2; }
#pragma unroll
        for (int u = 0; u < 4; ++u) { const int p = tid + 512 * u, kk = p >> 3, o8 = p & 7;
            v4u v = (v4u){0u, 0u, 0u, 0u};
            if (nb > 0 || kk >= 128) v = *(const v4u*)(PROJ + (size_t)(tb0 + kk) * 2560 + 1280 + hk * 64 + 8 * o8);
            const int pos = (kk & ~15) + perm16(kk & 15);
            LAS bf16* d = Vs + (8 * o8) * 264 + pos;
            d[0] = (bf16)(v.x & 0xffffu); d[264] = (bf16)(v.x >> 16); d[2 * 264] = (bf16)(v.y & 0xffffu); d[3 * 264] = (bf16)(v.y >> 16);
            d[4 * 264] = (bf16)(v.z & 0xffffu); d[5 * 264] = (bf16)(v.z >> 16); d[6 * 264] = (bf16)(v.w & 0xffffu); d[7 * 264] = (bf16)(v.w >> 16); }
        __syncthreads();
        const int g = wave >> 1, qh = wave & 1, head = hk * 4 + g;
        const float sink2 = sinks[head] * LOG2E;
        for (int sb = 0; sb < 2; ++sb) {
            const int qs = 64 * qh + 32 * sb, qi = qs + r, tbase = qs >> 5;
            const size_t t = (size_t)b * SEQ + (size_t)nb * 128 + qi;
            bf16x8 Qf[4];
            { const bf16* qp = PROJ + t * 2560 + head * 64 + 8 * hi;
              v4u qa[4];
#pragma unroll
              for (int ks = 0; ks < 4; ++ks) qa[ks] = *(const v4u*)(qp + 16 * ks);
#pragma unroll
              for (int k2 = 0; k2 < 2; ++k2) {
                  const f32x4 cs0 = *(const f32x4*)(ROPE + t * 64 + 16 * k2 + 8 * hi), cs1 = *(const f32x4*)(ROPE + t * 64 + 16 * k2 + 8 * hi + 4);
                  const f32x4 sn0 = *(const f32x4*)(ROPE + t * 64 + 32 + 16 * k2 + 8 * hi), sn1 = *(const f32x4*)(ROPE + t * 64 + 32 + 16 * k2 + 8 * hi + 4);
                  float y1[8], y2[8];
#pragma unroll
                  for (int e = 0; e < 4; ++e) {
                      const float a0 = bflo(qa[k2][e]), a1 = bfhi(qa[k2][e]), c0 = bflo(qa[k2 + 2][e]), c1 = bfhi(qa[k2 + 2][e]);
                      const float cA = (e < 2) ? cs0[2 * e] : cs1[2 * e - 4], cB = (e < 2) ? cs0[2 * e + 1] : cs1[2 * e - 3];
                      const float sA = (e < 2) ? sn0[2 * e] : sn1[2 * e - 4], sB = (e < 2) ? sn0[2 * e + 1] : sn1[2 * e - 3];
                      y1[2 * e] = a0 * cA - c0 * sA; y2[2 * e] = c0 * cA + a0 * sA;
                      y1[2 * e + 1] = a1 * cB - c1 * sB; y2[2 * e + 1] = c1 * cB + a1 * sB; }
                  v4u w1, w2;
                  w1.x = pk2(y1[0], y1[1]); w1.y = pk2(y1[2], y1[3]); w1.z = pk2(y1[4], y1[5]); w1.w = pk2(y1[6], y1[7]);
                  w2.x = pk2(y2[0], y2[1]); w2.y = pk2(y2[2], y2[3]); w2.z = pk2(y2[4], y2[5]); w2.w = pk2(y2[6], y2[7]);
                  Qf[k2] = __builtin_bit_cast(bf16x8, w1); Qf[k2 + 2] = __builtin_bit_cast(bf16x8, w2); } }
            f32x16 S[5];
            float mx = sink2;
#pragma unroll
            for (int tk = 0; tk < 5; ++tk) {
#pragma unroll
                for (int i = 0; i < 16; ++i) S[tk][i] = 0.f;
                const int kt = tbase + tk;
#pragma unroll
                for (int ks = 0; ks < 4; ++ks) { const bf16x8 a = *(const LAS bf16x8*)(Ks + (32 * kt + r) * 72 + 16 * ks + 8 * hi); S[tk] = MFMA32(a, Qf[ks], S[tk]); }
#pragma unroll
                for (int i = 0; i < 16; ++i) { const int kk = 32 * kt + crow32(i, hi);
                    const bool ok = (kk > qi) && (kk <= qi + 128) && (nb > 0 || kk >= 128);
                    const float xv = ok ? S[tk][i] * c2 : -INFINITY; S[tk][i] = xv; mx = fmaxf(mx, xv); }
            }
            mx = fmaxf(mx, __shfl_xor(mx, 32));
            float ps = 0.f;
#pragma unroll
            for (int tk = 0; tk < 5; ++tk)
#pragma unroll
                for (int i = 0; i < 16; ++i) { const float p = __builtin_amdgcn_exp2f(S[tk][i] - mx); S[tk][i] = p; ps += p; }
            const float tot = ps + __shfl_xor(ps, 32) + __builtin_amdgcn_exp2f(sink2 - mx);
            const float inv = 1.f / tot;
            f32x16 O[2];
#pragma unroll
            for (int dt = 0; dt < 2; ++dt)
#pragma unroll
                for (int i = 0; i < 16; ++i) O[dt][i] = 0.f;
#pragma unroll
            for (int tk = 0; tk < 5; ++tk)
#pragma unroll
                for (int s = 0; s < 2; ++s) { v4u w;
                    w.x = pk2(S[tk][8 * s], S[tk][8 * s + 1]); w.y = pk2(S[tk][8 * s + 2], S[tk][8 * s + 3]);
                    w.z = pk2(S[tk][8 * s + 4], S[tk][8 * s + 5]); w.w = pk2(S[tk][8 * s + 6], S[tk][8 * s + 7]);
                    const bf16x8 pf = __builtin_bit_cast(bf16x8, w);
                    const int kt = tbase + tk;
#pragma unroll
                    for (int dt = 0; dt < 2; ++dt) { const bf16x8 a = *(const LAS bf16x8*)(Vs + (32 * dt + r) * 264 + 32 * kt + 16 * s + 8 * hi); O[dt] = MFMA32(a, pf, O[dt]); } }
#pragma unroll
            for (int dt = 0; dt < 2; ++dt)
#pragma unroll
                for (int g4 = 0; g4 < 4; ++g4) { const int d = 32 * dt + 8 * g4 + 4 * hi;
                    const v2u z = *(const v2u*)(PROJ + t * 2560 + 1536 + head * 64 + d);
                    const float y0 = O[dt][4 * g4] * inv * silu_f(bflo(z.x)), y1 = O[dt][4 * g4 + 1] * inv * silu_f(bfhi(z.x));
                    const float y2 = O[dt][4 * g4 + 2] * inv * silu_f(bflo(z.y)), y3 = O[dt][4 * g4 + 3] * inv * silu_f(bfhi(z.y));
                    v2u o; o.x = pk2(y0, y1); o.y = pk2(y2, y3);
                    *(v2u*)(Y + t * 1024 + head * 64 + d) = o; }
        }
        __syncthreads();
    }
}
#ifndef LAYER_MASK
#define LAYER_MASK 15
#endif
__global__ void __launch_bounds__(NTHR, 2) mega_fwd(Ptrs P) {
    extern __shared__ __attribute__((aligned(16))) unsigned char lds_raw[];
    LAS unsigned char* lds = (LAS unsigned char*)lds_raw;
    cg::grid_group grid = cg::this_grid();
    int tid_o = threadIdx.x; int tid = tid_o, lane = tid & 63; const int wave = __builtin_amdgcn_readfirstlane(tid >> 6);
    const int G = gridDim.x, bid = blockIdx.x;
    const int gw = bid * NWAVES + wave, NGW = G * NWAVES, NG = G * NTHR; int gtid = bid * NTHR + tid;
    unsigned char* ws = P.ws;
    const float* x_in = P.in[0]; const int* positions = (const int*)P.in[1];
    const float* norm_w = P.in[2]; const float* fnorm_w = P.in[3];
    float* X = P.out;
    bf16* XB = (bf16*)P.out;
    bf16* XB3 = (bf16*)(ws + WS_EX + 64 * MiB);
    bf16* HY = (bf16*)(ws + WS_HY); bf16* PROJ = (bf16*)(ws + WS_PROJ);
#define RELAUNDER() do { asm volatile("" : "+v"(tid_o)); tid = tid_o; lane = tid & 63; gtid = bid * NTHR + tid; } while (0)
#define GSYNC() do { xcd_barrier(xbar); RELAUNDER(); } while (0)

    unsigned* CTL = (unsigned*)(ws + WS_GL + 65536);
    if (bid == 0 && tid < 128) CTL[tid] = 0u;
    unsigned* FLAGS = (unsigned*)(ws + WS_GL + 131072);
    for (int i = gtid; i < 4096; i += NG) FLAGS[i] = 0u;
    unsigned* XBW = (unsigned*)(ws + WS_GL + 262144);
    volatile LAS unsigned* xst = (volatile LAS unsigned*)(lds + LDS_BYTES - 16);
    if (bid == 0) for (int i = tid; i < XCD_BAR_WORDS; i += NTHR) XBW[i] = 0u;
    if (tid < 2) xst[tid] = 0u;
    p0_prologue(P, lds, gw, NGW, wave, lane);
#ifdef DBL_P0
    p0_prologue(P, lds, gw, NGW, wave, lane);
#endif
    norm_phase<0>(x_in, norm_w, HY, nullptr, nullptr, 0, nullptr, nullptr, nullptr, nullptr, nullptr, nullptr, lds, gw, NGW, tid, lane);
    grid.sync();
    RELAUNDER();
    const XcdBarrier xbar = xcd_barrier_post(XBW, xst);
    if (LAYER_MASK & 1) {
        bf16* Y0 = (bf16*)(ws + WS_EX); float* CVH = (float*)(ws + WS_PROJ); float* BND = (float*)(ws + WS_PROJ + 8 * MiB);
        { pg8::Gemm g{HY, (const bf16*)(ws + WS_W0I), TT, 4096, 1024}; pg8::StaticOrder S; S.init(TT, 4096, G, bid);
          pg8::EpiConvGate E{Y0, P.in[5], CVH, BND};
          pg8::gemm_phase<pg8::EpiConvGate, pg8::StaticOrder, true, true>(lds, g, S, E); }
        GSYNC();
        convfix_phase(CVH, BND, P.in[5], Y0, gtid, NG);
        GSYNC();
        { pg8::Gemm g{Y0, (const bf16*)(ws + WS_W0O), TT, 1024, 1024}; pg8::StaticOrder S; S.init(TT, 1024, G, bid);
          pg8::EpiRes<false, true> E{x_in, XB, nullptr};
          pg8::gemm_phase<pg8::EpiRes<false, true>, pg8::StaticOrder, true, true>(lds, g, S, E);
        }
    } else {
        for (size_t i = gtid; i < (size_t)TT * DM / 4; i += NG) { const f32x4 v = ((const f32x4*)x_in)[i]; v2u o; o.x = pk2(v.x, v.y); o.y = pk2(v.z, v.w); ((v2u*)XB)[i] = o; }
    }
    GSYNC();
    if (LAYER_MASK & 2) {
        float* LOGF = (float*)(ws + WS_LOGF); float* CUM = (float*)(ws + WS_CUM); bf16* VT = (bf16*)(ws + WS_EX);
        norm_phase<1, true>((const float*)XB, norm_w + 1024, HY, nullptr, P.in[7], 4104, LOGF, nullptr, P.in[8], nullptr, nullptr, nullptr, lds, gw, NGW, tid, lane);
        GSYNC();
        if (bid < 16) fox_cumsum(LOGF, CUM, bid, lds, tid);
        { pg8::Gemm g{HY, (const bf16*)(ws + WS_W1I), TT, 4096, 1024}; pg8::StaticOrder S; S.init(TT, 4096, G, bid);
          pg8::EpiStore E{PROJ, 4096, nullptr};
          pg8::gemm_phase<pg8::EpiStore, pg8::StaticOrder, true, true>(lds, g, S, E); }
        GSYNC();
        fox_norms_phase(PROJ, (float*)(CTL + 1024), gw, NGW, lane);
#ifdef DBL_VTRANS
        fox_norms_phase(PROJ, (float*)(CTL + 1024), gw, NGW, lane);
#endif
        GSYNC();
        fox_attn_phase(PROJ, CUM, HY, (const float*)(CTL + 1024), CTL + 64, lds, bid, G, tid, wave, lane);
#ifdef DBL_FOX
        fox_attn_phase(PROJ, CUM, HY, (const float*)(CTL + 1024), CTL + 65, lds, bid, G, tid, wave, lane);
#endif
        GSYNC();
        { pg8::Gemm g{HY, (const bf16*)(ws + WS_W1O), TT, 1024, 1024}; pg8::StaticOrder S; S.init(TT, 1024, G, bid);
          pg8::EpiRes<true, true> E{XB, XB, nullptr};
          pg8::gemm_phase<pg8::EpiRes<true, true>, pg8::StaticOrder, true, true>(lds, g, S, E); }
        GSYNC();
    }
    if (LAYER_MASK & 4) {
        float* BETA = (float*)(ws + WS_LOGF); float* GG = (float*)(ws + WS_CUM); float* GL = (float*)(ws + WS_GL); bf16* HALO = (bf16*)(ws + WS_HALO);
        norm_phase<2, true>((const float*)XB, norm_w + 2048, HY, nullptr, P.in[10], 4112, BETA, GG, P.in[12], P.in[13], nullptr, nullptr, lds, gw, NGW, tid, lane);
#ifdef DBL_NORM2
        norm_phase<2, true>((const float*)XB, norm_w + 2048, HY, nullptr, P.in[10], 4112, BETA, GG, P.in[12], P.in[13], nullptr, nullptr, lds, gw, NGW, tid, lane);
#endif
        GSYNC();
        { pg8::Gemm g{HY, (const bf16*)(ws + WS_W2I), TT, 4096, 1024}; pg8::StaticOrder S; S.init(TT, 4096, G, bid);
          pg8::EpiStore E{PROJ, 4096, HALO};
          pg8::gemm_phase<pg8::EpiStore, pg8::StaticOrder, true, true>(lds, g, S, E); }
        GSYNC();
        if (bid >= 64) gdn_prep_phase<false>(PROJ, HY, HALO, P.in[11], BETA, GG, ws + WS_EX, GL, FLAGS, lds, bid, G, 64, tid, wave, lane);
        else gdn_scan_phase(PROJ, ws + WS_EX, GL, FLAGS, HY, lds, bid, tid, wave, lane);
        GSYNC();
        gdn_onorm_phase(HY, PROJ, P.in[14], (float*)(ws + WS_EX), positions, gw, NGW, lane);
        GSYNC();
        { pg8::Gemm g{HY, (const bf16*)(ws + WS_W2O), TT, 1024, 1024}; pg8::StaticOrder S; S.init(TT, 1024, G, bid);
          pg8::EpiRes<true, true, true> E{XB, XB3, (float*)(ws + WS_LOGF)};
          pg8::gemm_phase<pg8::EpiRes<true, true, true>, pg8::StaticOrder, true, true>(lds, g, S, E); }
        GSYNC();
    }
    if (LAYER_MASK & 8) {
        float* ROPE = (float*)(ws + WS_EX);
        { pg8::Gemm g{XB3, (const bf16*)(ws + WS_W3I), TT, 2560, 1024}; pg8::StaticOrder S; S.init(TT, 2560, G, bid);
          pg8::EpiStoreScaled E{PROJ, 2560, (const float*)(ws + WS_LOGF)};
          pg8::gemm_phase<pg8::EpiStoreScaled, pg8::StaticOrder, true, true>(lds, g, S, E); }
        GSYNC();
        swa_phase(PROJ, ROPE, P.in[17], HY, lds, bid, G, tid, wave, lane);
#ifdef DBL_SWA
        swa_phase(PROJ, ROPE, P.in[17], HY, lds, bid, G, tid, wave, lane);
#endif
        GSYNC();
        { pg8::Gemm g{HY, (const bf16*)(ws + WS_W3O), TT, 1024, 1024}; pg8::StaticOrder S; S.init(TT, 1024, G, bid);
          pg8::EpiRes<true, false> E{XB3, X, nullptr};
          pg8::gemm_phase<pg8::EpiRes<true, false>, pg8::StaticOrder, true, true>(lds, g, S, E); }
        GSYNC();
    }
#ifdef DBL_SYNC
    for (int i = 0; i < 10; ++i) GSYNC();
#endif
#ifdef DBL_FINAL
    norm_phase<0>(X, fnorm_w, HY, nullptr, nullptr, 0, nullptr, nullptr, nullptr, nullptr, nullptr, nullptr, lds, gw, NGW, tid, lane);
#endif
    norm_phase<4>(X, fnorm_w, nullptr, X, nullptr, 0, nullptr, nullptr, nullptr, nullptr, nullptr, nullptr, lds, gw, NGW, tid, lane);
}

extern "C" void kernel_launch(void* const* d_in, const int* in_sizes, int n_in, void* d_out, int out_size, void* d_ws, size_t ws_size, hipStream_t stream) {
    static int grid = 0;
    if (grid == 0) {
        int dev = 0, cus = 0, per_cu = 0;
        hipGetDevice(&dev);
        hipDeviceGetAttribute(&cus, hipDeviceAttributeMultiprocessorCount, dev);
        if (hipFuncSetAttribute((const void*)mega_fwd, hipFuncAttributeMaxDynamicSharedMemorySize, LDS_BYTES) != hipSuccess) fprintf(stderr, "kernel_launch: hipFuncSetAttribute failed\n");
        if (hipOccupancyMaxActiveBlocksPerMultiprocessor(&per_cu, (const void*)mega_fwd, NTHR, LDS_BYTES) != hipSuccess || per_cu < 1) { fprintf(stderr, "kernel_launch: occupancy query says %d\n", per_cu); per_cu = 1; }
        (void)hipGetLastError();
        grid = cus;
        if (ws_size < WS_END) fprintf(stderr, "kernel_launch: workspace %zu < %zu\n", ws_size, (size_t)WS_END);
    }
    Ptrs p{};
    for (int i = 0; i < 19; ++i) p.in[i] = (const float*)d_in[i];
    p.out = (float*)d_out; p.ws = (unsigned char*)d_ws; p.ph_lo = 0; p.ph_hi = 0;
    void* args[] = {&p};
    hipError_t e = hipLaunchCooperativeKernel((const void*)mega_fwd, dim3(grid), dim3(NTHR), args, LDS_BYTES, stream);
    if (e != hipSuccess) fprintf(stderr, "cooperative launch failed: %s (grid %d)\n", hipGetErrorString(e), grid);
}
```
